# Optimizing an MI355X kernel written in HIP

```python
import jax, jax.numpy as jnp
from jax import lax
import numpy as np

D_MODEL = 1024
BATCH = 32
SEQ = 256
DEPTH = 4
DEC_BATCH = 4
DEC_SEQ = 1024
PAST_LEN = 256

GRID_W = 64
N_MIXERS = 3
N_NA_LAYERS = (DEPTH + 2) // 3
N_RET_LAYERS = (DEPTH + 1) // 3
N_MLP_LAYERS = DEPTH // 3
EPS = 1e-6
NEG_INF = -1e30

NA_HEADS = 16
NA_HEAD_DIM = D_MODEL // NA_HEADS
NA_WIDTH = NA_HEADS * NA_HEAD_DIM
NA_KH = 8
NA_KW = 16
ATTN_Q_BLOCK = 128

RET_HEADS = 4
RET_QK_DIM = D_MODEL // RET_HEADS
RET_V_DIM = 2 * D_MODEL // RET_HEADS
RET_QK_WIDTH = RET_HEADS * RET_QK_DIM
RET_WIDTH = RET_HEADS * RET_V_DIM
RET_CHUNK = 128
ROPE_BASE = 10000.0

MLP_WIDTH = 2 * D_MODEL
MLP_GROUPS = 8
MLP_GROUP_DIM = MLP_WIDTH // MLP_GROUPS
MLP_CHUNK = 128

kernel_name = "hybrid_na_retention_gmlp_diffusion_step"


def rms_norm(x, w):
    xf = x.astype(jnp.float32)
    y = xf * lax.rsqrt(jnp.mean(xf * xf, axis=-1, keepdims=True) + EPS)
    return (y * w.astype(jnp.float32)).astype(x.dtype)


def layer_norm(x, w, b):
    xf = x.astype(jnp.float32)
    mu = jnp.mean(xf, axis=-1, keepdims=True)
    var = jnp.mean(jnp.square(xf - mu), axis=-1, keepdims=True)
    y = (xf - mu) * lax.rsqrt(var + EPS)
    return (y * w.astype(jnp.float32) + b.astype(jnp.float32)).astype(x.dtype)


def adaln(cvec, w, b):
    m = jax.nn.silu(cvec) @ w + b
    return jnp.split(m, 3, axis=-1)


def axial_rope(x):
    N, Dh = x.shape[1], x.shape[-1]
    half = Dh // 2
    t = jnp.arange(N)
    row = (t // GRID_W).astype(jnp.float32)
    col = (t % GRID_W).astype(jnp.float32)

    def rot(xa, pos):
        d = xa.shape[-1]
        inv = ROPE_BASE ** (-jnp.arange(0, d, 2, dtype=jnp.float32) / d)
        ang = pos[:, None] * inv[None, :]
        cos = jnp.cos(ang)[None, :, None, :]
        sin = jnp.sin(ang)[None, :, None, :]
        x1, x2 = xa[..., : d // 2], xa[..., d // 2:]
        return jnp.concatenate([x1 * cos - x2 * sin, x1 * sin + x2 * cos], axis=-1).astype(xa.dtype)

    return jnp.concatenate([rot(x[..., :half], row), rot(x[..., half:], col)], axis=-1)


def na_project(h, w_in, q_gain, k_gain):
    B, N, _ = h.shape
    q, k, v, g = jnp.split(h @ w_in, 4, axis=-1)
    q = rms_norm(q.reshape(B, N, NA_HEADS, NA_HEAD_DIM), q_gain)
    k = rms_norm(k.reshape(B, N, NA_HEADS, NA_HEAD_DIM), k_gain)
    v = v.reshape(B, N, NA_HEADS, NA_HEAD_DIM)
    return q, k, v, g


def dense_attention(q, k, v):
    B, S, H, Dh = q.shape
    scale = Dh ** -0.5
    qb = q.reshape(B, S // ATTN_Q_BLOCK, ATTN_Q_BLOCK, H, Dh).transpose(1, 0, 2, 3, 4)

    def blk(qi):
        s = jnp.einsum('bqhd,bkhd->bhqk', qi, k).astype(jnp.float32) * scale
        p = jax.nn.softmax(s, axis=-1).astype(v.dtype)
        return jnp.einsum('bhqk,bkhd->bqhd', p, v)

    o = lax.map(blk, qb)
    return o.transpose(1, 0, 2, 3, 4).reshape(B, S, H, Dh)


def na_context(h, w_in, w_out, q_gain, k_gain):
    B, S, _ = h.shape
    q, k, v, g = na_project(h, w_in, q_gain, k_gain)
    o = dense_attention(q, k, v).reshape(B, S, NA_WIDTH) * jax.nn.silu(g)
    return o @ w_out, k, v


def na_latent(h, k_ctx, v_ctx, w_in, w_out, q_gain, k_gain, rpb):
    B, N, _ = h.shape
    R = N // GRID_W
    kh = min(NA_KH, R)
    scale = NA_HEAD_DIM ** -0.5
    q, k, v, g = na_project(h, w_in, q_gain, k_gain)
    qg = q.reshape(B, R, GRID_W, NA_HEADS, NA_HEAD_DIM)
    kg = k.reshape(B, R, GRID_W, NA_HEADS, NA_HEAD_DIM)
    vg = v.reshape(B, R, GRID_W, NA_HEADS, NA_HEAD_DIM)

    r = np.arange(R)
    rstart = np.clip(r - kh // 2, 0, R - kh)
    row_idx = rstart[:, None] + np.arange(kh)[None, :]
    cq = np.arange(GRID_W)
    cstart = np.clip(cq - NA_KW // 2, 0, GRID_W - NA_KW)
    ck = np.arange(GRID_W)
    col_in = (ck[None, :] >= cstart[:, None]) & (ck[None, :] < cstart[:, None] + NA_KW)

    k_rows = kg[:, row_idx]
    v_rows = vg[:, row_idx]
    s_loc = jnp.einsum('brqhd,brjkhd->brhqjk', qg, k_rows).astype(jnp.float32) * scale

    roff = row_idx - r[:, None] + (NA_KH - 1)
    coff = np.clip(ck[None, :] - cq[:, None], -(NA_KW - 1), NA_KW - 1) + (NA_KW - 1)
    bias = rpb[:, roff[:, None, :, None], coff[None, :, None, :]]
    bias = bias.transpose(1, 0, 2, 3, 4).astype(jnp.float32)
    s_loc = jnp.where(col_in[:, None, :], s_loc + bias[None], NEG_INF)
    s_loc = s_loc.reshape(B, R, NA_HEADS, GRID_W, kh * GRID_W)

    s_ctx = jnp.einsum('brqhd,bkhd->brhqk', qg, k_ctx).astype(jnp.float32) * scale
    p = jax.nn.softmax(jnp.concatenate([s_loc, s_ctx], axis=-1), axis=-1).astype(v.dtype)
    p_loc = p[..., : kh * GRID_W].reshape(B, R, NA_HEADS, GRID_W, kh, GRID_W)
    p_ctx = p[..., kh * GRID_W:]
    o = (jnp.einsum('brhqjk,brjkhd->brqhd', p_loc, v_rows)
         + jnp.einsum('brhqk,bkhd->brqhd', p_ctx, v_ctx))
    o = o.reshape(B, N, NA_WIDTH) * jax.nn.silu(g)
    return o @ w_out


def retention_scan(q, k, v, log_gamma, s0):
    B, N, H, Dk = q.shape
    Dv = v.shape[-1]
    C = RET_CHUNK
    nc = N // C
    lg = log_gamma.astype(jnp.float32)
    pos = jnp.arange(C, dtype=jnp.float32)
    decay_q = jnp.exp(lg[None, :] * (pos[:, None] + 1.0))[None, :, :, None]
    decay_k = jnp.exp(lg[None, :] * (C - 1.0 - pos[:, None]))[None, :, :, None]
    diff = pos[:, None] - pos[None, :]
    dmat = jnp.where(diff[None] >= 0, jnp.exp(lg[:, None, None] * jnp.maximum(diff, 0.0)[None]), 0.0)
    chunk_decay = jnp.exp(lg * C)[None, :, None, None]
    kscale = Dk ** -0.5

    def to_chunks(a):
        return a.reshape(B, nc, C, H, a.shape[-1]).transpose(1, 0, 2, 3, 4)

    def step(s, xs):
        qc, kc, vc = xs
        qf = qc.astype(jnp.float32)
        kf = kc.astype(jnp.float32) * kscale
        vf = vc.astype(jnp.float32)
        inner = jnp.einsum('bihd,bjhd->bhij', qf, kf) * dmat[None]
        o = (jnp.einsum('bhij,bjhv->bihv', inner, vf)
             + jnp.einsum('bihd,bhdv->bihv', qf, s) * decay_q)
        s = s * chunk_decay + jnp.einsum('bjhd,bjhv->bhdv', kf * decay_k, vf)
        return s, o

    s_final, o = lax.scan(step, s0.astype(jnp.float32), (to_chunks(q), to_chunks(k), to_chunks(v)))
    o = o.transpose(1, 0, 2, 3, 4).reshape(B, N, H, Dv)
    return o, s_final


def ret_project(h, w_in):
    B, N, _ = h.shape
    q, k, v, g = jnp.split(h @ w_in, [RET_QK_WIDTH, 2 * RET_QK_WIDTH, 2 * RET_QK_WIDTH + RET_WIDTH], axis=-1)
    q = q.reshape(B, N, RET_HEADS, RET_QK_DIM)
    k = k.reshape(B, N, RET_HEADS, RET_QK_DIM)
    v = v.reshape(B, N, RET_HEADS, RET_V_DIM)
    return q, k, v, g


def ret_bidirectional(q, k, v, decay_logit, s0_f, s0_b):
    lg = jax.nn.log_sigmoid(decay_logit.astype(jnp.float32))
    o_f, s_f = retention_scan(q, k, v, lg[0], s0_f)
    o_b, s_b = retention_scan(jnp.flip(q, 1), jnp.flip(k, 1), jnp.flip(v, 1), lg[1], s0_b)
    return o_f + jnp.flip(o_b, 1), s_f, s_b


def ret_output(o, g, gn_w, w_out, dtype):
    B, N = o.shape[:2]
    mu = jnp.mean(o, axis=-1, keepdims=True)
    var = jnp.mean(jnp.square(o - mu), axis=-1, keepdims=True)
    y = ((o - mu) * lax.rsqrt(var + EPS)).reshape(B, N, RET_WIDTH) * gn_w.astype(jnp.float32)
    y = y.astype(dtype) * jax.nn.silu(g)
    return y @ w_out


def ret_context(h, w_in, w_out, decay_logit, gn_w):
    B = h.shape[0]
    q, k, v, g = ret_project(h, w_in)
    s0 = jnp.zeros((B, RET_HEADS, RET_QK_DIM, RET_V_DIM), jnp.float32)
    o, s_f, s_b = ret_bidirectional(q, k, v, decay_logit, s0, s0)
    state = jnp.stack([s_f, s_b], axis=1).astype(h.dtype)
    return ret_output(o, g, gn_w, w_out, h.dtype), state


def ret_latent(h, state, w_in, w_out, decay_logit, gn_w):
    q, k, v, g = ret_project(h, w_in)
    q = axial_rope(q)
    k = axial_rope(k)
    o, _, _ = ret_bidirectional(q, k, v, decay_logit, state[:, 0], state[:, 1])
    return ret_output(o, g, gn_w, w_out, h.dtype)


def chunk_mlp(h, w_in, ln_w, ln_b, w_s, b_s, w_out):
    B, N, _ = h.shape
    nc = N // MLP_CHUNK
    u, v, g = jnp.split(h @ w_in, 3, axis=-1)
    u = jax.nn.gelu(u)
    v = layer_norm(jax.nn.gelu(v), ln_w, ln_b)
    vg = v.reshape(B, nc, MLP_CHUNK, MLP_GROUPS, MLP_GROUP_DIM)
    sv = jnp.einsum('gij,bnjgd->bnigd', w_s, vg) + b_s.T[None, None, :, :, None]
    o = u * sv.reshape(B, N, MLP_WIDTH) * jax.nn.silu(g)
    return o @ w_out


def modulate(h, shift, scale):
    return h * (1.0 + scale) + shift


def setup_inputs(seed: int = 0) -> dict:
    key = jax.random.key(seed)
    ks = jax.random.split(key, 26)
    f32 = jnp.float32

    def nrm(k, shape, s):
        return jax.random.normal(k, shape, f32) * s

    dec_base = jnp.log(2.0 ** (5.0 + jnp.arange(RET_HEADS, dtype=f32)) - 1.0)
    return {
        "x_prompt": nrm(ks[0], (BATCH, SEQ, D_MODEL), 1.0),
        "x_sample": nrm(ks[1], (DEC_BATCH, DEC_SEQ, D_MODEL), 1.0),
        "cache_na_k": nrm(ks[2], (DEC_BATCH, N_NA_LAYERS, PAST_LEN, NA_HEADS, NA_HEAD_DIM), 1.0),
        "cache_na_v": nrm(ks[3], (DEC_BATCH, N_NA_LAYERS, PAST_LEN, NA_HEADS, NA_HEAD_DIM), 1.0),
        "state_ret": nrm(ks[4], (DEC_BATCH, N_RET_LAYERS, 2, RET_HEADS, RET_QK_DIM, RET_V_DIM), 0.5),
        "c": nrm(ks[5], (DEC_BATCH, D_MODEL), 1.0),
        "c_ctx": nrm(ks[6], (D_MODEL,), 1.0),
        "norm_w": 1.0 + nrm(ks[7], (DEPTH, D_MODEL), 0.02),
        "w_ada": nrm(ks[8], (DEPTH, D_MODEL, 3 * D_MODEL), 0.5 * D_MODEL ** -0.5),
        "b_ada": nrm(ks[9], (DEPTH, 3 * D_MODEL), 0.01),
        "na_w_in": nrm(ks[10], (N_NA_LAYERS, D_MODEL, 4 * NA_WIDTH), D_MODEL ** -0.5),
        "na_w_out": nrm(ks[11], (N_NA_LAYERS, NA_WIDTH, D_MODEL), NA_WIDTH ** -0.5),
        "na_q_gain": 1.0 + nrm(ks[12], (N_NA_LAYERS, NA_HEAD_DIM), 0.02),
        "na_k_gain": 1.0 + nrm(ks[13], (N_NA_LAYERS, NA_HEAD_DIM), 0.02),
        "na_rpb": nrm(ks[14], (N_NA_LAYERS, NA_HEADS, 2 * NA_KH - 1, 2 * NA_KW - 1), 0.1),
        "ret_w_in": nrm(ks[15], (N_RET_LAYERS, D_MODEL, 2 * RET_QK_WIDTH + 2 * RET_WIDTH), D_MODEL ** -0.5),
        "ret_w_out": nrm(ks[16], (N_RET_LAYERS, RET_WIDTH, D_MODEL), RET_WIDTH ** -0.5),
        "ret_decay_logit": dec_base[None, None, :] + nrm(ks[17], (N_RET_LAYERS, 2, RET_HEADS), 0.1),
        "ret_gn_w": 1.0 + nrm(ks[18], (N_RET_LAYERS, RET_WIDTH), 0.02),
        "mlp_w_in": nrm(ks[19], (N_MLP_LAYERS, D_MODEL, 3 * MLP_WIDTH), D_MODEL ** -0.5),
        "mlp_ln_w": 1.0 + nrm(ks[20], (N_MLP_LAYERS, MLP_WIDTH), 0.02),
        "mlp_ln_b": nrm(ks[21], (N_MLP_LAYERS, MLP_WIDTH), 0.01),
        "mlp_w_s": nrm(ks[22], (N_MLP_LAYERS, MLP_GROUPS, MLP_CHUNK, MLP_CHUNK), MLP_CHUNK ** -0.5),
        "mlp_b_s": 1.0 + nrm(ks[23], (N_MLP_LAYERS, MLP_GROUPS, MLP_CHUNK), 0.02),
        "mlp_w_out": nrm(ks[24], (N_MLP_LAYERS, MLP_WIDTH, D_MODEL), MLP_WIDTH ** -0.5),
    }


def reference(x_prompt, x_sample, cache_na_k, cache_na_v, state_ret, c, c_ctx, norm_w, w_ada, b_ada,
              na_w_in, na_w_out, na_q_gain, na_k_gain, na_rpb,
              ret_w_in, ret_w_out, ret_decay_logit, ret_gn_w,
              mlp_w_in, mlp_ln_w, mlp_ln_b, mlp_w_s, mlp_b_s, mlp_w_out):
    yp = x_prompt
    ys = x_sample
    new_k, new_v, new_s = [], [], []
    for i in range(DEPTH):
        kind = i % N_MIXERS
        j = i // N_MIXERS
        sh_p, sc_p, g_p = adaln(c_ctx, w_ada[i], b_ada[i])
        sh_s, sc_s, g_s = adaln(c, w_ada[i], b_ada[i])
        sh_s, sc_s, g_s = sh_s[:, None, :], sc_s[:, None, :], g_s[:, None, :]
        hp = modulate(rms_norm(yp, norm_w[i]), sh_p, sc_p)
        hs = modulate(rms_norm(ys, norm_w[i]), sh_s, sc_s)
        if kind == 0:
            op, kc, vc = na_context(hp, na_w_in[j], na_w_out[j], na_q_gain[j], na_k_gain[j])
            os_ = na_latent(hs, cache_na_k[:, j], cache_na_v[:, j], na_w_in[j], na_w_out[j],
                            na_q_gain[j], na_k_gain[j], na_rpb[j])
            new_k.append(kc)
            new_v.append(vc)
        elif kind == 1:
            op, st = ret_context(hp, ret_w_in[j], ret_w_out[j], ret_decay_logit[j], ret_gn_w[j])
            os_ = ret_latent(hs, state_ret[:, j], ret_w_in[j], ret_w_out[j], ret_decay_logit[j], ret_gn_w[j])
            new_s.append(st)
        else:
            op = chunk_mlp(hp, mlp_w_in[j], mlp_ln_w[j], mlp_ln_b[j], mlp_w_s[j], mlp_b_s[j], mlp_w_out[j])
            os_ = chunk_mlp(hs, mlp_w_in[j], mlp_ln_w[j], mlp_ln_b[j], mlp_w_s[j], mlp_b_s[j], mlp_w_out[j])
        yp = yp + g_p * op
        ys = ys + g_s * os_
    new_na_k = jnp.stack(new_k, axis=1)
    new_na_v = jnp.stack(new_v, axis=1)
    new_ret = jnp.stack(new_s, axis=1)
    return (yp, ys, new_na_k, new_na_v, new_ret)
```

```cpp
#include <hip/hip_runtime.h>
#include <hip/hip_cooperative_groups.h>
#include <cstdio>
namespace cg = cooperative_groups;

typedef unsigned short u16;
using bf16x8 = __attribute__((ext_vector_type(8))) short;
using bf16x4 = __attribute__((ext_vector_type(4))) short;
using f32x4  = __attribute__((ext_vector_type(4))) float;

#define TP 8192
#define TS 4096
#define TT 12288

struct Params {
  const float *x_prompt, *x_sample, *cache_k, *cache_v, *state_ret, *c, *c_ctx, *norm_w, *w_ada, *b_ada;
  const float *na_w_in, *na_w_out, *na_q_gain, *na_k_gain, *na_rpb;
  const float *ret_w_in, *ret_w_out, *ret_decay, *ret_gn_w;
  const float *mlp_w_in, *mlp_ln_w, *mlp_ln_b, *mlp_w_s, *mlp_b_s, *mlp_w_out;
  float *y_out, *new_k, *new_v, *new_ret;
  u16 *wt_na_in, *wt_na_out, *wt_ret_in, *wt_ret_out, *wt_mlp_in, *wt_mlp_out, *ws_bf, *ck_bf, *cvt_bf, *s0t;
  float *mod, *ropetab, *dec, *X;
  u16 *h;
  u16 *na_q, *na_k, *na_vT, *na_sg, *na_o;
  u16 *rt_q, *rt_k, *rt_qs, *rt_kT, *rt_vT, *rt_sg, *rt_y;
  u16 *ml_gu, *ml_vT, *ml_sg, *ml_o;
  float *ml_st;
};

__device__ __forceinline__ u16 f2bf(float f) {
  unsigned u = __float_as_uint(f);
  u += 0x7fffu + ((u >> 16) & 1u);
  return (u16)(u >> 16);
}
__device__ __forceinline__ float bf2f(u16 h) { return __uint_as_float(((unsigned)h) << 16); }
__device__ __forceinline__ unsigned pk2(float a, float b) { return (unsigned)f2bf(a) | ((unsigned)f2bf(b) << 16); }
__device__ __forceinline__ bf16x8 pack8(f32x4 a, f32x4 b) {
  bf16x8 r;
  r[0] = (short)f2bf(a[0]); r[1] = (short)f2bf(a[1]); r[2] = (short)f2bf(a[2]); r[3] = (short)f2bf(a[3]);
  r[4] = (short)f2bf(b[0]); r[5] = (short)f2bf(b[1]); r[6] = (short)f2bf(b[2]); r[7] = (short)f2bf(b[3]);
  return r;
}
__device__ __forceinline__ void store4bf(u16* dst, float a, float b, float c, float d) {
  uint2 v; v.x = pk2(a, b); v.y = pk2(c, d);
  *(uint2*)dst = v;
}
__device__ __forceinline__ float silu_f(float x) { return x / (1.f + __expf(-x)); }
__device__ __forceinline__ float gelu_f(float x) {
  float z = 0.7978845608028654f * (x + 0.044715f * x * x * x);
  float t = 1.f - 2.f / (__expf(2.f * z) + 1.f);
  return 0.5f * x * (1.f + t);
}
__device__ __forceinline__ int tidx() { int t = threadIdx.x; asm volatile("" : "+v"(t)); return t; }
#define MFMA16(a, b, c) __builtin_amdgcn_mfma_f32_16x16x32_bf16((a), (b), (c), 0, 0, 0)

__device__ __forceinline__ void gemm_core(const u16* __restrict__ A, long lda, const u16* __restrict__ B, long ldb,
                                          int K, char* smem, f32x4 (&acc)[4][4]) {
  const int tid = tidx(), lane = tid & 63, wid = tid >> 6, wr = wid >> 1, wc = wid & 1, fr = lane & 15, fq = lane >> 4;
#pragma unroll
  for (int m = 0; m < 4; ++m)
#pragma unroll
    for (int n = 0; n < 4; ++n) acc[m][n] = f32x4{0.f, 0.f, 0.f, 0.f};
  const int nk = K >> 6;
  auto stage = [&](int kt, int b) {
#pragma unroll
    for (int i = 0; i < 4; ++i) {
      int s = tid + i * 256;
      int r = s >> 3, cp = s & 7, c = cp ^ ((r >> 1) & 7);
      __builtin_amdgcn_global_load_lds((const unsigned*)(A + (long)r * lda + kt * 64 + c * 8),
                                       (__attribute__((address_space(3))) unsigned*)(smem + b * 32768 + s * 16), 16, 0, 0);
      __builtin_amdgcn_global_load_lds((const unsigned*)(B + (long)r * ldb + kt * 64 + c * 8),
                                       (__attribute__((address_space(3))) unsigned*)(smem + b * 32768 + 16384 + s * 16), 16, 0, 0);
    }
  };
  stage(0, 0);
  for (int t = 0; t < nk; ++t) {
    asm volatile("s_waitcnt vmcnt(0)" ::: "memory");
    __syncthreads();
    if (t + 1 < nk) stage(t + 1, (t + 1) & 1);
    const char* sa = smem + (t & 1) * 32768;
    const char* sb = sa + 16384;
#pragma unroll
    for (int ks = 0; ks < 2; ++ks) {
      bf16x8 af[4], bfr[4];
#pragma unroll
      for (int m = 0; m < 4; ++m) {
        int r = wr * 64 + m * 16 + fr;
        af[m] = *(const bf16x8*)(sa + (r * 8 + ((ks * 4 + fq) ^ ((r >> 1) & 7))) * 16);
      }
#pragma unroll
      for (int n = 0; n < 4; ++n) {
        int r = wc * 64 + n * 16 + fr;
        bfr[n] = *(const bf16x8*)(sb + (r * 8 + ((ks * 4 + fq) ^ ((r >> 1) & 7))) * 16);
      }
#pragma unroll
      for (int m = 0; m < 4; ++m)
#pragma unroll
        for (int n = 0; n < 4; ++n) acc[m][n] = MFMA16(af[m], bfr[n], acc[m][n]);
    }
  }
  __syncthreads();
}

__device__ __forceinline__ void adaln_item(const Params& p, int it, char* smem) {
  const int tid = tidx();
  int layer = it / 48, n0 = (it % 48) * 64;
  float* s_c = (float*)smem;
  float* s_p = s_c + 5120;
  for (int idx = tid; idx < 5120; idx += 256) {
    int v = idx >> 10, kk = idx & 1023;
    float cv = (v == 0) ? p.c_ctx[kk] : p.c[(v - 1) * 1024 + kk];
    s_c[idx] = silu_f(cv);
  }
  __syncthreads();
  int cl = tid & 15, ksl = tid >> 4;
  const float* w = p.w_ada + (long)layer * 1024 * 3072 + n0 + cl * 4;
  float4 a0 = {0, 0, 0, 0}, a1 = a0, a2 = a0, a3 = a0, a4 = a0;
#pragma unroll 8
  for (int kk = 0; kk < 64; ++kk) {
    int k = ksl * 64 + kk;
    float4 w4 = *(const float4*)(w + (long)k * 3072);
    float c0 = s_c[k], c1 = s_c[1024 + k], c2 = s_c[2048 + k], c3 = s_c[3072 + k], c4 = s_c[4096 + k];
    a0.x += c0 * w4.x; a0.y += c0 * w4.y; a0.z += c0 * w4.z; a0.w += c0 * w4.w;
    a1.x += c1 * w4.x; a1.y += c1 * w4.y; a1.z += c1 * w4.z; a1.w += c1 * w4.w;
    a2.x += c2 * w4.x; a2.y += c2 * w4.y; a2.z += c2 * w4.z; a2.w += c2 * w4.w;
    a3.x += c3 * w4.x; a3.y += c3 * w4.y; a3.z += c3 * w4.z; a3.w += c3 * w4.w;
    a4.x += c4 * w4.x; a4.y += c4 * w4.y; a4.z += c4 * w4.z; a4.w += c4 * w4.w;
  }
  *(float4*)(s_p + (ksl * 5 + 0) * 64 + cl * 4) = a0;
  *(float4*)(s_p + (ksl * 5 + 1) * 64 + cl * 4) = a1;
  *(float4*)(s_p + (ksl * 5 + 2) * 64 + cl * 4) = a2;
  *(float4*)(s_p + (ksl * 5 + 3) * 64 + cl * 4) = a3;
  *(float4*)(s_p + (ksl * 5 + 4) * 64 + cl * 4) = a4;
  __syncthreads();
  for (int o = tid; o < 320; o += 256) {
    int v = o >> 6, col = o & 63;
    float s = p.b_ada[layer * 3072 + n0 + col];
#pragma unroll
    for (int k2 = 0; k2 < 16; ++k2) s += s_p[(k2 * 5 + v) * 64 + col];
    p.mod[(layer * 5 + v) * 3072 + n0 + col] = s;
  }
  __syncthreads();
}

__device__ __forceinline__ void tr_tile(const float* __restrict__ src, long ld_src, u16* __restrict__ dst, long ld_dst,
                        int r0, int c0, int perm, char* smem) {
  float* tile = (float*)smem;
  const int tid = tidx();
  {
    int cc = tid & 63;
    int pcol = c0 + cc;
    int scol = pcol;
    if (perm) {
      int blk = pcol & ~127, w = pcol & 127;
      int r = w & 63;
      scol = blk + (r >> 5) * 64 + (w >> 6) * 32 + (r & 31);
    }
#pragma unroll
    for (int i = 0; i < 16; ++i) {
      int rr = (tid >> 6) + i * 4;
      tile[rr * 65 + cc] = src[(long)(r0 + rr) * ld_src + scol];
    }
  }
  __syncthreads();
  {
    int rr = tid & 63;
#pragma unroll
    for (int i = 0; i < 16; ++i) {
      int pp = (tid >> 6) + i * 4;
      dst[(long)(c0 + pp) * ld_dst + r0 + rr] = f2bf(tile[rr * 65 + pp]);
    }
  }
  __syncthreads();
}

__device__ __forceinline__ void tr_item(const Params& p, int x, char* smem) {
  if (x < 2048) {
    int bt = x >> 10, tt = x & 1023, rt = tt & 15, ct = tt >> 4;
    tr_tile(p.na_w_in + (long)bt * 1024 * 4096, 4096, p.wt_na_in + (long)bt * 4096 * 1024, 1024, rt * 64, ct * 64, 0, smem);
    return;
  }
  x -= 2048;
  if (x < 512) {
    int bt = x >> 8, tt = x & 255, rt = tt & 15, ct = tt >> 4;
    tr_tile(p.na_w_out + (long)bt * 1024 * 1024, 1024, p.wt_na_out + (long)bt * 1024 * 1024, 1024, rt * 64, ct * 64, 0, smem);
    return;
  }
  x -= 512;
  if (x < 1536) {
    int rt = x & 15, ct = x >> 4;
    tr_tile(p.ret_w_in, 6144, p.wt_ret_in, 1024, rt * 64, ct * 64, ct < 32 ? 1 : 0, smem);
    return;
  }
  x -= 1536;
  if (x < 512) {
    int rt = x & 31, ct = x >> 5;
    tr_tile(p.ret_w_out, 1024, p.wt_ret_out, 2048, rt * 64, ct * 64, 0, smem);
    return;
  }
  x -= 512;
  if (x < 1536) {
    int rt = x & 15, ct = x >> 4;
    tr_tile(p.mlp_w_in, 6144, p.wt_mlp_in, 1024, rt * 64, ct * 64, 0, smem);
    return;
  }
  x -= 1536;
  if (x < 512) {
    int rt = x & 31, ct = x >> 5;
    tr_tile(p.mlp_w_out, 1024, p.wt_mlp_out, 2048, rt * 64, ct * 64, 0, smem);
    return;
  }
  x -= 512;
  if (x < 512) {
    int bt = x >> 6, tt = x & 63, rt = tt & 3, ct = tt >> 2;
    tr_tile(p.cache_v + (long)bt * 262144, 1024, p.cvt_bf + (long)bt * 262144, 256, rt * 64, ct * 64, 0, smem);
    return;
  }
  x -= 512;
  {
    int bt = x >> 5, tt = x & 31, rt = tt & 3, ct = tt >> 2;
    int b = bt >> 3, dir = (bt >> 2) & 1, hh = bt & 3;
    tr_tile(p.state_ret + (long)bt * 131072, 512, p.s0t + (long)(b * 4 + hh) * 262144 + dir * 256, 512, rt * 64, ct * 64, 0, smem);
  }
}

__device__ __forceinline__ void cv_item(const Params& p, int it) {
  const int tid = tidx();
  const float* src; u16* dst; long base;
  if (it < 2048) { src = p.cache_k; dst = p.ck_bf; base = (long)it * 1024 + tid * 4; }
  else { src = p.mlp_w_s; dst = p.ws_bf; base = (long)(it - 2048) * 1024 + tid * 4; }
  float4 v = *(const float4*)(src + base);
  store4bf(dst + base, v.x, v.y, v.z, v.w);
}

__device__ __forceinline__ void misc_item(const Params& p) {
  const int tid = tidx();
  for (int idx = tid; idx < 4096; idx += 256) {
    int pos = idx >> 6, i = idx & 63;
    float inv = exp2f(-(float)i * (13.287712379549449f / 64.f));
    float ang = (float)pos * inv;
    p.ropetab[2 * idx] = cosf(ang);
    p.ropetab[2 * idx + 1] = sinf(ang);
  }
  if (tid < 8) {
    float x = p.ret_decay[tid];
    float lg = -log1pf(expf(-x));
    p.dec[tid] = lg * 1.4426950408889634f;
  }
}

__device__ __forceinline__ void prep_phase(const Params& p, char* smem) {
  const int NADA = 192, NTR = 8192, NCV = 2176;
  for (int it = blockIdx.x; it < NADA + NTR + NCV + 1; it += gridDim.x) {
    if (it < NADA) adaln_item(p, it, smem);
    else if (it < NADA + NTR) tr_item(p, it - NADA, smem);
    else if (it < NADA + NTR + NCV) cv_item(p, it - NADA - NTR);
    else misc_item(p);
  }
}

__device__ __forceinline__ void norm_phase(const Params& p, int layer, const float* xp, const float* xs) {
  const int wave = tidx() >> 6, lane = tidx() & 63;
  const float* nw = p.norm_w + layer * 1024;
  for (int row = blockIdx.x * 4 + wave; row < TT; row += gridDim.x * 4) {
    const float* x = row < TP ? xp + (long)row * 1024 : xs + (long)(row - TP) * 1024;
    int mv = row < TP ? 0 : 1 + ((row - TP) >> 10);
    const float* md = p.mod + (long)(layer * 5 + mv) * 3072;
    float4 v[4];
    float ss = 0.f;
#pragma unroll
    for (int i = 0; i < 4; ++i) {
      v[i] = *(const float4*)(x + i * 256 + lane * 4);
      ss += v[i].x * v[i].x + v[i].y * v[i].y + v[i].z * v[i].z + v[i].w * v[i].w;
    }
#pragma unroll
    for (int o = 32; o > 0; o >>= 1) ss += __shfl_xor(ss, o);
    float r = rsqrtf(ss * (1.f / 1024.f) + 1e-6f);
#pragma unroll
    for (int i = 0; i < 4; ++i) {
      int c = i * 256 + lane * 4;
      float4 w4 = *(const float4*)(nw + c);
      float4 sh = *(const float4*)(md + c);
      float4 sc = *(const float4*)(md + 1024 + c);
      float o0 = (v[i].x * r * w4.x) * (1.f + sc.x) + sh.x;
      float o1 = (v[i].y * r * w4.y) * (1.f + sc.y) + sh.y;
      float o2 = (v[i].z * r * w4.z) * (1.f + sc.z) + sh.z;
      float o3 = (v[i].w * r * w4.w) * (1.f + sc.w) + sh.w;
      store4bf(p.h + (long)row * 1024 + c, o0, o1, o2, o3);
    }
  }
}

__device__ __forceinline__ void epi_resid(const Params& p, int layer, const float* xp, const float* xs, float* xout,
                                          int tm, int tn, f32x4 (&acc)[4][4]) {
  const int lane = tidx() & 63, wid = tidx() >> 6, wr = wid >> 1, wc = wid & 1, fr = lane & 15, fq = lane >> 4;
  int mv = tm < 64 ? 0 : 1 + ((tm - 64) >> 3);
  const float* gate = p.mod + (long)(layer * 5 + mv) * 3072 + 2048;
#pragma unroll
  for (int n = 0; n < 4; ++n) {
    int col = tn * 128 + wc * 64 + n * 16 + fr;
    float g = gate[col];
#pragma unroll
    for (int m = 0; m < 4; ++m)
#pragma unroll
      for (int j = 0; j < 4; ++j) {
        int t = tm * 128 + wr * 64 + m * 16 + fq * 4 + j;
        float xin = t < TP ? xp[(long)t * 1024 + col] : xs[(long)(t - TP) * 1024 + col];
        xout[(long)t * 1024 + col] = xin + g * acc[m][n][j];
      }
  }
}

__device__ __forceinline__ void epi_na_in(const Params& p, int lj, int tm, int tn, f32x4 (&acc)[4][4]) {
  const int lane = tidx() & 63, wid = tidx() >> 6, wr = wid >> 1, wc = wid & 1, fr = lane & 15, fq = lane >> 4;
  const int sec = tn >> 3;
  const int cbase = (tn & 7) * 128 + wc * 64;
  const int head = cbase >> 6;
  const int row0 = tm * 128 + wr * 64;
  if (sec <= 1) {
    const float* gain = (sec == 0 ? p.na_q_gain : p.na_k_gain) + lj * 64;
    float g[4];
#pragma unroll
    for (int n = 0; n < 4; ++n) g[n] = gain[n * 16 + fr];
#pragma unroll
    for (int m = 0; m < 4; ++m)
#pragma unroll
      for (int j = 0; j < 4; ++j) {
        float ss = 0.f;
#pragma unroll
        for (int n = 0; n < 4; ++n) ss += acc[m][n][j] * acc[m][n][j];
        ss += __shfl_xor(ss, 1); ss += __shfl_xor(ss, 2); ss += __shfl_xor(ss, 4); ss += __shfl_xor(ss, 8);
        float r = rsqrtf(ss * (1.f / 64.f) + 1e-6f);
        int t = row0 + m * 16 + fq * 4 + j;
#pragma unroll
        for (int n = 0; n < 4; ++n) {
          int col = cbase + n * 16 + fr;
          float val = acc[m][n][j] * r * g[n];
          if (sec == 0) {
            p.na_q[(long)t * 1024 + col] = f2bf(val * 0.125f);
          } else {
            p.na_k[(long)t * 1024 + col] = f2bf(val);
            if (t < TP) p.new_k[((long)((t >> 8) * 2 + lj) * 256 + (t & 255)) * 1024 + col] = val;
          }
        }
      }
  } else if (sec == 2) {
#pragma unroll
    for (int m = 0; m < 4; ++m) {
      int t0 = row0 + m * 16 + fq * 4;
#pragma unroll
      for (int n = 0; n < 4; ++n) {
        int d = n * 16 + fr;
        f32x4 a = acc[m][n];
        if (t0 < TP) {
          int b = t0 >> 8, s = t0 & 255;
          store4bf(p.na_vT + ((long)(b * 16 + head) * 64 + d) * 256 + s, a[0], a[1], a[2], a[3]);
          float* nv = p.new_v + ((long)(b * 2 + lj) * 256 + s) * 1024 + head * 64 + d;
          nv[0] = a[0]; nv[1024] = a[1]; nv[2048] = a[2]; nv[3072] = a[3];
        } else {
          int ts = t0 - TP, b = ts >> 10, nn = ts & 1023;
          store4bf(p.na_vT + (long)TP * 1024 + ((long)(b * 16 + head) * 64 + d) * 1024 + nn, a[0], a[1], a[2], a[3]);
        }
      }
    }
  } else {
#pragma unroll
    for (int m = 0; m < 4; ++m)
#pragma unroll
      for (int j = 0; j < 4; ++j) {
        int t = row0 + m * 16 + fq * 4 + j;
#pragma unroll
        for (int n = 0; n < 4; ++n) p.na_sg[(long)t * 1024 + cbase + n * 16 + fr] = f2bf(silu_f(acc[m][n][j]));
      }
  }
}

__device__ __forceinline__ void epi_ret_in(const Params& p, int tm, int tn, f32x4 (&acc)[4][4]) {
  const int lane = tidx() & 63, wid = tidx() >> 6, wr = wid >> 1, wc = wid & 1, fr = lane & 15, fq = lane >> 4;
  const int row0 = tm * 128 + wr * 64;
  if (tn < 16) {
    const bool isk = tn >= 8;
    const int blk = tn & 7, hh = blk >> 1, half = blk & 1;
    const float l2f = p.dec[hh], l2b = p.dec[4 + hh];
    const bool sample = tm >= 64;
#pragma unroll
    for (int m = 0; m < 4; ++m) {
      float o1[2][4], o2[2][4];
      const int t0 = row0 + m * 16 + fq * 4;
#pragma unroll
      for (int j = 0; j < 4; ++j) {
        int t = t0 + j;
        int nn = (t - TP) & 1023;
        int pos = half == 0 ? (nn >> 6) : (nn & 63);
#pragma unroll
        for (int n2 = 0; n2 < 2; ++n2) {
          int i = wc * 32 + n2 * 16 + fr;
          float x1 = acc[m][n2][j], x2 = acc[m][n2 + 2][j];
          if (sample) {
            float2 cs = *(const float2*)(p.ropetab + 2 * (pos * 64 + i));
            o1[n2][j] = x1 * cs.x - x2 * cs.y;
            o2[n2][j] = x1 * cs.y + x2 * cs.x;
          } else { o1[n2][j] = x1; o2[n2][j] = x2; }
          if (isk) { o1[n2][j] *= 0.0625f; o2[n2][j] *= 0.0625f; }
        }
      }
#pragma unroll
      for (int j = 0; j < 4; ++j) {
        int t = t0 + j;
        u16* dst = (isk ? p.rt_k : p.rt_q) + (long)t * 1024 + hh * 256 + half * 128;
#pragma unroll
        for (int n2 = 0; n2 < 2; ++n2) {
          int i = wc * 32 + n2 * 16 + fr;
          dst[i] = f2bf(o1[n2][j]);
          dst[64 + i] = f2bf(o2[n2][j]);
        }
        if (!isk && sample) {
          int ts = t - TP, b = ts >> 10, nn = ts & 1023;
          float df = exp2f(l2f * (float)(nn + 1)), db = exp2f(l2b * (float)(1024 - nn));
          u16* qs = p.rt_qs + ((long)(b * 4 + hh) * 1024 + nn) * 512 + half * 128;
#pragma unroll
          for (int n2 = 0; n2 < 2; ++n2) {
            int i = wc * 32 + n2 * 16 + fr;
            qs[i] = f2bf(o1[n2][j] * df);
            qs[64 + i] = f2bf(o2[n2][j] * df);
            qs[256 + i] = f2bf(o1[n2][j] * db);
            qs[256 + 64 + i] = f2bf(o2[n2][j] * db);
          }
        }
      }
      if (isk && !sample) {
        int b = t0 >> 8, s = t0 & 255;
        float wf[4], wb[4];
#pragma unroll
        for (int j = 0; j < 4; ++j) { wf[j] = exp2f(l2f * (float)(255 - s - j)); wb[j] = exp2f(l2b * (float)(s + j)); }
#pragma unroll
        for (int n2 = 0; n2 < 2; ++n2) {
          int dk1 = half * 128 + wc * 32 + n2 * 16 + fr, dk2 = dk1 + 64;
          u16* kf = p.rt_kT + ((long)((b * 4 + hh) * 2 + 0) * 256) * 256 + s;
          u16* kb = p.rt_kT + ((long)((b * 4 + hh) * 2 + 1) * 256) * 256 + s;
          store4bf(kf + (long)dk1 * 256, o1[n2][0] * wf[0], o1[n2][1] * wf[1], o1[n2][2] * wf[2], o1[n2][3] * wf[3]);
          store4bf(kf + (long)dk2 * 256, o2[n2][0] * wf[0], o2[n2][1] * wf[1], o2[n2][2] * wf[2], o2[n2][3] * wf[3]);
          store4bf(kb + (long)dk1 * 256, o1[n2][0] * wb[0], o1[n2][1] * wb[1], o1[n2][2] * wb[2], o1[n2][3] * wb[3]);
          store4bf(kb + (long)dk2 * 256, o2[n2][0] * wb[0], o2[n2][1] * wb[1], o2[n2][2] * wb[2], o2[n2][3] * wb[3]);
        }
      }
    }
  } else if (tn < 32) {
#pragma unroll
    for (int m = 0; m < 4; ++m) {
      int t0 = row0 + m * 16 + fq * 4;
#pragma unroll
      for (int n = 0; n < 4; ++n) {
        int cv = (tn - 16) * 128 + wc * 64 + n * 16 + fr;
        int hh = cv >> 9, dv = cv & 511;
        f32x4 a = acc[m][n];
        if (t0 < TP) {
          int b = t0 >> 8, s = t0 & 255;
          store4bf(p.rt_vT + ((long)(b * 4 + hh) * 512 + dv) * 256 + s, a[0], a[1], a[2], a[3]);
        } else {
          int ts = t0 - TP, b = ts >> 10, nn = ts & 1023;
          store4bf(p.rt_vT + (long)TP * 2048 + ((long)(b * 4 + hh) * 512 + dv) * 1024 + nn, a[0], a[1], a[2], a[3]);
        }
      }
    }
  } else {
#pragma unroll
    for (int m = 0; m < 4; ++m)
#pragma unroll
      for (int j = 0; j < 4; ++j) {
        int t = row0 + m * 16 + fq * 4 + j;
#pragma unroll
        for (int n = 0; n < 4; ++n)
          p.rt_sg[(long)t * 2048 + (tn - 32) * 128 + wc * 64 + n * 16 + fr] = f2bf(silu_f(acc[m][n][j]));
      }
  }
}

__device__ __forceinline__ void epi_mlp_in(const Params& p, int tm, int tn, f32x4 (&acc)[4][4]) {
  const int lane = tidx() & 63, wid = tidx() >> 6, wr = wid >> 1, wc = wid & 1, fr = lane & 15, fq = lane >> 4;
  const int row0 = tm * 128 + wr * 64;
  if (tn < 16 || tn >= 32) {
    const bool isu = tn < 16;
    u16* dstb = isu ? p.ml_gu : p.ml_sg;
    const int c0 = (isu ? tn : tn - 32) * 128 + wc * 64;
#pragma unroll
    for (int m = 0; m < 4; ++m)
#pragma unroll
      for (int j = 0; j < 4; ++j) {
        int t = row0 + m * 16 + fq * 4 + j;
#pragma unroll
        for (int n = 0; n < 4; ++n) {
          float a = acc[m][n][j];
          dstb[(long)t * 2048 + c0 + n * 16 + fr] = f2bf(isu ? gelu_f(a) : silu_f(a));
        }
      }
  } else {
    const int c0 = (tn - 16) * 128 + wc * 64;
#pragma unroll
    for (int m = 0; m < 4; ++m) {
      float s1[4] = {0, 0, 0, 0}, s2[4] = {0, 0, 0, 0};
      int il = wr * 64 + m * 16 + fq * 4;
#pragma unroll
      for (int n = 0; n < 4; ++n) {
        float g0 = bf2f(f2bf(gelu_f(acc[m][n][0]))), g1 = bf2f(f2bf(gelu_f(acc[m][n][1])));
        float g2 = bf2f(f2bf(gelu_f(acc[m][n][2]))), g3 = bf2f(f2bf(gelu_f(acc[m][n][3])));
        s1[0] += g0; s1[1] += g1; s1[2] += g2; s1[3] += g3;
        s2[0] += g0 * g0; s2[1] += g1 * g1; s2[2] += g2 * g2; s2[3] += g3 * g3;
        store4bf(p.ml_vT + ((long)tm * 2048 + c0 + n * 16 + fr) * 128 + il, g0, g1, g2, g3);
      }
#pragma unroll
      for (int j = 0; j < 4; ++j) {
        float a = s1[j], b = s2[j];
        a += __shfl_xor(a, 1); a += __shfl_xor(a, 2); a += __shfl_xor(a, 4); a += __shfl_xor(a, 8);
        b += __shfl_xor(b, 1); b += __shfl_xor(b, 2); b += __shfl_xor(b, 4); b += __shfl_xor(b, 8);
        if (fr == 0) {
          int t = tm * 128 + il + j;
          float2 st; st.x = a; st.y = b;
          *(float2*)(p.ml_st + ((long)t * 32 + (tn - 16) * 2 + wc) * 2) = st;
        }
      }
    }
  }
}

template <class F>
__device__ __forceinline__ void attn64_tile(const u16* __restrict__ kp, const u16* __restrict__ vp, long vs,
                                            const bf16x8 (&qf)[2], f32x4 (&o)[4], float& l, int fr, int fq, F f) {
  f32x4 s[4];
#pragma unroll
  for (int n = 0; n < 4; ++n) {
    s[n] = f32x4{0.f, 0.f, 0.f, 0.f};
#pragma unroll
    for (int ks = 0; ks < 2; ++ks) {
      bf16x8 kf = *(const bf16x8*)(kp + (long)(n * 16 + fr) * 1024 + ks * 32 + fq * 8);
      s[n] = MFMA16(kf, qf[ks], s[n]);
    }
  }
#pragma unroll
  for (int n = 0; n < 4; ++n)
#pragma unroll
    for (int j = 0; j < 4; ++j) {
      float pv = f(n, j, s[n][j]);
      l += pv;
      s[n][j] = pv;
    }
#pragma unroll
  for (int ks2 = 0; ks2 < 2; ++ks2) {
    bf16x8 pa = pack8(s[2 * ks2], s[2 * ks2 + 1]);
#pragma unroll
    for (int dt = 0; dt < 4; ++dt) {
      const u16* vv = vp + (long)(dt * 16 + fr) * vs + fq * 4;
      bf16x4 v0 = *(const bf16x4*)(vv + (2 * ks2) * 16);
      bf16x4 v1 = *(const bf16x4*)(vv + (2 * ks2 + 1) * 16);
      bf16x8 vb = __builtin_shufflevector(v0, v1, 0, 1, 2, 3, 4, 5, 6, 7);
      o[dt] = MFMA16(pa, vb, o[dt]);
    }
  }
}

__device__ __forceinline__ void na_attn_phase(const Params& p, int lj, char* smem) {
  float* s_rpb = (float*)smem;
  const int tid = tidx(), lane = tid & 63, wid = tid >> 6, fr = lane & 15, fq = lane >> 4;
  for (int item = blockIdx.x; item < 3072; item += gridDim.x) {
    f32x4 o[4];
#pragma unroll
    for (int dt = 0; dt < 4; ++dt) o[dt] = f32x4{0.f, 0.f, 0.f, 0.f};
    float l = 0.f;
    bf16x8 qf[2];
    int tq0, hh;
    if (item < 1024) {
      int b = item >> 8, r = item & 15;
      hh = (item >> 4) & 15;
      const float* rp = p.na_rpb + (long)(lj * 16 + hh) * 465;
      for (int i = tid; i < 465; i += 256) s_rpb[i] = rp[i];
      __syncthreads();
      tq0 = TP + b * 1024 + r * 64 + wid * 16;
#pragma unroll
      for (int ks = 0; ks < 2; ++ks) qf[ks] = *(const bf16x8*)(p.na_q + (long)(tq0 + fr) * 1024 + hh * 64 + ks * 32 + fq * 8);
      int rstart = min(max(r - 4, 0), 8);
      int cq = wid * 16 + fr;
      int cstart = min(max(cq - 8, 0), 48);
      for (int jj = 0; jj < 8; ++jj) {
        int jr = rstart + jj;
        const u16* kp = p.na_k + (long)(TP + b * 1024 + jr * 64) * 1024 + hh * 64;
        const u16* vp = p.na_vT + (long)TP * 1024 + ((long)(b * 16 + hh) * 64) * 1024 + jr * 64;
        const float* rb = s_rpb + (jr - r + 7) * 31;
        attn64_tile(kp, vp, 1024, qf, o, l, fr, fq, [&](int n, int j, float s) -> float {
          int ck = n * 16 + fq * 4 + j;
          bool valid = (ck >= cstart) && (ck < cstart + 16);
          int coff = min(max(ck - cq + 15, 0), 30);
          float e = __expf(s + rb[coff]);
          return valid ? e : 0.f;
        });
      }
      for (int kt = 0; kt < 4; ++kt) {
        const u16* kp = p.ck_bf + ((long)(b * 2 + lj) * 256 + kt * 64) * 1024 + hh * 64;
        const u16* vp = p.cvt_bf + ((long)(b * 2 + lj) * 1024 + hh * 64) * 256 + kt * 64;
        attn64_tile(kp, vp, 256, qf, o, l, fr, fq, [&](int n, int j, float s) -> float { return __expf(s); });
      }
      __syncthreads();
    } else {
      int it = item - 1024;
      int b = it >> 6, qt = it & 3;
      hh = (it >> 2) & 15;
      tq0 = b * 256 + qt * 64 + wid * 16;
#pragma unroll
      for (int ks = 0; ks < 2; ++ks) qf[ks] = *(const bf16x8*)(p.na_q + (long)(tq0 + fr) * 1024 + hh * 64 + ks * 32 + fq * 8);
      for (int kt = 0; kt < 4; ++kt) {
        const u16* kp = p.na_k + (long)(b * 256 + kt * 64) * 1024 + hh * 64;
        const u16* vp = p.na_vT + ((long)(b * 16 + hh) * 64) * 256 + kt * 64;
        attn64_tile(kp, vp, 256, qf, o, l, fr, fq, [&](int n, int j, float s) -> float { return __expf(s); });
      }
    }
    l += __shfl_xor(l, 16);
    l += __shfl_xor(l, 32);
#pragma unroll
    for (int j = 0; j < 4; ++j) {
      float lq = __shfl(l, fq * 4 + j);
      float inv = 1.f / lq;
      int t = tq0 + fq * 4 + j;
#pragma unroll
      for (int dt = 0; dt < 4; ++dt) {
        long idx = (long)t * 1024 + hh * 64 + dt * 16 + fr;
        p.na_o[idx] = f2bf(o[dt][j] * inv * bf2f(p.na_sg[idx]));
      }
    }
  }
}

template <bool sample>
__device__ __forceinline__ void ret_main_item(const Params& p, int bh, int qt, char* smem) {
  const int tid = tidx();
  int lane = tid & 63;
  asm volatile("" : "+v"(lane));
  const int fr = lane & 15, fq = lane >> 4;
  const int wid = __builtin_amdgcn_readfirstlane(tid >> 6);
  const int dvh = wid & 1;
  constexpr int S = sample ? 1024 : 256;
  const int tok0 = sample ? TP + (bh >> 2) * 1024 : (bh >> 2) * 256;
  const int hh = bh & 3;
  const int qw = qt * 32 + (wid >> 1) * 16;
  const int qi = qw + fr;
  const float l2f = p.dec[hh], l2b = p.dec[4 + hh];
  const u16* vTb = (sample ? p.rt_vT + (long)TP * 2048 + (long)bh * 512 * 1024 : p.rt_vT + (long)bh * 512 * 256) + (long)dvh * 256 * S;
  const unsigned k_lane = fr * 1024 + fq * 8;
  const unsigned v_lane = fr * S + fq * 4;
  bf16x8* qlds = (bf16x8*)(smem + wid * 8192) + lane;
  {
    const u16* qg = p.rt_q + (long)(tok0 + qw) * 1024 + hh * 256;
#pragma unroll
    for (int ks = 0; ks < 8; ++ks) qlds[ks * 64] = *(const bf16x8*)(qg + ks * 32 + k_lane);
  }
  f32x4 o[16];
#pragma unroll
  for (int dt = 0; dt < 16; ++dt) o[dt] = f32x4{0.f, 0.f, 0.f, 0.f};
  for (int kt = 0; kt < S / 64; ++kt) {
    f32x4 s[4];
    const u16* kg = p.rt_k + (long)(tok0 + kt * 64) * 1024 + hh * 256;
#pragma unroll
    for (int n = 0; n < 4; ++n) {
      s[n] = f32x4{0.f, 0.f, 0.f, 0.f};
#pragma unroll
      for (int ks = 0; ks < 8; ++ks) {
        bf16x8 kf = *(const bf16x8*)(kg + n * 16 * 1024 + ks * 32 + k_lane);
        s[n] = MFMA16(kf, qlds[ks * 64], s[n]);
      }
    }
#pragma unroll
    for (int n = 0; n < 4; ++n)
#pragma unroll
      for (int j = 0; j < 4; ++j) {
        int d = qi - (kt * 64 + n * 16 + fq * 4 + j);
        float e = (d >= 0 ? l2f : l2b) * fabsf((float)d);
        float w = __builtin_amdgcn_exp2f(e);
        s[n][j] *= (d == 0 ? 2.0f : w);
      }
#pragma unroll
    for (int ks2 = 0; ks2 < 2; ++ks2) {
      bf16x8 pa = pack8(s[2 * ks2], s[2 * ks2 + 1]);
      const u16* vg = vTb + kt * 64 + ks2 * 32;
#pragma unroll
      for (int dt = 0; dt < 16; ++dt) {
        bf16x4 v0 = *(const bf16x4*)(vg + dt * 16 * S + v_lane);
        bf16x4 v1 = *(const bf16x4*)(vg + dt * 16 * S + 16 + v_lane);
        bf16x8 vb = __builtin_shufflevector(v0, v1, 0, 1, 2, 3, 4, 5, 6, 7);
        o[dt] = MFMA16(pa, vb, o[dt]);
      }
    }
  }
  if (sample) {
    const u16* qs = p.rt_qs + ((long)bh * 1024 + qw) * 512;
    const u16* sb = p.s0t + ((long)bh * 512 + dvh * 256) * 512;
    const unsigned i_lane = fr * 512 + fq * 8;
    for (int ks = 0; ks < 16; ++ks) {
      bf16x8 a = *(const bf16x8*)(qs + ks * 32 + i_lane);
#pragma unroll
      for (int dt = 0; dt < 16; ++dt) {
        bf16x8 b = *(const bf16x8*)(sb + dt * 16 * 512 + ks * 32 + i_lane);
        o[dt] = MFMA16(a, b, o[dt]);
      }
    }
  }
  float* s_st = (float*)(smem + 32768);
  float sm[4], sq[4];
#pragma unroll
  for (int j = 0; j < 4; ++j) {
    float a = 0.f, b = 0.f;
#pragma unroll
    for (int dt = 0; dt < 16; ++dt) { a += o[dt][j]; b += o[dt][j] * o[dt][j]; }
    a += __shfl_xor(a, 1); a += __shfl_xor(a, 2); a += __shfl_xor(a, 4); a += __shfl_xor(a, 8);
    b += __shfl_xor(b, 1); b += __shfl_xor(b, 2); b += __shfl_xor(b, 4); b += __shfl_xor(b, 8);
    sm[j] = a; sq[j] = b;
    if (fr == 0) { s_st[(wid * 16 + fq * 4 + j) * 2] = a; s_st[(wid * 16 + fq * 4 + j) * 2 + 1] = b; }
  }
  __syncthreads();
#pragma unroll
  for (int j = 0; j < 4; ++j) {
    float a = sm[j] + s_st[((wid ^ 1) * 16 + fq * 4 + j) * 2];
    float b = sq[j] + s_st[((wid ^ 1) * 16 + fq * 4 + j) * 2 + 1];
    float mean = a * (1.f / 512.f);
    float var = fmaxf(b * (1.f / 512.f) - mean * mean, 0.f);
    float rstd = rsqrtf(var + 1e-6f);
    const long rowu = (long)(tok0 + qw) * 2048 + hh * 512 + dvh * 256;
    const unsigned o_lane = (fq * 4 + j) * 2048 + fr;
    const float* gw = p.ret_gn_w + hh * 512 + dvh * 256;
#pragma unroll
    for (int dt = 0; dt < 16; ++dt) {
      float val = (o[dt][j] - mean) * rstd * gw[dt * 16 + fr] * bf2f(p.rt_sg[rowu + dt * 16 + o_lane]);
      p.rt_y[rowu + dt * 16 + o_lane] = f2bf(val);
    }
  }
  __syncthreads();
}

__device__ __forceinline__ void ret_state_item(const Params& p, int x, char* smem) {
  const int lane = tidx() & 63, wid = tidx() >> 6, wr = wid >> 1, wc = wid & 1, fr = lane & 15, fq = lane >> 4;
  int mat = x >> 3, tile = x & 7, tmm = tile >> 2, tnn = tile & 3;
  f32x4 acc[4][4];
  gemm_core(p.rt_kT + ((long)mat * 256 + tmm * 128) * 256, 256, p.rt_vT + ((long)(mat >> 1) * 512 + tnn * 128) * 256, 256, 256, smem, acc);
  int bh = mat >> 1, dir = mat & 1, b = bh >> 2, hh = bh & 3;
  float* outb = p.new_ret + ((long)((b * 2 + dir) * 4 + hh) * 256) * 512;
#pragma unroll
  for (int m = 0; m < 4; ++m)
#pragma unroll
    for (int j = 0; j < 4; ++j) {
      int dk = tmm * 128 + wr * 64 + m * 16 + fq * 4 + j;
#pragma unroll
      for (int n = 0; n < 4; ++n) outb[(long)dk * 512 + tnn * 128 + wc * 64 + n * 16 + fr] = acc[m][n][j];
    }
}

__device__ __forceinline__ void ret_phase(const Params& p, char* smem) {
  for (int it = blockIdx.x; it < 3584; it += gridDim.x) {
    if (it < 512) ret_main_item<true>(p, it >> 5, it & 31, smem);
    else if (it < 1536) { int x = it - 512; ret_main_item<false>(p, x >> 3, x & 7, smem); }
    else ret_state_item(p, it - 1536, smem);
  }
}

__device__ __forceinline__ void mlp_spatial_phase(const Params& p, char* smem) {
  float* s_mu = (float*)smem;
  float* s_rs = s_mu + 128;
  const int tid = tidx(), lane = tid & 63, wid = tid >> 6, wr = wid >> 1, wc = wid & 1, fr = lane & 15, fq = lane >> 4;
  for (int item = blockIdx.x; item < 1536; item += gridDim.x) {
    int chunk = item >> 4, g = (item >> 1) & 7, dh = item & 1;
    if (tid < 128) {
      const float4* st = (const float4*)(p.ml_st + ((long)(chunk * 128 + tid) * 32) * 2);
      float a = 0.f, b = 0.f;
#pragma unroll
      for (int i = 0; i < 16; ++i) { float4 v = st[i]; a += v.x + v.z; b += v.y + v.w; }
      float mu = a * (1.f / 2048.f);
      float var = b * (1.f / 2048.f) - mu * mu;
      s_mu[tid] = mu;
      s_rs[tid] = rsqrtf(fmaxf(var, 0.f) + 1e-6f);
    }
    __syncthreads();
    f32x4 acc[4][4];
#pragma unroll
    for (int m = 0; m < 4; ++m)
#pragma unroll
      for (int n = 0; n < 4; ++n) acc[m][n] = f32x4{0.f, 0.f, 0.f, 0.f};
    const int cb = g * 256 + dh * 128 + wc * 64;
    float lw[4], lb[4];
#pragma unroll
    for (int n = 0; n < 4; ++n) { lw[n] = p.mlp_ln_w[cb + n * 16 + fr]; lb[n] = p.mlp_ln_b[cb + n * 16 + fr]; }
#pragma unroll
    for (int ks = 0; ks < 4; ++ks) {
      bf16x8 af[4], bfr[4];
#pragma unroll
      for (int m = 0; m < 4; ++m)
        af[m] = *(const bf16x8*)(p.ws_bf + ((long)g * 128 + wr * 64 + m * 16 + fr) * 128 + ks * 32 + fq * 8);
      float mu[8], rs[8];
#pragma unroll
      for (int e = 0; e < 8; ++e) { mu[e] = s_mu[ks * 32 + fq * 8 + e]; rs[e] = s_rs[ks * 32 + fq * 8 + e]; }
#pragma unroll
      for (int n = 0; n < 4; ++n) {
        bf16x8 raw = *(const bf16x8*)(p.ml_vT + ((long)chunk * 2048 + cb + n * 16 + fr) * 128 + ks * 32 + fq * 8);
        bf16x8 nv;
#pragma unroll
        for (int e = 0; e < 8; ++e) nv[e] = (short)f2bf((bf2f((u16)raw[e]) - mu[e]) * rs[e] * lw[n] + lb[n]);
        bfr[n] = nv;
      }
#pragma unroll
      for (int m = 0; m < 4; ++m)
#pragma unroll
        for (int n = 0; n < 4; ++n) acc[m][n] = MFMA16(af[m], bfr[n], acc[m][n]);
    }
#pragma unroll
    for (int m = 0; m < 4; ++m)
#pragma unroll
      for (int j = 0; j < 4; ++j) {
        int i = wr * 64 + m * 16 + fq * 4 + j;
        float bs = p.mlp_b_s[g * 128 + i];
        long rowb = (long)(chunk * 128 + i) * 2048;
#pragma unroll
        for (int n = 0; n < 4; ++n) {
          long idx = rowb + cb + n * 16 + fr;
          float sv = acc[m][n][j] + bs;
          p.ml_o[idx] = f2bf(bf2f(p.ml_gu[idx]) * sv * bf2f(p.ml_sg[idx]));
        }
      }
    __syncthreads();
  }
}

__device__ __forceinline__ void run_phase(const Params& p, int ph, char* smem) {
  if (ph == 0) { prep_phase(p, smem); return; }
  const int layer = (ph - 1) >> 2, sub = (ph - 1) & 3;
  const int kind = layer % 3, lj = layer / 3;
  const float* xp = layer == 0 ? p.x_prompt : p.X;
  const float* xs = layer == 0 ? p.x_sample : p.X + (long)TP * 1024;
  float* xout = layer == 3 ? p.y_out : p.X;
  if (sub == 0) { norm_phase(p, layer, xp, xs); return; }
  if (sub == 1) {
    if (kind == 0) {
      const u16* W = p.wt_na_in + (long)lj * 4096 * 1024;
      for (int t = blockIdx.x; t < 96 * 32; t += gridDim.x) {
        int tn = t & 31, tm = t >> 5;
        f32x4 acc[4][4];
        gemm_core(p.h + (long)tm * 128 * 1024, 1024, W + (long)tn * 128 * 1024, 1024, 1024, smem, acc);
        epi_na_in(p, lj, tm, tn, acc);
      }
    } else {
      const u16* W = kind == 1 ? p.wt_ret_in : p.wt_mlp_in;
      for (int t = blockIdx.x; t < 96 * 48; t += gridDim.x) {
        int tn = t % 48, tm = t / 48;
        f32x4 acc[4][4];
        gemm_core(p.h + (long)tm * 128 * 1024, 1024, W + (long)tn * 128 * 1024, 1024, 1024, smem, acc);
        if (kind == 1) epi_ret_in(p, tm, tn, acc); else epi_mlp_in(p, tm, tn, acc);
      }
    }
    return;
  }
  if (sub == 2) {
    if (kind == 0) na_attn_phase(p, lj, smem);
    else if (kind == 1) ret_phase(p, smem);
    else mlp_spatial_phase(p, smem);
    return;
  }
  {
    const u16* A; const u16* W; int K;
    if (kind == 0) { A = p.na_o; W = p.wt_na_out + (long)lj * 1024 * 1024; K = 1024; }
    else if (kind == 1) { A = p.rt_y; W = p.wt_ret_out; K = 2048; }
    else { A = p.ml_o; W = p.wt_mlp_out; K = 2048; }
    for (int t = blockIdx.x; t < 96 * 8; t += gridDim.x) {
      int tn = t & 7, tm = t >> 3;
      f32x4 acc[4][4];
      gemm_core(A + (long)tm * 128 * K, K, W + (long)tn * 128 * K, K, K, smem, acc);
      epi_resid(p, layer, xp, xs, xout, tm, tn, acc);
    }
  }
}

#define NPHASE 17

__global__ void __launch_bounds__(256, 2) mega_kernel(Params p) {
  __shared__ __attribute__((aligned(16))) char smem[65536];
  cg::grid_group grid = cg::this_grid();
#pragma nounroll
  for (int ph = 0; ph < NPHASE; ++ph) {
    int phv = ph;
    asm volatile("" : "+s"(phv));
    run_phase(p, phv, smem);
    if (ph + 1 < NPHASE) grid.sync();
  }
}

__global__ void __launch_bounds__(256, 2) phase_kernel(Params p, int ph) {
  __shared__ __attribute__((aligned(16))) char smem[65536];
  run_phase(p, ph, smem);
}

#ifndef MULTI_LAUNCH
#define MULTI_LAUNCH 0
#endif

extern "C" void kernel_launch(void* const* d_in, const int* in_sizes, int n_in, void* d_out, int out_size, void* d_ws,
                              size_t ws_size, hipStream_t stream) {
  Params p{};
  p.x_prompt = (const float*)d_in[0];  p.x_sample = (const float*)d_in[1];
  p.cache_k = (const float*)d_in[2];   p.cache_v = (const float*)d_in[3];
  p.state_ret = (const float*)d_in[4]; p.c = (const float*)d_in[5];
  p.c_ctx = (const float*)d_in[6];     p.norm_w = (const float*)d_in[7];
  p.w_ada = (const float*)d_in[8];     p.b_ada = (const float*)d_in[9];
  p.na_w_in = (const float*)d_in[10];  p.na_w_out = (const float*)d_in[11];
  p.na_q_gain = (const float*)d_in[12]; p.na_k_gain = (const float*)d_in[13];
  p.na_rpb = (const float*)d_in[14];
  p.ret_w_in = (const float*)d_in[15]; p.ret_w_out = (const float*)d_in[16];
  p.ret_decay = (const float*)d_in[17]; p.ret_gn_w = (const float*)d_in[18];
  p.mlp_w_in = (const float*)d_in[19]; p.mlp_ln_w = (const float*)d_in[20];
  p.mlp_ln_b = (const float*)d_in[21]; p.mlp_w_s = (const float*)d_in[22];
  p.mlp_b_s = (const float*)d_in[23];  p.mlp_w_out = (const float*)d_in[24];
  float* out = (float*)d_out;
  p.y_out = out;
  p.new_k = out + (long)TT * 1024;
  p.new_v = p.new_k + (long)32 * 2 * 256 * 1024;
  p.new_ret = p.new_v + (long)32 * 2 * 256 * 1024;

  char* w = (char*)d_ws;
  size_t off = 0;
  auto take = [&](size_t bytes) { char* r = w + off; off += (bytes + 255) & ~(size_t)255; return r; };
  p.wt_na_in = (u16*)take((size_t)2 * 4096 * 1024 * 2);
  p.wt_na_out = (u16*)take((size_t)2 * 1024 * 1024 * 2);
  p.wt_ret_in = (u16*)take((size_t)6144 * 1024 * 2);
  p.wt_ret_out = (u16*)take((size_t)1024 * 2048 * 2);
  p.wt_mlp_in = (u16*)take((size_t)6144 * 1024 * 2);
  p.wt_mlp_out = (u16*)take((size_t)1024 * 2048 * 2);
  p.ws_bf = (u16*)take((size_t)8 * 128 * 128 * 2);
  p.ck_bf = (u16*)take((size_t)4 * 2 * 256 * 1024 * 2);
  p.cvt_bf = (u16*)take((size_t)4 * 2 * 256 * 1024 * 2);
  p.s0t = (u16*)take((size_t)16 * 512 * 512 * 2);
  p.mod = (float*)take((size_t)4 * 5 * 3072 * 4);
  p.ropetab = (float*)take((size_t)4096 * 2 * 4);
  p.dec = (float*)take(256);
  p.X = (float*)take((size_t)TT * 1024 * 4);
  p.h = (u16*)take((size_t)TT * 1024 * 2);
  size_t region = off;
  p.na_q = (u16*)take((size_t)TT * 1024 * 2);
  p.na_k = (u16*)take((size_t)TT * 1024 * 2);
  p.na_vT = (u16*)take((size_t)TT * 1024 * 2);
  p.na_sg = (u16*)take((size_t)TT * 1024 * 2);
  p.na_o = (u16*)take((size_t)TT * 1024 * 2);
  off = region;
  p.rt_q = (u16*)take((size_t)TT * 1024 * 2);
  p.rt_k = (u16*)take((size_t)TT * 1024 * 2);
  p.rt_qs = (u16*)take((size_t)16 * 1024 * 512 * 2);
  p.rt_kT = (u16*)take((size_t)256 * 256 * 256 * 2);
  p.rt_vT = (u16*)take((size_t)TT * 2048 * 2);
  p.rt_sg = (u16*)take((size_t)TT * 2048 * 2);
  p.rt_y = (u16*)take((size_t)TT * 2048 * 2);
  off = region;
  p.ml_gu = (u16*)take((size_t)TT * 2048 * 2);
  p.ml_vT = (u16*)take((size_t)TT * 2048 * 2);
  p.ml_sg = (u16*)take((size_t)TT * 2048 * 2);
  p.ml_o = (u16*)take((size_t)TT * 2048 * 2);
  p.ml_st = (float*)take((size_t)TT * 64 * 4);

#if MULTI_LAUNCH
  for (int ph = 0; ph < NPHASE; ++ph) phase_kernel<<<dim3(1024), dim3(256), 0, stream>>>(p, ph);
#else
  static int grid_blocks = 0;
  if (!grid_blocks) {
    int dev = 0, cus = 0, per_cu = 0;
    hipGetDevice(&dev);
    hipDeviceGetAttribute(&cus, hipDeviceAttributeMultiprocessorCount, dev);
    hipOccupancyMaxActiveBlocksPerMultiprocessor(&per_cu, mega_kernel, 256, 0);
    if (per_cu > 2) per_cu = 2;
    if (per_cu < 1) per_cu = 1;
    grid_blocks = cus * per_cu;
  }
  void* args[] = {&p};
  hipError_t e = hipLaunchCooperativeKernel((void*)mega_kernel, dim3(grid_blocks), dim3(256), args, 0, stream);
  if (e != hipSuccess) fprintf(stderr, "cooperative launch failed: %s (grid %d)\n", hipGetErrorString(e), grid_blocks);
#endif
}
```

```cpp
#include <hip/hip_runtime.h>
#include <hip/hip_cooperative_groups.h>
#include <cstdio>
namespace cg = cooperative_groups;

typedef unsigned short u16;
using bf16x8 = __attribute__((ext_vector_type(8))) short;
using bf16x4 = __attribute__((ext_vector_type(4))) short;
using f32x4  = __attribute__((ext_vector_type(4))) float;

#define TP 8192
#define TS 4096
#define TT 12288

struct Params {
  const float *x_prompt, *x_sample, *cache_k, *cache_v, *state_ret, *c, *c_ctx, *norm_w, *w_ada, *b_ada;
  const float *na_w_in, *na_w_out, *na_q_gain, *na_k_gain, *na_rpb;
  const float *ret_w_in, *ret_w_out, *ret_decay, *ret_gn_w;
  const float *mlp_w_in, *mlp_ln_w, *mlp_ln_b, *mlp_w_s, *mlp_b_s, *mlp_w_out;
  float *y_out, *new_k, *new_v, *new_ret;
  u16 *wt_na_in, *wt_na_out, *wt_ret_in, *wt_ret_out, *wt_mlp_in, *wt_mlp_out, *ws_bf, *ck_bf, *cvt_bf, *s0t;
  float *mod, *ropetab, *dec, *X;
  u16 *h;
  u16 *na_q, *na_k, *na_vT, *na_sg, *na_o;
  u16 *rt_q, *rt_k, *rt_qs, *rt_kT, *rt_vT, *rt_sg, *rt_y;
  u16 *ml_gu, *ml_vT, *ml_sg, *ml_o;
  float *ml_st;
  unsigned *bar;
};

__device__ __forceinline__ u16 f2bf(float f) {
  unsigned u = __float_as_uint(f);
  u += 0x7fffu + ((u >> 16) & 1u);
  return (u16)(u >> 16);
}
__device__ __forceinline__ float bf2f(u16 h) { return __uint_as_float(((unsigned)h) << 16); }
__device__ __forceinline__ unsigned pk2(float a, float b) { return (unsigned)f2bf(a) | ((unsigned)f2bf(b) << 16); }
__device__ __forceinline__ bf16x8 pack8(f32x4 a, f32x4 b) {
  bf16x8 r;
  r[0] = (short)f2bf(a[0]); r[1] = (short)f2bf(a[1]); r[2] = (short)f2bf(a[2]); r[3] = (short)f2bf(a[3]);
  r[4] = (short)f2bf(b[0]); r[5] = (short)f2bf(b[1]); r[6] = (short)f2bf(b[2]); r[7] = (short)f2bf(b[3]);
  return r;
}
__device__ __forceinline__ void store4bf(u16* dst, float a, float b, float c, float d) {
  uint2 v; v.x = pk2(a, b); v.y = pk2(c, d);
  *(uint2*)dst = v;
}
__device__ __forceinline__ float silu_f(float x) { return x / (1.f + __expf(-x)); }
__device__ __forceinline__ float gelu_f(float x) {
  float z = 0.7978845608028654f * (x + 0.044715f * x * x * x);
  float t = 1.f - 2.f / (__expf(2.f * z) + 1.f);
  return 0.5f * x * (1.f + t);
}
__device__ __forceinline__ int tidx() { int t = threadIdx.x; asm volatile("" : "+v"(t)); return t; }
#define MFMA16(a, b, c) __builtin_amdgcn_mfma_f32_16x16x32_bf16((a), (b), (c), 0, 0, 0)

__device__ __forceinline__ void gemm_core(const u16* __restrict__ A, long lda, const u16* __restrict__ B, long ldb,
                                          int K, char* smem, f32x4 (&acc)[4][4]) {
  const int tid = tidx(), lane = tid & 63, wid = tid >> 6, wr = wid >> 1, wc = wid & 1, fr = lane & 15, fq = lane >> 4;
#pragma unroll
  for (int m = 0; m < 4; ++m)
#pragma unroll
    for (int n = 0; n < 4; ++n) acc[m][n] = f32x4{0.f, 0.f, 0.f, 0.f};
  const int nk = K >> 6;
  auto stage = [&](int kt, int b) {
#pragma unroll
    for (int i = 0; i < 4; ++i) {
      int s = tid + i * 256;
      int r = s >> 3, cp = s & 7, c = cp ^ ((r >> 1) & 7);
      __builtin_amdgcn_global_load_lds((const unsigned*)(A + (long)r * lda + kt * 64 + c * 8),
                                       (__attribute__((address_space(3))) unsigned*)(smem + b * 32768 + s * 16), 16, 0, 0);
      __builtin_amdgcn_global_load_lds((const unsigned*)(B + (long)r * ldb + kt * 64 + c * 8),
                                       (__attribute__((address_space(3))) unsigned*)(smem + b * 32768 + 16384 + s * 16), 16, 0, 0);
    }
  };
  stage(0, 0);
  for (int t = 0; t < nk; ++t) {
    asm volatile("s_waitcnt vmcnt(0)" ::: "memory");
    __syncthreads();
    if (t + 1 < nk) stage(t + 1, (t + 1) & 1);
    const char* sa = smem + (t & 1) * 32768;
    const char* sb = sa + 16384;
#pragma unroll
    for (int ks = 0; ks < 2; ++ks) {
      bf16x8 af[4], bfr[4];
#pragma unroll
      for (int m = 0; m < 4; ++m) {
        int r = wr * 64 + m * 16 + fr;
        af[m] = *(const bf16x8*)(sa + (r * 8 + ((ks * 4 + fq) ^ ((r >> 1) & 7))) * 16);
      }
#pragma unroll
      for (int n = 0; n < 4; ++n) {
        int r = wc * 64 + n * 16 + fr;
        bfr[n] = *(const bf16x8*)(sb + (r * 8 + ((ks * 4 + fq) ^ ((r >> 1) & 7))) * 16);
      }
#pragma unroll
      for (int m = 0; m < 4; ++m)
#pragma unroll
        for (int n = 0; n < 4; ++n) acc[m][n] = MFMA16(af[m], bfr[n], acc[m][n]);
    }
  }
  __syncthreads();
}

__device__ __forceinline__ void adaln_item(const Params& p, int it, char* smem) {
  const int tid = tidx();
  int layer = it / 48, n0 = (it % 48) * 64;
  float* s_c = (float*)smem;
  float* s_p = s_c + 5120;
  for (int idx = tid; idx < 5120; idx += 256) {
    int v = idx >> 10, kk = idx & 1023;
    float cv = (v == 0) ? p.c_ctx[kk] : p.c[(v - 1) * 1024 + kk];
    s_c[idx] = silu_f(cv);
  }
  __syncthreads();
  int cl = tid & 15, ksl = tid >> 4;
  const float* w = p.w_ada + (long)layer * 1024 * 3072 + n0 + cl * 4;
  float4 a0 = {0, 0, 0, 0}, a1 = a0, a2 = a0, a3 = a0, a4 = a0;
#pragma unroll 8
  for (int kk = 0; kk < 64; ++kk) {
    int k = ksl * 64 + kk;
    float4 w4 = *(const float4*)(w + (long)k * 3072);
    float c0 = s_c[k], c1 = s_c[1024 + k], c2 = s_c[2048 + k], c3 = s_c[3072 + k], c4 = s_c[4096 + k];
    a0.x += c0 * w4.x; a0.y += c0 * w4.y; a0.z += c0 * w4.z; a0.w += c0 * w4.w;
    a1.x += c1 * w4.x; a1.y += c1 * w4.y; a1.z += c1 * w4.z; a1.w += c1 * w4.w;
    a2.x += c2 * w4.x; a2.y += c2 * w4.y; a2.z += c2 * w4.z; a2.w += c2 * w4.w;
    a3.x += c3 * w4.x; a3.y += c3 * w4.y; a3.z += c3 * w4.z; a3.w += c3 * w4.w;
    a4.x += c4 * w4.x; a4.y += c4 * w4.y; a4.z += c4 * w4.z; a4.w += c4 * w4.w;
  }
  *(float4*)(s_p + (ksl * 5 + 0) * 64 + cl * 4) = a0;
  *(float4*)(s_p + (ksl * 5 + 1) * 64 + cl * 4) = a1;
  *(float4*)(s_p + (ksl * 5 + 2) * 64 + cl * 4) = a2;
  *(float4*)(s_p + (ksl * 5 + 3) * 64 + cl * 4) = a3;
  *(float4*)(s_p + (ksl * 5 + 4) * 64 + cl * 4) = a4;
  __syncthreads();
  for (int o = tid; o < 320; o += 256) {
    int v = o >> 6, col = o & 63;
    float s = p.b_ada[layer * 3072 + n0 + col];
#pragma unroll
    for (int k2 = 0; k2 < 16; ++k2) s += s_p[(k2 * 5 + v) * 64 + col];
    p.mod[(layer * 5 + v) * 3072 + n0 + col] = s;
  }
  __syncthreads();
}

__device__ __forceinline__ void tr_tile(const float* __restrict__ src, long ld_src, u16* __restrict__ dst, long ld_dst,
                        int r0, int c0, int perm, char* smem) {
  float* tile = (float*)smem;
  const int tid = tidx();
  {
    int cc = tid & 63;
    int pcol = c0 + cc;
    int scol = pcol;
    if (perm) {
      int blk = pcol & ~127, w = pcol & 127;
      int r = w & 63;
      scol = blk + (r >> 5) * 64 + (w >> 6) * 32 + (r & 31);
    }
#pragma unroll
    for (int i = 0; i < 16; ++i) {
      int rr = (tid >> 6) + i * 4;
      tile[rr * 65 + cc] = src[(long)(r0 + rr) * ld_src + scol];
    }
  }
  __syncthreads();
  {
    int rr = tid & 63;
#pragma unroll
    for (int i = 0; i < 16; ++i) {
      int pp = (tid >> 6) + i * 4;
      dst[(long)(c0 + pp) * ld_dst + r0 + rr] = f2bf(tile[rr * 65 + pp]);
    }
  }
  __syncthreads();
}

__device__ __forceinline__ void tr_item(const Params& p, int x, char* smem) {
  if (x < 2048) {
    int bt = x >> 10, tt = x & 1023, rt = tt & 15, ct = tt >> 4;
    tr_tile(p.na_w_in + (long)bt * 1024 * 4096, 4096, p.wt_na_in + (long)bt * 4096 * 1024, 1024, rt * 64, ct * 64, 0, smem);
    return;
  }
  x -= 2048;
  if (x < 512) {
    int bt = x >> 8, tt = x & 255, rt = tt & 15, ct = tt >> 4;
    tr_tile(p.na_w_out + (long)bt * 1024 * 1024, 1024, p.wt_na_out + (long)bt * 1024 * 1024, 1024, rt * 64, ct * 64, 0, smem);
    return;
  }
  x -= 512;
  if (x < 1536) {
    int rt = x & 15, ct = x >> 4;
    tr_tile(p.ret_w_in, 6144, p.wt_ret_in, 1024, rt * 64, ct * 64, ct < 32 ? 1 : 0, smem);
    return;
  }
  x -= 1536;
  if (x < 512) {
    int rt = x & 31, ct = x >> 5;
    tr_tile(p.ret_w_out, 1024, p.wt_ret_out, 2048, rt * 64, ct * 64, 0, smem);
    return;
  }
  x -= 512;
  if (x < 1536) {
    int rt = x & 15, ct = x >> 4;
    tr_tile(p.mlp_w_in, 6144, p.wt_mlp_in, 1024, rt * 64, ct * 64, 0, smem);
    return;
  }
  x -= 1536;
  if (x < 512) {
    int rt = x & 31, ct = x >> 5;
    tr_tile(p.mlp_w_out, 1024, p.wt_mlp_out, 2048, rt * 64, ct * 64, 0, smem);
    return;
  }
  x -= 512;
  if (x < 512) {
    int bt = x >> 6, tt = x & 63, rt = tt & 3, ct = tt >> 2;
    tr_tile(p.cache_v + (long)bt * 262144, 1024, p.cvt_bf + (long)bt * 262144, 256, rt * 64, ct * 64, 0, smem);
    return;
  }
  x -= 512;
  {
    int bt = x >> 5, tt = x & 31, rt = tt & 3, ct = tt >> 2;
    int b = bt >> 3, dir = (bt >> 2) & 1, hh = bt & 3;
    tr_tile(p.state_ret + (long)bt * 131072, 512, p.s0t + (long)(b * 4 + hh) * 262144 + dir * 256, 512, rt * 64, ct * 64, 0, smem);
  }
}

__device__ __forceinline__ void cv_item(const Params& p, int it) {
  const int tid = tidx();
  const float* src; u16* dst; long base;
  if (it < 2048) { src = p.cache_k; dst = p.ck_bf; base = (long)it * 1024 + tid * 4; }
  else { src = p.mlp_w_s; dst = p.ws_bf; base = (long)(it - 2048) * 1024 + tid * 4; }
  float4 v = *(const float4*)(src + base);
  store4bf(dst + base, v.x, v.y, v.z, v.w);
}

__device__ __forceinline__ void misc_item(const Params& p) {
  const int tid = tidx();
  for (int idx = tid; idx < 4096; idx += 256) {
    int pos = idx >> 6, i = idx & 63;
    float inv = exp2f(-(float)i * (13.287712379549449f / 64.f));
    float ang = (float)pos * inv;
    p.ropetab[2 * idx] = cosf(ang);
    p.ropetab[2 * idx + 1] = sinf(ang);
  }
  if (tid < 8) {
    float x = p.ret_decay[tid];
    float lg = -log1pf(expf(-x));
    p.dec[tid] = lg * 1.4426950408889634f;
  }
}

__device__ __forceinline__ void prep_phase(const Params& p, char* smem) {
  const int NADA = 192, NTR = 8192, NCV = 2176;
  for (int it = blockIdx.x; it < NADA + NTR + NCV + 1; it += gridDim.x) {
    if (it < NADA) adaln_item(p, it, smem);
    else if (it < NADA + NTR) tr_item(p, it - NADA, smem);
    else if (it < NADA + NTR + NCV) cv_item(p, it - NADA - NTR);
    else misc_item(p);
  }
}

__device__ __forceinline__ void norm_phase(const Params& p, int layer, const float* xp, const float* xs) {
  const int wave = tidx() >> 6, lane = tidx() & 63;
  const float* nw = p.norm_w + layer * 1024;
  for (int row = blockIdx.x * 4 + wave; row < TT; row += gridDim.x * 4) {
    const float* x = row < TP ? xp + (long)row * 1024 : xs + (long)(row - TP) * 1024;
    int mv = row < TP ? 0 : 1 + ((row - TP) >> 10);
    const float* md = p.mod + (long)(layer * 5 + mv) * 3072;
    float4 v[4];
    float ss = 0.f;
#pragma unroll
    for (int i = 0; i < 4; ++i) {
      v[i] = *(const float4*)(x + i * 256 + lane * 4);
      ss += v[i].x * v[i].x + v[i].y * v[i].y + v[i].z * v[i].z + v[i].w * v[i].w;
    }
#pragma unroll
    for (int o = 32; o > 0; o >>= 1) ss += __shfl_xor(ss, o);
    float r = rsqrtf(ss * (1.f / 1024.f) + 1e-6f);
#pragma unroll
    for (int i = 0; i < 4; ++i) {
      int c = i * 256 + lane * 4;
      float4 w4 = *(const float4*)(nw + c);
      float4 sh = *(const float4*)(md + c);
      float4 sc = *(const float4*)(md + 1024 + c);
      float o0 = (v[i].x * r * w4.x) * (1.f + sc.x) + sh.x;
      float o1 = (v[i].y * r * w4.y) * (1.f + sc.y) + sh.y;
      float o2 = (v[i].z * r * w4.z) * (1.f + sc.z) + sh.z;
      float o3 = (v[i].w * r * w4.w) * (1.f + sc.w) + sh.w;
      store4bf(p.h + (long)row * 1024 + c, o0, o1, o2, o3);
    }
  }
}

__device__ __forceinline__ void epi_resid(const Params& p, int layer, const float* xp, const float* xs, float* xout,
                                          int tm, int tn, f32x4 (&acc)[4][4]) {
  const int lane = tidx() & 63, wid = tidx() >> 6, wr = wid >> 1, wc = wid & 1, fr = lane & 15, fq = lane >> 4;
  int mv = tm < 64 ? 0 : 1 + ((tm - 64) >> 3);
  const float* gate = p.mod + (long)(layer * 5 + mv) * 3072 + 2048;
#pragma unroll
  for (int n = 0; n < 4; ++n) {
    int col = tn * 128 + wc * 64 + n * 16 + fr;
    float g = gate[col];
#pragma unroll
    for (int m = 0; m < 4; ++m)
#pragma unroll
      for (int j = 0; j < 4; ++j) {
        int t = tm * 128 + wr * 64 + m * 16 + fq * 4 + j;
        float xin = t < TP ? xp[(long)t * 1024 + col] : xs[(long)(t - TP) * 1024 + col];
        xout[(long)t * 1024 + col] = xin + g * acc[m][n][j];
      }
  }
}

__device__ __forceinline__ void epi_na_in(const Params& p, int lj, int tm, int tn, f32x4 (&acc)[4][4]) {
  const int lane = tidx() & 63, wid = tidx() >> 6, wr = wid >> 1, wc = wid & 1, fr = lane & 15, fq = lane >> 4;
  const int sec = tn >> 3;
  const int cbase = (tn & 7) * 128 + wc * 64;
  const int head = cbase >> 6;
  const int row0 = tm * 128 + wr * 64;
  if (sec <= 1) {
    const float* gain = (sec == 0 ? p.na_q_gain : p.na_k_gain) + lj * 64;
    float g[4];
#pragma unroll
    for (int n = 0; n < 4; ++n) g[n] = gain[n * 16 + fr];
#pragma unroll
    for (int m = 0; m < 4; ++m)
#pragma unroll
      for (int j = 0; j < 4; ++j) {
        float ss = 0.f;
#pragma unroll
        for (int n = 0; n < 4; ++n) ss += acc[m][n][j] * acc[m][n][j];
        ss += __shfl_xor(ss, 1); ss += __shfl_xor(ss, 2); ss += __shfl_xor(ss, 4); ss += __shfl_xor(ss, 8);
        float r = rsqrtf(ss * (1.f / 64.f) + 1e-6f);
        int t = row0 + m * 16 + fq * 4 + j;
#pragma unroll
        for (int n = 0; n < 4; ++n) {
          int col = cbase + n * 16 + fr;
          float val = acc[m][n][j] * r * g[n];
          if (sec == 0) {
            p.na_q[(long)t * 1024 + col] = f2bf(val * 0.125f);
          } else {
            p.na_k[(long)t * 1024 + col] = f2bf(val);
            if (t < TP) p.new_k[((long)((t >> 8) * 2 + lj) * 256 + (t & 255)) * 1024 + col] = val;
          }
        }
      }
  } else if (sec == 2) {
#pragma unroll
    for (int m = 0; m < 4; ++m) {
      int t0 = row0 + m * 16 + fq * 4;
#pragma unroll
      for (int n = 0; n < 4; ++n) {
        int d = n * 16 + fr;
        f32x4 a = acc[m][n];
        if (t0 < TP) {
          int b = t0 >> 8, s = t0 & 255;
          store4bf(p.na_vT + ((long)(b * 16 + head) * 64 + d) * 256 + s, a[0], a[1], a[2], a[3]);
          float* nv = p.new_v + ((long)(b * 2 + lj) * 256 + s) * 1024 + head * 64 + d;
          nv[0] = a[0]; nv[1024] = a[1]; nv[2048] = a[2]; nv[3072] = a[3];
        } else {
          int ts = t0 - TP, b = ts >> 10, nn = ts & 1023;
          store4bf(p.na_vT + (long)TP * 1024 + ((long)(b * 16 + head) * 64 + d) * 1024 + nn, a[0], a[1], a[2], a[3]);
        }
      }
    }
  } else {
#pragma unroll
    for (int m = 0; m < 4; ++m)
#pragma unroll
      for (int j = 0; j < 4; ++j) {
        int t = row0 + m * 16 + fq * 4 + j;
#pragma unroll
        for (int n = 0; n < 4; ++n) p.na_sg[(long)t * 1024 + cbase + n * 16 + fr] = f2bf(silu_f(acc[m][n][j]));
      }
  }
}

__device__ __forceinline__ void epi_ret_in(const Params& p, int tm, int tn, f32x4 (&acc)[4][4]) {
  const int lane = tidx() & 63, wid = tidx() >> 6, wr = wid >> 1, wc = wid & 1, fr = lane & 15, fq = lane >> 4;
  const int row0 = tm * 128 + wr * 64;
  if (tn < 16) {
    const bool isk = tn >= 8;
    const int blk = tn & 7, hh = blk >> 1, half = blk & 1;
    const float l2f = p.dec[hh], l2b = p.dec[4 + hh];
    const bool sample = tm >= 64;
#pragma unroll
    for (int m = 0; m < 4; ++m) {
      float o1[2][4], o2[2][4];
      const int t0 = row0 + m * 16 + fq * 4;
#pragma unroll
      for (int j = 0; j < 4; ++j) {
        int t = t0 + j;
        int nn = (t - TP) & 1023;
        int pos = half == 0 ? (nn >> 6) : (nn & 63);
#pragma unroll
        for (int n2 = 0; n2 < 2; ++n2) {
          int i = wc * 32 + n2 * 16 + fr;
          float x1 = acc[m][n2][j], x2 = acc[m][n2 + 2][j];
          if (sample) {
            float2 cs = *(const float2*)(p.ropetab + 2 * (pos * 64 + i));
            o1[n2][j] = x1 * cs.x - x2 * cs.y;
            o2[n2][j] = x1 * cs.y + x2 * cs.x;
          } else { o1[n2][j] = x1; o2[n2][j] = x2; }
          if (isk) { o1[n2][j] *= 0.0625f; o2[n2][j] *= 0.0625f; }
        }
      }
#pragma unroll
      for (int j = 0; j < 4; ++j) {
        int t = t0 + j;
        u16* dst = (isk ? p.rt_k : p.rt_q) + (long)t * 1024 + hh * 256 + half * 128;
#pragma unroll
        for (int n2 = 0; n2 < 2; ++n2) {
          int i = wc * 32 + n2 * 16 + fr;
          dst[i] = f2bf(o1[n2][j]);
          dst[64 + i] = f2bf(o2[n2][j]);
        }
        if (!isk && sample) {
          int ts = t - TP, b = ts >> 10, nn = ts & 1023;
          float df = exp2f(l2f * (float)(nn + 1)), db = exp2f(l2b * (float)(1024 - nn));
          u16* qs = p.rt_qs + ((long)(b * 4 + hh) * 1024 + nn) * 512 + half * 128;
#pragma unroll
          for (int n2 = 0; n2 < 2; ++n2) {
            int i = wc * 32 + n2 * 16 + fr;
            qs[i] = f2bf(o1[n2][j] * df);
            qs[64 + i] = f2bf(o2[n2][j] * df);
            qs[256 + i] = f2bf(o1[n2][j] * db);
            qs[256 + 64 + i] = f2bf(o2[n2][j] * db);
          }
        }
      }
      if (isk && !sample) {
        int b = t0 >> 8, s = t0 & 255;
        float wf[4], wb[4];
#pragma unroll
        for (int j = 0; j < 4; ++j) { wf[j] = exp2f(l2f * (float)(255 - s - j)); wb[j] = exp2f(l2b * (float)(s + j)); }
#pragma unroll
        for (int n2 = 0; n2 < 2; ++n2) {
          int dk1 = half * 128 + wc * 32 + n2 * 16 + fr, dk2 = dk1 + 64;
          u16* kf = p.rt_kT + ((long)((b * 4 + hh) * 2 + 0) * 256) * 256 + s;
          u16* kb = p.rt_kT + ((long)((b * 4 + hh) * 2 + 1) * 256) * 256 + s;
          store4bf(kf + (long)dk1 * 256, o1[n2][0] * wf[0], o1[n2][1] * wf[1], o1[n2][2] * wf[2], o1[n2][3] * wf[3]);
          store4bf(kf + (long)dk2 * 256, o2[n2][0] * wf[0], o2[n2][1] * wf[1], o2[n2][2] * wf[2], o2[n2][3] * wf[3]);
          store4bf(kb + (long)dk1 * 256, o1[n2][0] * wb[0], o1[n2][1] * wb[1], o1[n2][2] * wb[2], o1[n2][3] * wb[3]);
          store4bf(kb + (long)dk2 * 256, o2[n2][0] * wb[0], o2[n2][1] * wb[1], o2[n2][2] * wb[2], o2[n2][3] * wb[3]);
        }
      }
    }
  } else if (tn < 32) {
#pragma unroll
    for (int m = 0; m < 4; ++m) {
      int t0 = row0 + m * 16 + fq * 4;
#pragma unroll
      for (int n = 0; n < 4; ++n) {
        int cv = (tn - 16) * 128 + wc * 64 + n * 16 + fr;
        int hh = cv >> 9, dv = cv & 511;
        f32x4 a = acc[m][n];
        if (t0 < TP) {
          int b = t0 >> 8, s = t0 & 255;
          store4bf(p.rt_vT + ((long)(b * 4 + hh) * 512 + dv) * 256 + s, a[0], a[1], a[2], a[3]);
        } else {
          int ts = t0 - TP, b = ts >> 10, nn = ts & 1023;
          store4bf(p.rt_vT + (long)TP * 2048 + ((long)(b * 4 + hh) * 512 + dv) * 1024 + nn, a[0], a[1], a[2], a[3]);
        }
      }
    }
  } else {
#pragma unroll
    for (int m = 0; m < 4; ++m)
#pragma unroll
      for (int j = 0; j < 4; ++j) {
        int t = row0 + m * 16 + fq * 4 + j;
#pragma unroll
        for (int n = 0; n < 4; ++n)
          p.rt_sg[(long)t * 2048 + (tn - 32) * 128 + wc * 64 + n * 16 + fr] = f2bf(silu_f(acc[m][n][j]));
      }
  }
}

__device__ __forceinline__ void epi_mlp_in(const Params& p, int tm, int tn, f32x4 (&acc)[4][4]) {
  const int lane = tidx() & 63, wid = tidx() >> 6, wr = wid >> 1, wc = wid & 1, fr = lane & 15, fq = lane >> 4;
  const int row0 = tm * 128 + wr * 64;
  if (tn < 16 || tn >= 32) {
    const bool isu = tn < 16;
    u16* dstb = isu ? p.ml_gu : p.ml_sg;
    const int c0 = (isu ? tn : tn - 32) * 128 + wc * 64;
#pragma unroll
    for (int m = 0; m < 4; ++m)
#pragma unroll
      for (int j = 0; j < 4; ++j) {
        int t = row0 + m * 16 + fq * 4 + j;
#pragma unroll
        for (int n = 0; n < 4; ++n) {
          float a = acc[m][n][j];
          dstb[(long)t * 2048 + c0 + n * 16 + fr] = f2bf(isu ? gelu_f(a) : silu_f(a));
        }
      }
  } else {
    const int c0 = (tn - 16) * 128 + wc * 64;
#pragma unroll
    for (int m = 0; m < 4; ++m) {
      float s1[4] = {0, 0, 0, 0}, s2[4] = {0, 0, 0, 0};
      int il = wr * 64 + m * 16 + fq * 4;
#pragma unroll
      for (int n = 0; n < 4; ++n) {
        float g0 = bf2f(f2bf(gelu_f(acc[m][n][0]))), g1 = bf2f(f2bf(gelu_f(acc[m][n][1])));
        float g2 = bf2f(f2bf(gelu_f(acc[m][n][2]))), g3 = bf2f(f2bf(gelu_f(acc[m][n][3])));
        s1[0] += g0; s1[1] += g1; s1[2] += g2; s1[3] += g3;
        s2[0] += g0 * g0; s2[1] += g1 * g1; s2[2] += g2 * g2; s2[3] += g3 * g3;
        store4bf(p.ml_vT + ((long)tm * 2048 + c0 + n * 16 + fr) * 128 + il, g0, g1, g2, g3);
      }
#pragma unroll
      for (int j = 0; j < 4; ++j) {
        float a = s1[j], b = s2[j];
        a += __shfl_xor(a, 1); a += __shfl_xor(a, 2); a += __shfl_xor(a, 4); a += __shfl_xor(a, 8);
        b += __shfl_xor(b, 1); b += __shfl_xor(b, 2); b += __shfl_xor(b, 4); b += __shfl_xor(b, 8);
        if (fr == 0) {
          int t = tm * 128 + il + j;
          float2 st; st.x = a; st.y = b;
          *(float2*)(p.ml_st + ((long)t * 32 + (tn - 16) * 2 + wc) * 2) = st;
        }
      }
    }
  }
}

template <class F>
__device__ __forceinline__ void attn64_tile(const u16* __restrict__ kp, const u16* __restrict__ vp, long vs,
                                            const bf16x8 (&qf)[2], f32x4 (&o)[4], float& l, int fr, int fq, F f) {
  f32x4 s[4];
#pragma unroll
  for (int n = 0; n < 4; ++n) {
    s[n] = f32x4{0.f, 0.f, 0.f, 0.f};
#pragma unroll
    for (int ks = 0; ks < 2; ++ks) {
      bf16x8 kf = *(const bf16x8*)(kp + (long)(n * 16 + fr) * 1024 + ks * 32 + fq * 8);
      s[n] = MFMA16(kf, qf[ks], s[n]);
    }
  }
#pragma unroll
  for (int n = 0; n < 4; ++n)
#pragma unroll
    for (int j = 0; j < 4; ++j) {
      float pv = f(n, j, s[n][j]);
      l += pv;
      s[n][j] = pv;
    }
#pragma unroll
  for (int ks2 = 0; ks2 < 2; ++ks2) {
    bf16x8 pa = pack8(s[2 * ks2], s[2 * ks2 + 1]);
#pragma unroll
    for (int dt = 0; dt < 4; ++dt) {
      const u16* vv = vp + (long)(dt * 16 + fr) * vs + fq * 4;
      bf16x4 v0 = *(const bf16x4*)(vv + (2 * ks2) * 16);
      bf16x4 v1 = *(const bf16x4*)(vv + (2 * ks2 + 1) * 16);
      bf16x8 vb = __builtin_shufflevector(v0, v1, 0, 1, 2, 3, 4, 5, 6, 7);
      o[dt] = MFMA16(pa, vb, o[dt]);
    }
  }
}

__device__ __forceinline__ void na_attn_phase(const Params& p, int lj, char* smem) {
  float* s_rpb = (float*)smem;
  const int tid = tidx(), lane = tid & 63, wid = tid >> 6, fr = lane & 15, fq = lane >> 4;
  for (int item = blockIdx.x; item < 3072; item += gridDim.x) {
    f32x4 o[4];
#pragma unroll
    for (int dt = 0; dt < 4; ++dt) o[dt] = f32x4{0.f, 0.f, 0.f, 0.f};
    float l = 0.f;
    bf16x8 qf[2];
    int tq0, hh;
    if (item < 1024) {
      int b = item >> 8, r = item & 15;
      hh = (item >> 4) & 15;
      const float* rp = p.na_rpb + (long)(lj * 16 + hh) * 465;
      for (int i = tid; i < 465; i += 256) s_rpb[i] = rp[i];
      __syncthreads();
      tq0 = TP + b * 1024 + r * 64 + wid * 16;
#pragma unroll
      for (int ks = 0; ks < 2; ++ks) qf[ks] = *(const bf16x8*)(p.na_q + (long)(tq0 + fr) * 1024 + hh * 64 + ks * 32 + fq * 8);
      int rstart = min(max(r - 4, 0), 8);
      int cq = wid * 16 + fr;
      int cstart = min(max(cq - 8, 0), 48);
      for (int jj = 0; jj < 8; ++jj) {
        int jr = rstart + jj;
        const u16* kp = p.na_k + (long)(TP + b * 1024 + jr * 64) * 1024 + hh * 64;
        const u16* vp = p.na_vT + (long)TP * 1024 + ((long)(b * 16 + hh) * 64) * 1024 + jr * 64;
        const float* rb = s_rpb + (jr - r + 7) * 31;
        attn64_tile(kp, vp, 1024, qf, o, l, fr, fq, [&](int n, int j, float s) -> float {
          int ck = n * 16 + fq * 4 + j;
          bool valid = (ck >= cstart) && (ck < cstart + 16);
          int coff = min(max(ck - cq + 15, 0), 30);
          float e = __expf(s + rb[coff]);
          return valid ? e : 0.f;
        });
      }
      for (int kt = 0; kt < 4; ++kt) {
        const u16* kp = p.ck_bf + ((long)(b * 2 + lj) * 256 + kt * 64) * 1024 + hh * 64;
        const u16* vp = p.cvt_bf + ((long)(b * 2 + lj) * 1024 + hh * 64) * 256 + kt * 64;
        attn64_tile(kp, vp, 256, qf, o, l, fr, fq, [&](int n, int j, float s) -> float { return __expf(s); });
      }
      __syncthreads();
    } else {
      int it = item - 1024;
      int b = it >> 6, qt = it & 3;
      hh = (it >> 2) & 15;
      tq0 = b * 256 + qt * 64 + wid * 16;
#pragma unroll
      for (int ks = 0; ks < 2; ++ks) qf[ks] = *(const bf16x8*)(p.na_q + (long)(tq0 + fr) * 1024 + hh * 64 + ks * 32 + fq * 8);
      for (int kt = 0; kt < 4; ++kt) {
        const u16* kp = p.na_k + (long)(b * 256 + kt * 64) * 1024 + hh * 64;
        const u16* vp = p.na_vT + ((long)(b * 16 + hh) * 64) * 256 + kt * 64;
        attn64_tile(kp, vp, 256, qf, o, l, fr, fq, [&](int n, int j, float s) -> float { return __expf(s); });
      }
    }
    l += __shfl_xor(l, 16);
    l += __shfl_xor(l, 32);
#pragma unroll
    for (int j = 0; j < 4; ++j) {
      float lq = __shfl(l, fq * 4 + j);
      float inv = 1.f / lq;
      int t = tq0 + fq * 4 + j;
#pragma unroll
      for (int dt = 0; dt < 4; ++dt) {
        long idx = (long)t * 1024 + hh * 64 + dt * 16 + fr;
        p.na_o[idx] = f2bf(o[dt][j] * inv * bf2f(p.na_sg[idx]));
      }
    }
  }
}

template <bool sample>
__device__ __forceinline__ void ret_main_item(const Params& p, int bh, int qt, char* smem) {
  const int tid = tidx();
  int lane = tid & 63;
  asm volatile("" : "+v"(lane));
  const int fr = lane & 15, fq = lane >> 4;
  const int wid = __builtin_amdgcn_readfirstlane(tid >> 6);
  const int dvh = wid & 1;
  constexpr int S = sample ? 1024 : 256;
  const int tok0 = sample ? TP + (bh >> 2) * 1024 : (bh >> 2) * 256;
  const int hh = bh & 3;
  const int qw = qt * 32 + (wid >> 1) * 16;
  const int qi = qw + fr;
  const float l2f = p.dec[hh], l2b = p.dec[4 + hh];
  const u16* vTb = (sample ? p.rt_vT + (long)TP * 2048 + (long)bh * 512 * 1024 : p.rt_vT + (long)bh * 512 * 256) + (long)dvh * 256 * S;
  const unsigned k_lane = fr * 1024 + fq * 8;
  const unsigned v_lane = fr * S + fq * 4;
  bf16x8* qlds = (bf16x8*)(smem + wid * 8192) + lane;
  {
    const u16* qg = p.rt_q + (long)(tok0 + qw) * 1024 + hh * 256;
#pragma unroll
    for (int ks = 0; ks < 8; ++ks) qlds[ks * 64] = *(const bf16x8*)(qg + ks * 32 + k_lane);
  }
  f32x4 o[16];
#pragma unroll
  for (int dt = 0; dt < 16; ++dt) o[dt] = f32x4{0.f, 0.f, 0.f, 0.f};
  for (int kt = 0; kt < S / 64; ++kt) {
    f32x4 s[4];
    const u16* kg = p.rt_k + (long)(tok0 + kt * 64) * 1024 + hh * 256;
#pragma unroll
    for (int n = 0; n < 4; ++n) {
      s[n] = f32x4{0.f, 0.f, 0.f, 0.f};
#pragma unroll
      for (int ks = 0; ks < 8; ++ks) {
        bf16x8 kf = *(const bf16x8*)(kg + n * 16 * 1024 + ks * 32 + k_lane);
        s[n] = MFMA16(kf, qlds[ks * 64], s[n]);
      }
    }
#pragma unroll
    for (int n = 0; n < 4; ++n)
#pragma unroll
      for (int j = 0; j < 4; ++j) {
        int d = qi - (kt * 64 + n * 16 + fq * 4 + j);
        float e = (d >= 0 ? l2f : l2b) * fabsf((float)d);
        float w = __builtin_amdgcn_exp2f(e);
        s[n][j] *= (d == 0 ? 2.0f : w);
      }
#pragma unroll
    for (int ks2 = 0; ks2 < 2; ++ks2) {
      bf16x8 pa = pack8(s[2 * ks2], s[2 * ks2 + 1]);
      const u16* vg = vTb + kt * 64 + ks2 * 32;
#pragma unroll
      for (int dt = 0; dt < 16; ++dt) {
        bf16x4 v0 = *(const bf16x4*)(vg + dt * 16 * S + v_lane);
        bf16x4 v1 = *(const bf16x4*)(vg + dt * 16 * S + 16 + v_lane);
        bf16x8 vb = __builtin_shufflevector(v0, v1, 0, 1, 2, 3, 4, 5, 6, 7);
        o[dt] = MFMA16(pa, vb, o[dt]);
      }
    }
  }
  if (sample) {
    const u16* qs = p.rt_qs + ((long)bh * 1024 + qw) * 512;
    const u16* sb = p.s0t + ((long)bh * 512 + dvh * 256) * 512;
    const unsigned i_lane = fr * 512 + fq * 8;
    for (int ks = 0; ks < 16; ++ks) {
      bf16x8 a = *(const bf16x8*)(qs + ks * 32 + i_lane);
#pragma unroll
      for (int dt = 0; dt < 16; ++dt) {
        bf16x8 b = *(const bf16x8*)(sb + dt * 16 * 512 + ks * 32 + i_lane);
        o[dt] = MFMA16(a, b, o[dt]);
      }
    }
  }
  float* s_st = (float*)(smem + 32768);
  float sm[4], sq[4];
#pragma unroll
  for (int j = 0; j < 4; ++j) {
    float a = 0.f, b = 0.f;
#pragma unroll
    for (int dt = 0; dt < 16; ++dt) { a += o[dt][j]; b += o[dt][j] * o[dt][j]; }
    a += __shfl_xor(a, 1); a += __shfl_xor(a, 2); a += __shfl_xor(a, 4); a += __shfl_xor(a, 8);
    b += __shfl_xor(b, 1); b += __shfl_xor(b, 2); b += __shfl_xor(b, 4); b += __shfl_xor(b, 8);
    sm[j] = a; sq[j] = b;
    if (fr == 0) { s_st[(wid * 16 + fq * 4 + j) * 2] = a; s_st[(wid * 16 + fq * 4 + j) * 2 + 1] = b; }
  }
  __syncthreads();
#pragma unroll
  for (int j = 0; j < 4; ++j) {
    float a = sm[j] + s_st[((wid ^ 1) * 16 + fq * 4 + j) * 2];
    float b = sq[j] + s_st[((wid ^ 1) * 16 + fq * 4 + j) * 2 + 1];
    float mean = a * (1.f / 512.f);
    float var = fmaxf(b * (1.f / 512.f) - mean * mean, 0.f);
    float rstd = rsqrtf(var + 1e-6f);
    const long rowu = (long)(tok0 + qw) * 2048 + hh * 512 + dvh * 256;
    const unsigned o_lane = (fq * 4 + j) * 2048 + fr;
    const float* gw = p.ret_gn_w + hh * 512 + dvh * 256;
#pragma unroll
    for (int dt = 0; dt < 16; ++dt) {
      float val = (o[dt][j] - mean) * rstd * gw[dt * 16 + fr] * bf2f(p.rt_sg[rowu + dt * 16 + o_lane]);
      p.rt_y[rowu + dt * 16 + o_lane] = f2bf(val);
    }
  }
  __syncthreads();
}

__device__ __forceinline__ void ret_state_item(const Params& p, int x, char* smem) {
  const int lane = tidx() & 63, wid = tidx() >> 6, wr = wid >> 1, wc = wid & 1, fr = lane & 15, fq = lane >> 4;
  int mat = x >> 3, tile = x & 7, tmm = tile >> 2, tnn = tile & 3;
  f32x4 acc[4][4];
  gemm_core(p.rt_kT + ((long)mat * 256 + tmm * 128) * 256, 256, p.rt_vT + ((long)(mat >> 1) * 512 + tnn * 128) * 256, 256, 256, smem, acc);
  int bh = mat >> 1, dir = mat & 1, b = bh >> 2, hh = bh & 3;
  float* outb = p.new_ret + ((long)((b * 2 + dir) * 4 + hh) * 256) * 512;
#pragma unroll
  for (int m = 0; m < 4; ++m)
#pragma unroll
    for (int j = 0; j < 4; ++j) {
      int dk = tmm * 128 + wr * 64 + m * 16 + fq * 4 + j;
#pragma unroll
      for (int n = 0; n < 4; ++n) outb[(long)dk * 512 + tnn * 128 + wc * 64 + n * 16 + fr] = acc[m][n][j];
    }
}

__device__ __forceinline__ void ret_phase(const Params& p, char* smem) {
  for (int it = blockIdx.x; it < 3584; it += gridDim.x) {
    if (it < 512) ret_main_item<true>(p, it >> 5, it & 31, smem);
    else if (it < 1536) { int x = it - 512; ret_main_item<false>(p, x >> 3, x & 7, smem); }
    else ret_state_item(p, it - 1536, smem);
  }
}

__device__ __forceinline__ void mlp_spatial_phase(const Params& p, char* smem) {
  float* s_mu = (float*)smem;
  float* s_rs = s_mu + 128;
  const int tid = tidx(), lane = tid & 63, wid = tid >> 6, wr = wid >> 1, wc = wid & 1, fr = lane & 15, fq = lane >> 4;
  for (int item = blockIdx.x; item < 1536; item += gridDim.x) {
    int chunk = item >> 4, g = (item >> 1) & 7, dh = item & 1;
    if (tid < 128) {
      const float4* st = (const float4*)(p.ml_st + ((long)(chunk * 128 + tid) * 32) * 2);
      float a = 0.f, b = 0.f;
#pragma unroll
      for (int i = 0; i < 16; ++i) { float4 v = st[i]; a += v.x + v.z; b += v.y + v.w; }
      float mu = a * (1.f / 2048.f);
      float var = b * (1.f / 2048.f) - mu * mu;
      s_mu[tid] = mu;
      s_rs[tid] = rsqrtf(fmaxf(var, 0.f) + 1e-6f);
    }
    __syncthreads();
    f32x4 acc[4][4];
#pragma unroll
    for (int m = 0; m < 4; ++m)
#pragma unroll
      for (int n = 0; n < 4; ++n) acc[m][n] = f32x4{0.f, 0.f, 0.f, 0.f};
    const int cb = g * 256 + dh * 128 + wc * 64;
    float lw[4], lb[4];
#pragma unroll
    for (int n = 0; n < 4; ++n) { lw[n] = p.mlp_ln_w[cb + n * 16 + fr]; lb[n] = p.mlp_ln_b[cb + n * 16 + fr]; }
#pragma unroll
    for (int ks = 0; ks < 4; ++ks) {
      bf16x8 af[4], bfr[4];
#pragma unroll
      for (int m = 0; m < 4; ++m)
        af[m] = *(const bf16x8*)(p.ws_bf + ((long)g * 128 + wr * 64 + m * 16 + fr) * 128 + ks * 32 + fq * 8);
      float mu[8], rs[8];
#pragma unroll
      for (int e = 0; e < 8; ++e) { mu[e] = s_mu[ks * 32 + fq * 8 + e]; rs[e] = s_rs[ks * 32 + fq * 8 + e]; }
#pragma unroll
      for (int n = 0; n < 4; ++n) {
        bf16x8 raw = *(const bf16x8*)(p.ml_vT + ((long)chunk * 2048 + cb + n * 16 + fr) * 128 + ks * 32 + fq * 8);
        bf16x8 nv;
#pragma unroll
        for (int e = 0; e < 8; ++e) nv[e] = (short)f2bf((bf2f((u16)raw[e]) - mu[e]) * rs[e] * lw[n] + lb[n]);
        bfr[n] = nv;
      }
#pragma unroll
      for (int m = 0; m < 4; ++m)
#pragma unroll
        for (int n = 0; n < 4; ++n) acc[m][n] = MFMA16(af[m], bfr[n], acc[m][n]);
    }
#pragma unroll
    for (int m = 0; m < 4; ++m)
#pragma unroll
      for (int j = 0; j < 4; ++j) {
        int i = wr * 64 + m * 16 + fq * 4 + j;
        float bs = p.mlp_b_s[g * 128 + i];
        long rowb = (long)(chunk * 128 + i) * 2048;
#pragma unroll
        for (int n = 0; n < 4; ++n) {
          long idx = rowb + cb + n * 16 + fr;
          float sv = acc[m][n][j] + bs;
          p.ml_o[idx] = f2bf(bf2f(p.ml_gu[idx]) * sv * bf2f(p.ml_sg[idx]));
        }
      }
    __syncthreads();
  }
}


#define XB_TMO      128
#define XB_XCNT(j)  (256  + 64 * (j))
#define XB_XSUB(j)  (1280 + 64 * (j))
#define XB_XGEN(j)  (2304 + 64 * (j))
#define XB_TOP      3328
#define XB_TOPGEN   3392
#define XCD_BAR_WORDS 3456
#define XB_SPIN_CAP (1u << 22)
#define LAS __attribute__((address_space(3)))
__device__ __forceinline__ unsigned xb_ld(unsigned* p)              { return __hip_atomic_load(p, __ATOMIC_RELAXED, __HIP_MEMORY_SCOPE_AGENT); }
__device__ __forceinline__ unsigned xb_add(unsigned* p, unsigned v) { return __hip_atomic_fetch_add(p, v, __ATOMIC_RELAXED, __HIP_MEMORY_SCOPE_AGENT); }
__device__ __forceinline__ unsigned xb_xcc_id() { return (unsigned)__builtin_amdgcn_s_getreg((3 << 11) | 20) & 0xFu; }
#define XB_SPIN(cond, bar) do { unsigned _sp = 0; while (cond) { __builtin_amdgcn_s_sleep(1); \
    if ((++_sp & 255u) == 0u) { if (xb_ld(&(bar)[XB_TMO])) break; if (_sp > XB_SPIN_CAP) { atomicAdd(&(bar)[XB_TMO], 1u); break; } } } } while (0)
struct XcdBarrier { unsigned* bar; unsigned x; volatile LAS unsigned* st; };
__device__ __forceinline__ XcdBarrier xcd_barrier_post(unsigned* bar, volatile LAS unsigned* st) {
  XcdBarrier b; b.bar = bar; b.x = xb_xcc_id(); b.st = st;
  if (threadIdx.x == 0) (void)xb_add(&bar[XB_XCNT(b.x)], 1u);
  return b;
}
__device__ __forceinline__ void xcd_barrier_complete(unsigned* bar, unsigned x, unsigned& nloc, unsigned& nx) {
  const unsigned G = gridDim.x * gridDim.y * gridDim.z;
  unsigned sum, cnt, mine, sp = 0u;
  for (;;) {
    sum = 0u; cnt = 0u; mine = 0u;
#pragma unroll
    for (unsigned j = 0; j < 16; ++j) { const unsigned c = xb_ld(&bar[XB_XCNT(j)]); sum += c; cnt += (c > 0u) ? 1u : 0u; mine = (j == x) ? c : mine; }
    if (sum == G) break;
    __builtin_amdgcn_s_sleep(1);
    if ((++sp & 255u) == 0u) { if (xb_ld(&bar[XB_TMO])) break; if (sp > XB_SPIN_CAP) { atomicAdd(&bar[XB_TMO], 1u); break; } }
  }
  nloc = mine > 0u ? mine : 1u; nx = cnt > 0u ? cnt : 1u;
}
__device__ __forceinline__ void xcd_barrier(const XcdBarrier& b) {
  asm volatile("s_waitcnt vmcnt(0)" ::: "memory");
  __syncthreads();
  if (threadIdx.x == 0) {
    unsigned* bar = b.bar;
    __builtin_amdgcn_s_waitcnt(0);
    unsigned nloc = b.st[0], nx = b.st[1];
    if (nloc == 0u) { xcd_barrier_complete(bar, b.x, nloc, nx); b.st[0] = nloc; b.st[1] = nx; }
    const unsigned old = xb_add(&bar[XB_XSUB(b.x)], 1u);
    const unsigned gen = old / nloc;
    if (old + 1u == (gen + 1u) * nloc) {
      __builtin_amdgcn_fence(__ATOMIC_RELEASE, "agent");
      asm volatile("s_waitcnt vmcnt(0)" ::: "memory");
      const unsigned og = xb_add(&bar[XB_TOP], 1u);
      const unsigned tg = og / nx;
      if (og + 1u == (tg + 1u) * nx) xb_add(&bar[XB_TOPGEN], 1u);
      else XB_SPIN(xb_ld(&bar[XB_TOPGEN]) == tg, bar);
      __builtin_amdgcn_fence(__ATOMIC_ACQUIRE, "agent");
      xb_add(&bar[XB_XGEN(b.x)], 1u);
      asm volatile("s_waitcnt vmcnt(0)" ::: "memory");
    } else {
      XB_SPIN(xb_ld(&bar[XB_XGEN(b.x)]) == gen, bar);
      __builtin_amdgcn_fence(__ATOMIC_ACQUIRE, "agent");
      asm volatile("s_waitcnt vmcnt(0)" ::: "memory");
    }
  }
  __syncthreads();
}

__device__ __forceinline__ void run_phase(const Params& p, int ph, char* smem) {
  if (ph == 0) { prep_phase(p, smem); return; }
  const int layer = (ph - 1) >> 2, sub = (ph - 1) & 3;
  const int kind = layer % 3, lj = layer / 3;
  const float* xp = layer == 0 ? p.x_prompt : p.X;
  const float* xs = layer == 0 ? p.x_sample : p.X + (long)TP * 1024;
  float* xout = layer == 3 ? p.y_out : p.X;
  if (sub == 0) { norm_phase(p, layer, xp, xs); return; }
  if (sub == 1) {
    if (kind == 0) {
      const u16* W = p.wt_na_in + (long)lj * 4096 * 1024;
      for (int t = blockIdx.x; t < 96 * 32; t += gridDim.x) {
        int tn = t & 31, tm = t >> 5;
        f32x4 acc[4][4];
        gemm_core(p.h + (long)tm * 128 * 1024, 1024, W + (long)tn * 128 * 1024, 1024, 1024, smem, acc);
        epi_na_in(p, lj, tm, tn, acc);
      }
    } else {
      const u16* W = kind == 1 ? p.wt_ret_in : p.wt_mlp_in;
      for (int t = blockIdx.x; t < 96 * 48; t += gridDim.x) {
        int tn = t % 48, tm = t / 48;
        f32x4 acc[4][4];
        gemm_core(p.h + (long)tm * 128 * 1024, 1024, W + (long)tn * 128 * 1024, 1024, 1024, smem, acc);
        if (kind == 1) epi_ret_in(p, tm, tn, acc); else epi_mlp_in(p, tm, tn, acc);
      }
    }
    return;
  }
  if (sub == 2) {
    if (kind == 0) na_attn_phase(p, lj, smem);
    else if (kind == 1) ret_phase(p, smem);
    else mlp_spatial_phase(p, smem);
    return;
  }
  {
    const u16* A; const u16* W; int K;
    if (kind == 0) { A = p.na_o; W = p.wt_na_out + (long)lj * 1024 * 1024; K = 1024; }
    else if (kind == 1) { A = p.rt_y; W = p.wt_ret_out; K = 2048; }
    else { A = p.ml_o; W = p.wt_mlp_out; K = 2048; }
    for (int t = blockIdx.x; t < 96 * 8; t += gridDim.x) {
      int tn = t & 7, tm = t >> 3;
      f32x4 acc[4][4];
      gemm_core(A + (long)tm * 128 * K, K, W + (long)tn * 128 * K, K, K, smem, acc);
      epi_resid(p, layer, xp, xs, xout, tm, tn, acc);
    }
  }
}

#define NPHASE 17
#ifndef PROBE_MASK
#define PROBE_MASK 0
#endif

__global__ void __launch_bounds__(256, 2) mega_kernel(Params p) {
  __shared__ __attribute__((aligned(16))) char smem[65536];
  __shared__ uint4 xb_words;
  cg::grid_group grid = cg::this_grid();
  if (threadIdx.x == 0) xb_words = make_uint4(0u, 0u, 0u, 0u);
  __syncthreads();
  XcdBarrier xb = xcd_barrier_post(p.bar, (volatile LAS unsigned*)&xb_words);
  if (p.bar == nullptr) grid.sync();
#pragma nounroll
  for (int ph = 0; ph < NPHASE; ++ph) {
    int phv = ph;
    asm volatile("" : "+s"(phv));
    run_phase(p, phv, smem);
#if PROBE_MASK
    {
      int sub = (ph - 1) & 3, kind = ((ph - 1) >> 2) % 3;
      int cls = ph == 0 ? 1 : (sub == 0 ? 2 : (sub == 1 ? 4 : (sub == 2 ? (8 << kind) : 64)));
      if (cls & PROBE_MASK) { xcd_barrier(xb); run_phase(p, phv, smem); }
    }
#endif
    if (ph + 1 < NPHASE) xcd_barrier(xb);
  }
}

__global__ void __launch_bounds__(256, 2) phase_kernel(Params p, int ph) {
  __shared__ __attribute__((aligned(16))) char smem[65536];
  run_phase(p, ph, smem);
}

#ifndef MULTI_LAUNCH
#define MULTI_LAUNCH 0
#endif

extern "C" void kernel_launch(void* const* d_in, const int* in_sizes, int n_in, void* d_out, int out_size, void* d_ws,
                              size_t ws_size, hipStream_t stream) {
  Params p{};
  p.x_prompt = (const float*)d_in[0];  p.x_sample = (const float*)d_in[1];
  p.cache_k = (const float*)d_in[2];   p.cache_v = (const float*)d_in[3];
  p.state_ret = (const float*)d_in[4]; p.c = (const float*)d_in[5];
  p.c_ctx = (const float*)d_in[6];     p.norm_w = (const float*)d_in[7];
  p.w_ada = (const float*)d_in[8];     p.b_ada = (const float*)d_in[9];
  p.na_w_in = (const float*)d_in[10];  p.na_w_out = (const float*)d_in[11];
  p.na_q_gain = (const float*)d_in[12]; p.na_k_gain = (const float*)d_in[13];
  p.na_rpb = (const float*)d_in[14];
  p.ret_w_in = (const float*)d_in[15]; p.ret_w_out = (const float*)d_in[16];
  p.ret_decay = (const float*)d_in[17]; p.ret_gn_w = (const float*)d_in[18];
  p.mlp_w_in = (const float*)d_in[19]; p.mlp_ln_w = (const float*)d_in[20];
  p.mlp_ln_b = (const float*)d_in[21]; p.mlp_w_s = (const float*)d_in[22];
  p.mlp_b_s = (const float*)d_in[23];  p.mlp_w_out = (const float*)d_in[24];
  float* out = (float*)d_out;
  p.y_out = out;
  p.new_k = out + (long)TT * 1024;
  p.new_v = p.new_k + (long)32 * 2 * 256 * 1024;
  p.new_ret = p.new_v + (long)32 * 2 * 256 * 1024;

  char* w = (char*)d_ws;
  size_t off = 0;
  auto take = [&](size_t bytes) { char* r = w + off; off += (bytes + 255) & ~(size_t)255; return r; };
  p.wt_na_in = (u16*)take((size_t)2 * 4096 * 1024 * 2);
  p.wt_na_out = (u16*)take((size_t)2 * 1024 * 1024 * 2);
  p.wt_ret_in = (u16*)take((size_t)6144 * 1024 * 2);
  p.wt_ret_out = (u16*)take((size_t)1024 * 2048 * 2);
  p.wt_mlp_in = (u16*)take((size_t)6144 * 1024 * 2);
  p.wt_mlp_out = (u16*)take((size_t)1024 * 2048 * 2);
  p.ws_bf = (u16*)take((size_t)8 * 128 * 128 * 2);
  p.ck_bf = (u16*)take((size_t)4 * 2 * 256 * 1024 * 2);
  p.cvt_bf = (u16*)take((size_t)4 * 2 * 256 * 1024 * 2);
  p.s0t = (u16*)take((size_t)16 * 512 * 512 * 2);
  p.mod = (float*)take((size_t)4 * 5 * 3072 * 4);
  p.ropetab = (float*)take((size_t)4096 * 2 * 4);
  p.dec = (float*)take(256);
  p.bar = (unsigned*)take((size_t)XCD_BAR_WORDS * 4);
  p.X = (float*)take((size_t)TT * 1024 * 4);
  p.h = (u16*)take((size_t)TT * 1024 * 2);
  size_t region = off;
  p.na_q = (u16*)take((size_t)TT * 1024 * 2);
  p.na_k = (u16*)take((size_t)TT * 1024 * 2);
  p.na_vT = (u16*)take((size_t)TT * 1024 * 2);
  p.na_sg = (u16*)take((size_t)TT * 1024 * 2);
  p.na_o = (u16*)take((size_t)TT * 1024 * 2);
  off = region;
  p.rt_q = (u16*)take((size_t)TT * 1024 * 2);
  p.rt_k = (u16*)take((size_t)TT * 1024 * 2);
  p.rt_qs = (u16*)take((size_t)16 * 1024 * 512 * 2);
  p.rt_kT = (u16*)take((size_t)256 * 256 * 256 * 2);
  p.rt_vT = (u16*)take((size_t)TT * 2048 * 2);
  p.rt_sg = (u16*)take((size_t)TT * 2048 * 2);
  p.rt_y = (u16*)take((size_t)TT * 2048 * 2);
  off = region;
  p.ml_gu = (u16*)take((size_t)TT * 2048 * 2);
  p.ml_vT = (u16*)take((size_t)TT * 2048 * 2);
  p.ml_sg = (u16*)take((size_t)TT * 2048 * 2);
  p.ml_o = (u16*)take((size_t)TT * 2048 * 2);
  p.ml_st = (float*)take((size_t)TT * 64 * 4);

#if MULTI_LAUNCH
  for (int ph = 0; ph < NPHASE; ++ph) phase_kernel<<<dim3(1024), dim3(256), 0, stream>>>(p, ph);
#else
  static int grid_blocks = 0;
  if (!grid_blocks) {
    int dev = 0, cus = 0, per_cu = 0;
    (void)hipGetDevice(&dev);
    (void)hipDeviceGetAttribute(&cus, hipDeviceAttributeMultiprocessorCount, dev);
    (void)hipOccupancyMaxActiveBlocksPerMultiprocessor(&per_cu, mega_kernel, 256, 0);
    if (per_cu > 2) per_cu = 2;
    if (per_cu < 1) per_cu = 1;
    grid_blocks = cus * per_cu;
  }
  (void)hipMemsetAsync(p.bar, 0, (size_t)XCD_BAR_WORDS * 4, stream);
  void* args[] = {&p};
  hipError_t e = hipLaunchCooperativeKernel((void*)mega_kernel, dim3(grid_blocks), dim3(256), args, 0, stream);
  if (e != hipSuccess) fprintf(stderr, "cooperative launch failed: %s (grid %d)\n", hipGetErrorString(e), grid_blocks);
#endif
}
```

```cpp
#include <hip/hip_runtime.h>
#include <hip/hip_cooperative_groups.h>
#include <cstdio>
namespace cg = cooperative_groups;

typedef unsigned short u16;
using bf16x8 = __attribute__((ext_vector_type(8))) short;
using bf16x4 = __attribute__((ext_vector_type(4))) short;
using f32x4  = __attribute__((ext_vector_type(4))) float;

#define TP 8192
#define TS 4096
#define TT 12288

struct Params {
  const float *x_prompt, *x_sample, *cache_k, *cache_v, *state_ret, *c, *c_ctx, *norm_w, *w_ada, *b_ada;
  const float *na_w_in, *na_w_out, *na_q_gain, *na_k_gain, *na_rpb;
  const float *ret_w_in, *ret_w_out, *ret_decay, *ret_gn_w;
  const float *mlp_w_in, *mlp_ln_w, *mlp_ln_b, *mlp_w_s, *mlp_b_s, *mlp_w_out;
  float *y_out, *new_k, *new_v, *new_ret;
  u16 *wt_na_in, *wt_na_out, *wt_ret_in, *wt_ret_out, *wt_mlp_in, *wt_mlp_out, *ws_bf, *ck_bf, *cvt_bf, *s0t;
  float *mod, *ropetab, *dec, *X;
  u16 *h;
  u16 *na_q, *na_k, *na_vT, *na_sg, *na_o;
  u16 *rt_q, *rt_k, *rt_qs, *rt_kT, *rt_vT, *rt_vF, *rt_sg, *rt_y;
  u16 *ml_gu, *ml_vT, *ml_sg, *ml_o;
  float *ml_st;
  unsigned *bar;
};

__device__ __forceinline__ u16 f2bf(float f) {
  unsigned u = __float_as_uint(f);
  u += 0x7fffu + ((u >> 16) & 1u);
  return (u16)(u >> 16);
}
__device__ __forceinline__ float bf2f(u16 h) { return __uint_as_float(((unsigned)h) << 16); }
__device__ __forceinline__ unsigned pk2(float a, float b) { return (unsigned)f2bf(a) | ((unsigned)f2bf(b) << 16); }
__device__ __forceinline__ bf16x8 pack8(f32x4 a, f32x4 b) {
  bf16x8 r;
  r[0] = (short)f2bf(a[0]); r[1] = (short)f2bf(a[1]); r[2] = (short)f2bf(a[2]); r[3] = (short)f2bf(a[3]);
  r[4] = (short)f2bf(b[0]); r[5] = (short)f2bf(b[1]); r[6] = (short)f2bf(b[2]); r[7] = (short)f2bf(b[3]);
  return r;
}
__device__ __forceinline__ void store4bf(u16* dst, float a, float b, float c, float d) {
  uint2 v; v.x = pk2(a, b); v.y = pk2(c, d);
  *(uint2*)dst = v;
}
__device__ __forceinline__ float silu_f(float x) { return x / (1.f + __expf(-x)); }
__device__ __forceinline__ float gelu_f(float x) {
  float z = 0.7978845608028654f * (x + 0.044715f * x * x * x);
  float t = 1.f - 2.f / (__expf(2.f * z) + 1.f);
  return 0.5f * x * (1.f + t);
}
__device__ __forceinline__ int tidx() { int t = threadIdx.x; asm volatile("" : "+v"(t)); return t; }
#define MFMA16(a, b, c) __builtin_amdgcn_mfma_f32_16x16x32_bf16((a), (b), (c), 0, 0, 0)

__device__ __forceinline__ void gemm_core(const u16* __restrict__ A, long lda, const u16* __restrict__ B, long ldb,
                                          int K, char* smem, f32x4 (&acc)[4][4]) {
  const int tid = tidx(), lane = tid & 63, wid = tid >> 6, wr = wid >> 1, wc = wid & 1, fr = lane & 15, fq = lane >> 4;
#pragma unroll
  for (int m = 0; m < 4; ++m)
#pragma unroll
    for (int n = 0; n < 4; ++n) acc[m][n] = f32x4{0.f, 0.f, 0.f, 0.f};
  const int nk = K >> 6;
  const int r0 = tid >> 3, c0 = (tid & 7) ^ ((r0 >> 1) & 7);
  const u16* ap = A + (long)r0 * lda + c0 * 8;
  const u16* bp = B + (long)r0 * ldb + c0 * 8;
  const long sa32 = 32 * lda, sb32 = 32 * ldb;
  uint4 ga0, ga1, ga2, ga3, gb0, gb1, gb2, gb3, ha0, ha1, ha2, ha3, hb0, hb1, hb2, hb3;
  char* lw = smem + tid * 16;
#define GLOAD(P, kt) { P##a0 = *(const uint4*)(ap + (kt) * 64); P##a1 = *(const uint4*)(ap + sa32 + (kt) * 64); \
    P##a2 = *(const uint4*)(ap + 2 * sa32 + (kt) * 64); P##a3 = *(const uint4*)(ap + 3 * sa32 + (kt) * 64); \
    P##b0 = *(const uint4*)(bp + (kt) * 64); P##b1 = *(const uint4*)(bp + sb32 + (kt) * 64); \
    P##b2 = *(const uint4*)(bp + 2 * sb32 + (kt) * 64); P##b3 = *(const uint4*)(bp + 3 * sb32 + (kt) * 64); }
#define LWRITE(P, b) { char* l_ = lw + (b) * 32768; \
    *(uint4*)(l_) = P##a0; *(uint4*)(l_ + 4096) = P##a1; *(uint4*)(l_ + 8192) = P##a2; *(uint4*)(l_ + 12288) = P##a3; \
    *(uint4*)(l_ + 16384) = P##b0; *(uint4*)(l_ + 20480) = P##b1; *(uint4*)(l_ + 24576) = P##b2; *(uint4*)(l_ + 28672) = P##b3; }
  auto compute = [&](int b) {
    const char* sa = smem + b * 32768;
    const char* sb = sa + 16384;
#pragma unroll
    for (int ks = 0; ks < 2; ++ks) {
      bf16x8 af[4], bfr[4];
#pragma unroll
      for (int m = 0; m < 4; ++m) {
        int r = wr * 64 + m * 16 + fr;
        af[m] = *(const bf16x8*)(sa + (r * 8 + ((ks * 4 + fq) ^ ((r >> 1) & 7))) * 16);
      }
#pragma unroll
      for (int n = 0; n < 4; ++n) {
        int r = wc * 64 + n * 16 + fr;
        bfr[n] = *(const bf16x8*)(sb + (r * 8 + ((ks * 4 + fq) ^ ((r >> 1) & 7))) * 16);
      }
#pragma unroll
      for (int m = 0; m < 4; ++m)
#pragma unroll
        for (int n = 0; n < 4; ++n) acc[m][n] = MFMA16(af[m], bfr[n], acc[m][n]);
    }
  };
  GLOAD(g, 0);
  GLOAD(h, 1);
  LWRITE(g, 0);
  __syncthreads();
  for (int t = 0; t < nk; t += 2) {
    if (t + 2 < nk) GLOAD(g, t + 2);
    __builtin_amdgcn_sched_barrier(0);
    compute(0);
    __builtin_amdgcn_sched_barrier(0);
    LWRITE(h, 1);
    __syncthreads();
    if (t + 3 < nk) GLOAD(h, t + 3);
    __builtin_amdgcn_sched_barrier(0);
    compute(1);
    __builtin_amdgcn_sched_barrier(0);
    if (t + 2 < nk) LWRITE(g, 0);
    __syncthreads();
  }
#undef GLOAD
#undef LWRITE
}

__device__ __forceinline__ void adaln_item(const Params& p, int it, char* smem) {
  const int tid = tidx();
  int layer = it / 48, n0 = (it % 48) * 64;
  float* s_c = (float*)smem;
  float* s_p = s_c + 5120;
  for (int idx = tid; idx < 5120; idx += 256) {
    int v = idx >> 10, kk = idx & 1023;
    float cv = (v == 0) ? p.c_ctx[kk] : p.c[(v - 1) * 1024 + kk];
    s_c[idx] = silu_f(cv);
  }
  __syncthreads();
  int cl = tid & 15, ksl = tid >> 4;
  const float* w = p.w_ada + (long)layer * 1024 * 3072 + n0 + cl * 4;
  float4 a0 = {0, 0, 0, 0}, a1 = a0, a2 = a0, a3 = a0, a4 = a0;
#pragma unroll 8
  for (int kk = 0; kk < 64; ++kk) {
    int k = ksl * 64 + kk;
    float4 w4 = *(const float4*)(w + (long)k * 3072);
    float c0 = s_c[k], c1 = s_c[1024 + k], c2 = s_c[2048 + k], c3 = s_c[3072 + k], c4 = s_c[4096 + k];
    a0.x += c0 * w4.x; a0.y += c0 * w4.y; a0.z += c0 * w4.z; a0.w += c0 * w4.w;
    a1.x += c1 * w4.x; a1.y += c1 * w4.y; a1.z += c1 * w4.z; a1.w += c1 * w4.w;
    a2.x += c2 * w4.x; a2.y += c2 * w4.y; a2.z += c2 * w4.z; a2.w += c2 * w4.w;
    a3.x += c3 * w4.x; a3.y += c3 * w4.y; a3.z += c3 * w4.z; a3.w += c3 * w4.w;
    a4.x += c4 * w4.x; a4.y += c4 * w4.y; a4.z += c4 * w4.z; a4.w += c4 * w4.w;
  }
  *(float4*)(s_p + (ksl * 5 + 0) * 64 + cl * 4) = a0;
  *(float4*)(s_p + (ksl * 5 + 1) * 64 + cl * 4) = a1;
  *(float4*)(s_p + (ksl * 5 + 2) * 64 + cl * 4) = a2;
  *(float4*)(s_p + (ksl * 5 + 3) * 64 + cl * 4) = a3;
  *(float4*)(s_p + (ksl * 5 + 4) * 64 + cl * 4) = a4;
  __syncthreads();
  for (int o = tid; o < 320; o += 256) {
    int v = o >> 6, col = o & 63;
    float s = p.b_ada[layer * 3072 + n0 + col];
#pragma unroll
    for (int k2 = 0; k2 < 16; ++k2) s += s_p[(k2 * 5 + v) * 64 + col];
    p.mod[(layer * 5 + v) * 3072 + n0 + col] = s;
  }
  __syncthreads();
}

__device__ __forceinline__ void tr_tile(const float* __restrict__ src, long ld_src, u16* __restrict__ dst, long ld_dst,
                        int r0, int c0, int perm, char* smem) {
  float* tile = (float*)smem;
  const int tid = tidx();
  {
    int cc = tid & 63;
    int pcol = c0 + cc;
    int scol = pcol;
    if (perm) {
      int blk = pcol & ~127, w = pcol & 127;
      int r = w & 63;
      scol = blk + (r >> 5) * 64 + (w >> 6) * 32 + (r & 31);
    }
#pragma unroll
    for (int i = 0; i < 16; ++i) {
      int rr = (tid >> 6) + i * 4;
      tile[rr * 65 + cc] = src[(long)(r0 + rr) * ld_src + scol];
    }
  }
  __syncthreads();
  {
    int rr = tid & 63;
#pragma unroll
    for (int i = 0; i < 16; ++i) {
      int pp = (tid >> 6) + i * 4;
      dst[(long)(c0 + pp) * ld_dst + r0 + rr] = f2bf(tile[rr * 65 + pp]);
    }
  }
  __syncthreads();
}

__device__ __forceinline__ void tr_item(const Params& p, int x, char* smem) {
  if (x < 2048) {
    int bt = x >> 10, tt = x & 1023, rt = tt & 15, ct = tt >> 4;
    tr_tile(p.na_w_in + (long)bt * 1024 * 4096, 4096, p.wt_na_in + (long)bt * 4096 * 1024, 1024, rt * 64, ct * 64, 0, smem);
    return;
  }
  x -= 2048;
  if (x < 512) {
    int bt = x >> 8, tt = x & 255, rt = tt & 15, ct = tt >> 4;
    tr_tile(p.na_w_out + (long)bt * 1024 * 1024, 1024, p.wt_na_out + (long)bt * 1024 * 1024, 1024, rt * 64, ct * 64, 0, smem);
    return;
  }
  x -= 512;
  if (x < 1536) {
    int rt = x & 15, ct = x >> 4;
    tr_tile(p.ret_w_in, 6144, p.wt_ret_in, 1024, rt * 64, ct * 64, ct < 32 ? 1 : 0, smem);
    return;
  }
  x -= 1536;
  if (x < 512) {
    int rt = x & 31, ct = x >> 5;
    tr_tile(p.ret_w_out, 1024, p.wt_ret_out, 2048, rt * 64, ct * 64, 0, smem);
    return;
  }
  x -= 512;
  if (x < 1536) {
    int rt = x & 15, ct = x >> 4;
    tr_tile(p.mlp_w_in, 6144, p.wt_mlp_in, 1024, rt * 64, ct * 64, 0, smem);
    return;
  }
  x -= 1536;
  if (x < 512) {
    int rt = x & 31, ct = x >> 5;
    tr_tile(p.mlp_w_out, 1024, p.wt_mlp_out, 2048, rt * 64, ct * 64, 0, smem);
    return;
  }
  x -= 512;
  (void)x;
}

__device__ __forceinline__ void cv_item(const Params& p, int it) {
  const int tid = tidx();
  if (it < 128) {
    long base = (long)it * 1024 + tid * 4;
    float4 v = *(const float4*)(p.mlp_w_s + base);
    store4bf(p.ws_bf + base, v.x, v.y, v.z, v.w);
    return;
  }
  it -= 128;
  if (it < 1024) {
    int g = it * 256 + tid;
    int seq = g >> 11, r = g & 2047, lane = r & 63, f = r >> 6;
    int ks = f & 1, n = (f >> 1) & 3, kt = f >> 3, fr = lane & 15, fq = lane >> 4;
    int blj = seq >> 4, hh = seq & 15;
    int s = kt * 64 + n * 16 + fr, d0 = ks * 32 + fq * 8;
    const float* sp = p.cache_k + ((long)(blj * 256 + s) * 16 + hh) * 64 + d0;
    float4 a = *(const float4*)sp, b = *(const float4*)(sp + 4);
    uint4 o; o.x = pk2(a.x, a.y); o.y = pk2(a.z, a.w); o.z = pk2(b.x, b.y); o.w = pk2(b.z, b.w);
    *(uint4*)(p.ck_bf + (long)g * 8) = o;
    return;
  }
  it -= 1024;
  if (it < 1024) {
    int g = it * 256 + tid;
    int seq = g >> 11, r = g & 2047, lane = r & 63, f = r >> 6;
    int dt = f & 3, ks2 = (f >> 2) & 1, kt = f >> 3, fr = lane & 15, fq = lane >> 4;
    int blj = seq >> 4, hh = seq & 15;
    int dv = dt * 16 + fr, kA = kt * 64 + (2 * ks2) * 16 + fq * 4;
    const float* sp = p.cache_v + ((long)(blj * 256 + kA) * 16 + hh) * 64 + dv;
    uint4 o;
    o.x = pk2(sp[0], sp[1024]); o.y = pk2(sp[2048], sp[3072]);
    o.z = pk2(sp[16 * 1024], sp[17 * 1024]); o.w = pk2(sp[18 * 1024], sp[19 * 1024]);
    *(uint4*)(p.cvt_bf + (long)g * 8) = o;
    return;
  }
  it -= 1024;
  {
    int g = it * 256 + tid;
    int bh = g >> 15, r = g & 32767, lane = r & 63, f = r >> 6;
    int dtg = f & 31, ks = f >> 5, fr = lane & 15, fq = lane >> 4;
    int dv = dtg * 16 + fr, k0 = ks * 32 + fq * 8, dir = k0 >> 8, dk0 = k0 & 255;
    int b = bh >> 2, hh = bh & 3;
    const float* sp = p.state_ret + ((long)((b * 2 + dir) * 4 + hh) * 256 + dk0) * 512 + dv;
    uint4 o;
    o.x = pk2(sp[0], sp[512]); o.y = pk2(sp[1024], sp[1536]);
    o.z = pk2(sp[2048], sp[2560]); o.w = pk2(sp[3072], sp[3584]);
    *(uint4*)(p.s0t + (long)g * 8) = o;
  }
}

__device__ __forceinline__ void misc_item(const Params& p) {
  const int tid = tidx();
  for (int idx = tid; idx < 4096; idx += 256) {
    int pos = idx >> 6, i = idx & 63;
    float inv = exp2f(-(float)i * (13.287712379549449f / 64.f));
    float ang = (float)pos * inv;
    p.ropetab[2 * idx] = cosf(ang);
    p.ropetab[2 * idx + 1] = sinf(ang);
  }
  if (tid < 8) {
    float x = p.ret_decay[tid];
    float lg = -log1pf(expf(-x));
    p.dec[tid] = lg * 1.4426950408889634f;
  }
}

__device__ __forceinline__ void prep_phase(const Params& p, char* smem) {
  const int NADA = 192, NTR = 6656, NCV = 128 + 1024 + 1024 + 2048;
  for (int it = blockIdx.x; it < NADA + NTR + NCV + 1; it += gridDim.x) {
    if (it < NADA) adaln_item(p, it, smem);
    else if (it < NADA + NTR) tr_item(p, it - NADA, smem);
    else if (it < NADA + NTR + NCV) cv_item(p, it - NADA - NTR);
    else misc_item(p);
  }
}

__device__ __forceinline__ void norm_phase(const Params& p, int layer, const float* xp, const float* xs) {
  const int wave = tidx() >> 6, lane = tidx() & 63;
  const float* nw = p.norm_w + layer * 1024;
  for (int row = blockIdx.x * 4 + wave; row < TT; row += gridDim.x * 4) {
    const float* x = row < TP ? xp + (long)row * 1024 : xs + (long)(row - TP) * 1024;
    int mv = row < TP ? 0 : 1 + ((row - TP) >> 10);
    const float* md = p.mod + (long)(layer * 5 + mv) * 3072;
    float4 v[4];
    float ss = 0.f;
#pragma unroll
    for (int i = 0; i < 4; ++i) {
      v[i] = *(const float4*)(x + i * 256 + lane * 4);
      ss += v[i].x * v[i].x + v[i].y * v[i].y + v[i].z * v[i].z + v[i].w * v[i].w;
    }
#pragma unroll
    for (int o = 32; o > 0; o >>= 1) ss += __shfl_xor(ss, o);
    float r = rsqrtf(ss * (1.f / 1024.f) + 1e-6f);
#pragma unroll
    for (int i = 0; i < 4; ++i) {
      int c = i * 256 + lane * 4;
      float4 w4 = *(const float4*)(nw + c);
      float4 sh = *(const float4*)(md + c);
      float4 sc = *(const float4*)(md + 1024 + c);
      float o0 = (v[i].x * r * w4.x) * (1.f + sc.x) + sh.x;
      float o1 = (v[i].y * r * w4.y) * (1.f + sc.y) + sh.y;
      float o2 = (v[i].z * r * w4.z) * (1.f + sc.z) + sh.z;
      float o3 = (v[i].w * r * w4.w) * (1.f + sc.w) + sh.w;
      store4bf(p.h + (long)row * 1024 + c, o0, o1, o2, o3);
    }
  }
}

#define LDSWAIT() asm volatile("s_waitcnt lgkmcnt(0)" ::: "memory")

__device__ __forceinline__ void rows_out_bf16(const char* wl, int lane, u16* dst, long ld) {
#pragma unroll
  for (int i = 0; i < 8; ++i) {
    int row = (lane >> 3) + 8 * i, ch = lane & 7;
    uint4 v = *(const uint4*)(wl + row * 144 + ch * 16);
    *(uint4*)(dst + (long)row * ld + ch * 8) = v;
  }
}
__device__ __forceinline__ void rows_out_bf16_split(const char* wl, int lane, u16* dst, long ld, int gap) {
#pragma unroll
  for (int i = 0; i < 8; ++i) {
    int row = (lane >> 3) + 8 * i, ch = lane & 7;
    uint4 v = *(const uint4*)(wl + row * 144 + ch * 16);
    *(uint4*)(dst + (long)row * ld + (ch & 3) * 8 + (ch >> 2) * gap) = v;
  }
}
template <class F>
__device__ __forceinline__ void rows_out_f32(const float* wl, int lane, F f) {
#pragma unroll
  for (int i = 0; i < 8; ++i) {
    int row = (lane >> 4) + 4 * i, ch = lane & 15;
    float4 v = *(const float4*)(wl + row * 68 + ch * 4);
    f(row, ch, v);
  }
}

__device__ __forceinline__ void epi_resid(const Params& p, int layer, const float* xp, const float* xs, float* xout,
                                          int tm, int tn, f32x4 (&acc)[4][4], char* smem) {
  const int lane = tidx() & 63, wid = tidx() >> 6, wr = wid >> 1, wc = wid & 1, fr = lane & 15, fq = lane >> 4;
  float* wl = (float*)(smem + wid * 16384);
  int mv = tm < 64 ? 0 : 1 + ((tm - 64) >> 3);
  const int ch = lane & 15;
  const int col = tn * 128 + wc * 64 + ch * 4;
  const float4 g4 = *(const float4*)(p.mod + (long)(layer * 5 + mv) * 3072 + 2048 + col);
  const int trow0 = tm * 128 + wr * 64;
  const float* xin = (trow0 < TP ? xp + (long)trow0 * 1024 : xs + (long)(trow0 - TP) * 1024) + col;
  float* xo = xout + (long)trow0 * 1024 + col;
#pragma unroll
  for (int a = 0; a < 2; ++a) {
#pragma unroll
    for (int mm = 0; mm < 2; ++mm)
#pragma unroll
      for (int j = 0; j < 4; ++j)
#pragma unroll
        for (int n = 0; n < 4; ++n) wl[(mm * 16 + fq * 4 + j) * 68 + n * 16 + fr] = acc[2 * a + mm][n][j];
    LDSWAIT();
    rows_out_f32(wl, lane, [&](int row, int, float4 v) {
      long off = (long)(a * 32 + row) * 1024;
      float4 x = *(const float4*)(xin + off);
      float4 o;
      o.x = x.x + g4.x * v.x; o.y = x.y + g4.y * v.y; o.z = x.z + g4.z * v.z; o.w = x.w + g4.w * v.w;
      *(float4*)(xo + off) = o;
    });
    LDSWAIT();
  }
}

__device__ __forceinline__ void epi_na_in(const Params& p, int lj, int tm, int tn, f32x4 (&acc)[4][4], char* smem) {
  const int lane = tidx() & 63, wid = tidx() >> 6, wr = wid >> 1, wc = wid & 1, fr = lane & 15, fq = lane >> 4;
  char* wl = smem + wid * 16384;
  u16* wl16 = (u16*)wl;
  float* wlf = (float*)wl;
  const int sec = tn >> 3;
  const int cbase = (tn & 7) * 128 + wc * 64;
  const int head = cbase >> 6;
  const int row0 = tm * 128 + wr * 64;
  int b, s0; long sb;
  if (row0 < TP) { b = row0 >> 8; s0 = row0 & 255; sb = (long)(b * 16 + head) * 256 * 64; }
  else { int ts = row0 - TP; b = ts >> 10; s0 = ts & 1023; sb = (long)TP * 1024 + (long)(b * 16 + head) * 1024 * 64; }
  const int kt = s0 >> 6;
  if (sec <= 1) {
    const float* gain = (sec == 0 ? p.na_q_gain : p.na_k_gain) + lj * 64;
    float g[4];
#pragma unroll
    for (int n = 0; n < 4; ++n) g[n] = gain[n * 16 + fr] * (sec == 0 ? 0.125f : 1.f);
#pragma unroll
    for (int m = 0; m < 4; ++m)
#pragma unroll
      for (int j = 0; j < 4; ++j) {
        float ss = 0.f;
#pragma unroll
        for (int n = 0; n < 4; ++n) ss += acc[m][n][j] * acc[m][n][j];
        ss += __shfl_xor(ss, 1); ss += __shfl_xor(ss, 2); ss += __shfl_xor(ss, 4); ss += __shfl_xor(ss, 8);
        float r = rsqrtf(ss * (1.f / 64.f) + 1e-6f);
#pragma unroll
        for (int n = 0; n < 4; ++n) acc[m][n][j] *= r * g[n];
      }
#pragma unroll
    for (int m = 0; m < 4; ++m)
#pragma unroll
      for (int j = 0; j < 4; ++j)
#pragma unroll
        for (int n = 0; n < 4; ++n) wl16[(m * 16 + fq * 4 + j) * 72 + n * 16 + fr] = f2bf(acc[m][n][j]);
    LDSWAIT();
    if (sec == 0) {
      rows_out_bf16(wl, lane, p.na_q + (long)row0 * 1024 + cbase, 1024);
    } else {
#pragma unroll
      for (int m = 0; m < 4; ++m)
#pragma unroll
        for (int ks = 0; ks < 2; ++ks) {
          uint4 v = *(const uint4*)(wl + (m * 16 + fr) * 144 + (ks * 32 + fq * 8) * 2);
          *(uint4*)(p.na_k + sb + (long)(((kt * 4 + m) * 2 + ks) * 64 + lane) * 8) = v;
        }
    }
    LDSWAIT();
    if (sec == 1 && row0 < TP) {
      float* nk = p.new_k + ((long)(b * 2 + lj) * 256 + s0) * 1024 + head * 64;
#pragma unroll
      for (int a = 0; a < 2; ++a) {
#pragma unroll
        for (int mm = 0; mm < 2; ++mm)
#pragma unroll
          for (int j = 0; j < 4; ++j)
#pragma unroll
            for (int n = 0; n < 4; ++n) wlf[(mm * 16 + fq * 4 + j) * 68 + n * 16 + fr] = acc[2 * a + mm][n][j];
        LDSWAIT();
        rows_out_f32(wlf, lane, [&](int row, int ch, float4 v) { *(float4*)(nk + (long)(a * 32 + row) * 1024 + ch * 4) = v; });
        LDSWAIT();
      }
    }
  } else if (sec == 2) {
#pragma unroll
    for (int m = 0; m < 4; m += 2) {
#pragma unroll
      for (int n = 0; n < 4; ++n) {
        f32x4 a = acc[m][n], a2 = acc[m + 1][n];
        uint4 o; o.x = pk2(a[0], a[1]); o.y = pk2(a[2], a[3]); o.z = pk2(a2[0], a2[1]); o.w = pk2(a2[2], a2[3]);
        *(uint4*)(p.na_vT + sb + ((long)(((kt * 2 + (m >> 1)) * 4 + n) * 64 + lane)) * 8) = o;
      }
    }
    if (row0 < TP) {
      float* nv = p.new_v + ((long)(b * 2 + lj) * 256 + s0) * 1024 + head * 64;
#pragma unroll
      for (int a = 0; a < 2; ++a) {
#pragma unroll
        for (int mm = 0; mm < 2; ++mm)
#pragma unroll
          for (int j = 0; j < 4; ++j)
#pragma unroll
            for (int n = 0; n < 4; ++n) wlf[(mm * 16 + fq * 4 + j) * 68 + n * 16 + fr] = acc[2 * a + mm][n][j];
        LDSWAIT();
        rows_out_f32(wlf, lane, [&](int row, int ch, float4 v) { *(float4*)(nv + (long)(a * 32 + row) * 1024 + ch * 4) = v; });
        LDSWAIT();
      }
    }
  } else {
#pragma unroll
    for (int m = 0; m < 4; ++m)
#pragma unroll
      for (int j = 0; j < 4; ++j)
#pragma unroll
        for (int n = 0; n < 4; ++n) wl16[(m * 16 + fq * 4 + j) * 72 + n * 16 + fr] = f2bf(silu_f(acc[m][n][j]));
    LDSWAIT();
    rows_out_bf16(wl, lane, p.na_sg + (long)row0 * 1024 + cbase, 1024);
    LDSWAIT();
  }
}

__device__ __forceinline__ void epi_ret_in(const Params& p, int tm, int tn, f32x4 (&acc)[4][4], char* smem) {
  const int lane = tidx() & 63, wid = tidx() >> 6, wr = wid >> 1, wc = wid & 1, fr = lane & 15, fq = lane >> 4;
  char* wl = smem + wid * 16384;
  u16* wl16 = (u16*)wl;
  const int row0 = tm * 128 + wr * 64;
  const bool sample = tm >= 64;
  if (tn < 16) {
    const bool isk = tn >= 8;
    const int blk = tn & 7, hh = blk >> 1, half = blk & 1;
    const float l2f = p.dec[hh], l2b = p.dec[4 + hh];
#pragma unroll
    for (int m = 0; m < 4; ++m)
#pragma unroll
      for (int j = 0; j < 4; ++j) {
        int t = row0 + m * 16 + fq * 4 + j;
        int nn = (t - TP) & 1023;
        int pos = half == 0 ? (nn >> 6) : (nn & 63);
#pragma unroll
        for (int n2 = 0; n2 < 2; ++n2) {
          int i = wc * 32 + n2 * 16 + fr;
          float x1 = acc[m][n2][j], x2 = acc[m][n2 + 2][j];
          float o1 = x1, o2 = x2;
          if (sample) {
            float2 cs = *(const float2*)(p.ropetab + 2 * (pos * 64 + i));
            o1 = x1 * cs.x - x2 * cs.y;
            o2 = x1 * cs.y + x2 * cs.x;
          }
          if (isk) { o1 *= 0.0625f; o2 *= 0.0625f; }
          acc[m][n2][j] = o1; acc[m][n2 + 2][j] = o2;
        }
      }
#pragma unroll
    for (int m = 0; m < 4; ++m)
#pragma unroll
      for (int j = 0; j < 4; ++j)
#pragma unroll
        for (int n = 0; n < 4; ++n) wl16[(m * 16 + fq * 4 + j) * 72 + (n >> 1) * 32 + (n & 1) * 16 + fr] = f2bf(acc[m][n][j]);
    LDSWAIT();
    if (!isk) {
      rows_out_bf16_split(wl, lane, p.rt_q + (long)row0 * 1024 + hh * 256 + half * 128 + wc * 32, 1024, 64);
      LDSWAIT();
      if (sample) {
        int ts0 = row0 - TP, b = ts0 >> 10, nn0 = ts0 & 1023;
        u16* qs = p.rt_qs + ((long)(b * 4 + hh) * 1024 + nn0) * 512 + half * 128 + wc * 32;
#pragma unroll
        for (int dir = 0; dir < 2; ++dir) {
#pragma unroll
          for (int m = 0; m < 4; ++m)
#pragma unroll
            for (int j = 0; j < 4; ++j) {
              int nn = nn0 + m * 16 + fq * 4 + j;
              float w = dir == 0 ? exp2f(l2f * (float)(nn + 1)) : exp2f(l2b * (float)(1024 - nn));
#pragma unroll
              for (int n = 0; n < 4; ++n) wl16[(m * 16 + fq * 4 + j) * 72 + (n >> 1) * 32 + (n & 1) * 16 + fr] = f2bf(acc[m][n][j] * w);
            }
          LDSWAIT();
          rows_out_bf16_split(wl, lane, qs + dir * 256, 512, 64);
          LDSWAIT();
        }
      }
    } else {
      int s0; long sb;
      if (!sample) { s0 = row0 & 255; sb = (long)((row0 >> 8) * 4 + hh) * 256 * 256; }
      else { int ts = row0 - TP; s0 = ts & 1023; sb = (long)TP * 1024 + (long)((ts >> 10) * 4 + hh) * 1024 * 256; }
      const int kt = s0 >> 6;
#pragma unroll
      for (int m = 0; m < 4; ++m)
#pragma unroll
        for (int r = 0; r < 2; ++r) {
          uint4 v = *(const uint4*)(wl + (m * 16 + fr) * 144 + (r * 32 + fq * 8) * 2);
          *(uint4*)(p.rt_k + sb + (long)(((kt * 4 + m) * 8 + half * 4 + wc + 2 * r) * 64 + lane) * 8) = v;
        }
      LDSWAIT();
      if (!sample) {
        const int bh = (row0 >> 8) * 4 + hh;
#pragma unroll
        for (int m = 0; m < 4; m += 2) {
          float wf[8], wb[8];
#pragma unroll
          for (int e = 0; e < 8; ++e) {
            int s = s0 + (m + (e >> 2)) * 16 + fq * 4 + (e & 3);
            wf[e] = exp2f(l2f * (float)(255 - s));
            wb[e] = exp2f(l2b * (float)s);
          }
#pragma unroll
          for (int n = 0; n < 4; ++n) {
            int dk = half * 128 + (n >> 1) * 64 + wc * 32 + (n & 1) * 16;
            f32x4 a = acc[m][n], a2 = acc[m + 1][n];
            uint4 of, ob;
            of.x = pk2(a[0] * wf[0], a[1] * wf[1]); of.y = pk2(a[2] * wf[2], a[3] * wf[3]);
            of.z = pk2(a2[0] * wf[4], a2[1] * wf[5]); of.w = pk2(a2[2] * wf[6], a2[3] * wf[7]);
            ob.x = pk2(a[0] * wb[0], a[1] * wb[1]); ob.y = pk2(a[2] * wb[2], a[3] * wb[3]);
            ob.z = pk2(a2[0] * wb[4], a2[1] * wb[5]); ob.w = pk2(a2[2] * wb[6], a2[3] * wb[7]);
            long off = ((long)((kt * 2 + (m >> 1)) * 16 + (dk >> 4)) * 64 + lane) * 8;
            *(uint4*)(p.rt_kT + (long)(bh * 2 + 0) * 65536 + off) = of;
            *(uint4*)(p.rt_kT + (long)(bh * 2 + 1) * 65536 + off) = ob;
          }
        }
      }
    }
  } else if (tn < 32) {
    const int cv0 = (tn - 16) * 128 + wc * 64;
    const int hh = cv0 >> 9;
    int s0; long sb;
    if (!sample) { s0 = row0 & 255; sb = (long)((row0 >> 8) * 4 + hh) * 256 * 512; }
    else { int ts = row0 - TP; s0 = ts & 1023; sb = (long)TP * 2048 + (long)((ts >> 10) * 4 + hh) * 1024 * 512; }
    const int kt = s0 >> 6;
#pragma unroll
    for (int m = 0; m < 4; m += 2)
#pragma unroll
      for (int n = 0; n < 4; ++n) {
        int dvt = ((cv0 & 511) >> 4) + n;
        f32x4 a = acc[m][n], a2 = acc[m + 1][n];
        uint4 o; o.x = pk2(a[0], a[1]); o.y = pk2(a[2], a[3]); o.z = pk2(a2[0], a2[1]); o.w = pk2(a2[2], a2[3]);
        *(uint4*)(p.rt_vF + sb + ((long)((kt * 2 + (m >> 1)) * 32 + dvt) * 64 + lane) * 8) = o;
      }
  } else {
#pragma unroll
    for (int m = 0; m < 4; ++m)
#pragma unroll
      for (int j = 0; j < 4; ++j)
#pragma unroll
        for (int n = 0; n < 4; ++n) wl16[(m * 16 + fq * 4 + j) * 72 + n * 16 + fr] = f2bf(silu_f(acc[m][n][j]));
    LDSWAIT();
    rows_out_bf16(wl, lane, p.rt_sg + (long)row0 * 2048 + (tn - 32) * 128 + wc * 64, 2048);
    LDSWAIT();
  }
}

__device__ __forceinline__ void epi_mlp_in(const Params& p, int tm, int tn, f32x4 (&acc)[4][4], char* smem) {
  const int lane = tidx() & 63, wid = tidx() >> 6, wr = wid >> 1, wc = wid & 1, fr = lane & 15, fq = lane >> 4;
  char* wl = smem + wid * 16384;
  u16* wl16 = (u16*)wl;
  const int row0 = tm * 128 + wr * 64;
  if (tn < 16 || tn >= 32) {
    const bool isu = tn < 16;
    u16* dstb = isu ? p.ml_gu : p.ml_sg;
    const int c0 = (isu ? tn : tn - 32) * 128 + wc * 64;
#pragma unroll
    for (int m = 0; m < 4; ++m)
#pragma unroll
      for (int j = 0; j < 4; ++j)
#pragma unroll
        for (int n = 0; n < 4; ++n) {
          float a = acc[m][n][j];
          wl16[(m * 16 + fq * 4 + j) * 72 + n * 16 + fr] = f2bf(isu ? gelu_f(a) : silu_f(a));
        }
    LDSWAIT();
    rows_out_bf16(wl, lane, dstb + (long)row0 * 2048 + c0, 2048);
    LDSWAIT();
  } else {
    const int c0 = (tn - 16) * 128 + wc * 64;
    float s1[4][4], s2[4][4];
#pragma unroll
    for (int m = 0; m < 4; ++m)
#pragma unroll
      for (int j = 0; j < 4; ++j) { s1[m][j] = 0.f; s2[m][j] = 0.f; }
#pragma unroll
    for (int m = 0; m < 4; ++m)
#pragma unroll
      for (int n = 0; n < 4; ++n)
#pragma unroll
        for (int j = 0; j < 4; ++j) {
          float gq = bf2f(f2bf(gelu_f(acc[m][n][j])));
          acc[m][n][j] = gq;
          s1[m][j] += gq; s2[m][j] += gq * gq;
        }
#pragma unroll
    for (int m = 0; m < 4; m += 2)
#pragma unroll
      for (int n = 0; n < 4; ++n) {
        f32x4 a = acc[m][n], a2 = acc[m + 1][n];
        uint4 o; o.x = pk2(a[0], a[1]); o.y = pk2(a[2], a[3]); o.z = pk2(a2[0], a2[1]); o.w = pk2(a2[2], a2[3]);
        int ks2 = wr * 2 + (m >> 1), ct = (c0 >> 4) + n;
        *(uint4*)(p.ml_vT + ((long)((tm * 4 + ks2) * 128 + ct) * 64 + lane) * 8) = o;
      }
#pragma unroll
    for (int m = 0; m < 4; ++m)
#pragma unroll
      for (int j = 0; j < 4; ++j) {
        float a = s1[m][j], b = s2[m][j];
        a += __shfl_xor(a, 1); a += __shfl_xor(a, 2); a += __shfl_xor(a, 4); a += __shfl_xor(a, 8);
        b += __shfl_xor(b, 1); b += __shfl_xor(b, 2); b += __shfl_xor(b, 4); b += __shfl_xor(b, 8);
        if (fr == 0) {
          int t = row0 + m * 16 + fq * 4 + j;
          float2 st; st.x = a; st.y = b;
          *(float2*)(p.ml_st + ((long)t * 32 + (tn - 16) * 2 + wc) * 2) = st;
        }
      }
  }
}

__device__ __forceinline__ void na_attn_phase(const Params& p, int lj, char* smem) {
  float* s_rpb = (float*)smem;
  const int tid = tidx(), lane = tid & 63, wid = tid >> 6, fr = lane & 15, fq = lane >> 4;
  const unsigned lane8 = lane * 8;
  for (int item = blockIdx.x; item < 3072; item += gridDim.x) {
    f32x4 o[4];
#pragma unroll
    for (int dt = 0; dt < 4; ++dt) o[dt] = f32x4{0.f, 0.f, 0.f, 0.f};
    float l = 0.f;
    bf16x8 qf[2];
    const bool lat = item < 1024;
    int tq0, hh, b, r = 0, rstart = 0, NT;
    const u16 *kbase, *vbase, *ckb = nullptr, *cvb = nullptr;
    if (lat) {
      b = item >> 8; r = item & 15; hh = (item >> 4) & 15;
      const float* rp = p.na_rpb + (long)(lj * 16 + hh) * 465;
      for (int i = tid; i < 465; i += 256) s_rpb[i] = rp[i];
      __syncthreads();
      tq0 = TP + b * 1024 + r * 64 + wid * 16;
      rstart = min(max(r - 4, 0), 8);
      kbase = p.na_k + (long)TP * 1024 + (long)(b * 16 + hh) * 1024 * 64 + rstart * 4096;
      vbase = p.na_vT + (long)TP * 1024 + (long)(b * 16 + hh) * 1024 * 64 + rstart * 4096;
      ckb = p.ck_bf + (long)((b * 2 + lj) * 16 + hh) * 256 * 64;
      cvb = p.cvt_bf + (long)((b * 2 + lj) * 16 + hh) * 256 * 64;
      NT = 12;
    } else {
      int it = item - 1024;
      b = it >> 6; hh = (it >> 2) & 15;
      int qt = it & 3;
      tq0 = b * 256 + qt * 64 + wid * 16;
      kbase = p.na_k + (long)(b * 16 + hh) * 256 * 64;
      vbase = p.na_vT + (long)(b * 16 + hh) * 256 * 64;
      NT = 4;
    }
#pragma unroll
    for (int ks = 0; ks < 2; ++ks) qf[ks] = *(const bf16x8*)(p.na_q + (long)(tq0 + fr) * 1024 + hh * 64 + ks * 32 + fq * 8);
    const int cq = wid * 16 + fr;
    const int cstart = min(max(cq - 8, 0), 48);
    bf16x8 ring[16];
#pragma unroll
    for (int i = 0; i < 8; ++i) { ring[i] = *(const bf16x8*)(kbase + i * 512 + lane8); ring[8 + i] = *(const bf16x8*)(vbase + i * 512 + lane8); }
    for (int tau = 0; tau < NT; ++tau) {
      const bool more = tau + 1 < NT;
      const u16 *kn = kbase, *vn = vbase;
      if (more) {
        if (lat && tau + 1 >= 8) { kn = ckb + (tau + 1 - 8) * 4096; vn = cvb + (tau + 1 - 8) * 4096; }
        else { kn = kbase + (tau + 1) * 4096; vn = vbase + (tau + 1) * 4096; }
      }
      f32x4 s[4];
#pragma unroll
      for (int n = 0; n < 4; ++n) s[n] = f32x4{0.f, 0.f, 0.f, 0.f};
#pragma unroll
      for (int i = 0; i < 8; ++i) {
        s[i >> 1] = MFMA16(ring[i], qf[i & 1], s[i >> 1]);
        if (more) ring[i] = *(const bf16x8*)(kn + i * 512 + lane8);
      }
      if (lat && tau < 8) {
        const float* rb = s_rpb + (rstart + tau - r + 7) * 31;
#pragma unroll
        for (int n = 0; n < 4; ++n)
#pragma unroll
          for (int j = 0; j < 4; ++j) {
            int ck = n * 16 + fq * 4 + j;
            bool valid = (ck >= cstart) && (ck < cstart + 16);
            int coff = min(max(ck - cq + 15, 0), 30);
            float e = __expf(s[n][j] + rb[coff]);
            float pv = valid ? e : 0.f;
            l += pv; s[n][j] = pv;
          }
      } else {
#pragma unroll
        for (int n = 0; n < 4; ++n)
#pragma unroll
          for (int j = 0; j < 4; ++j) { float pv = __expf(s[n][j]); l += pv; s[n][j] = pv; }
      }
      bf16x8 pa0 = pack8(s[0], s[1]), pa1 = pack8(s[2], s[3]);
#pragma unroll
      for (int v = 0; v < 8; ++v) {
        o[v & 3] = MFMA16(v < 4 ? pa0 : pa1, ring[8 + v], o[v & 3]);
        if (more) ring[8 + v] = *(const bf16x8*)(vn + v * 512 + lane8);
      }
    }
    if (lat) __syncthreads();
    l += __shfl_xor(l, 16);
    l += __shfl_xor(l, 32);
#pragma unroll
    for (int j = 0; j < 4; ++j) {
      float lq = __shfl(l, fq * 4 + j);
      float inv = 1.f / lq;
      int t = tq0 + fq * 4 + j;
#pragma unroll
      for (int dt = 0; dt < 4; ++dt) {
        long idx = (long)t * 1024 + hh * 64 + dt * 16 + fr;
        p.na_o[idx] = f2bf(o[dt][j] * inv * bf2f(p.na_sg[idx]));
      }
    }
  }
}

template <bool sample>
__device__ __forceinline__ void ret_main_item(const Params& p, int bh, int qt, char* smem) {
  const int tid = tidx();
  int lane = tid & 63;
  asm volatile("" : "+v"(lane));
  const int fr = lane & 15, fq = lane >> 4;
  const int wid = __builtin_amdgcn_readfirstlane(tid >> 6);
  const int dvh = wid & 1;
  constexpr int S = sample ? 1024 : 256;
  const int tok0 = sample ? TP + (bh >> 2) * 1024 : (bh >> 2) * 256;
  const int hh = bh & 3;
  const int qw = qt * 32 + (wid >> 1) * 16;
  const int qi = qw + fr;
  const float l2f = p.dec[hh], l2b = p.dec[4 + hh];
  const u16* vFb = (sample ? p.rt_vF + (long)TP * 2048 + (long)bh * 1024 * 512 : p.rt_vF + (long)bh * 256 * 512) + dvh * 16 * 512;
  const u16* kFb = sample ? p.rt_k + (long)TP * 1024 + (long)bh * 1024 * 256 : p.rt_k + (long)bh * 256 * 256;
  const unsigned k_lane = fr * 1024 + fq * 8;
  const unsigned lane8 = lane * 8;
  bf16x8* qlds = (bf16x8*)(smem + wid * 8192) + lane;
  {
    const u16* qg = p.rt_q + (long)(tok0 + qw) * 1024 + hh * 256;
#pragma unroll
    for (int ks = 0; ks < 8; ++ks) qlds[ks * 64] = *(const bf16x8*)(qg + ks * 32 + k_lane);
  }
  f32x4 o[16];
#pragma unroll
  for (int dt = 0; dt < 16; ++dt) o[dt] = f32x4{0.f, 0.f, 0.f, 0.f};
#define RFRAG(kt_, i_) ((i_) < 32 ? *(const bf16x8*)(kFb + (kt_) * 16384 + (i_) * 512 + lane8) \
                                  : *(const bf16x8*)(vFb + ((kt_) * 2 + (((i_) - 32) >> 4)) * 16384 + (((i_) - 32) & 15) * 512 + lane8))
  bf16x8 ring[16];
#pragma unroll
  for (int i = 0; i < 16; ++i) ring[i] = RFRAG(0, i);
  constexpr int NKT = S / 64;
  for (int kt = 0; kt < NKT; ++kt) {
    f32x4 s[4];
#pragma unroll
    for (int n = 0; n < 4; ++n) s[n] = f32x4{0.f, 0.f, 0.f, 0.f};
#pragma unroll
    for (int i = 0; i < 32; ++i) {
      s[i >> 3] = MFMA16(ring[i & 15], qlds[(i & 7) * 64], s[i >> 3]);
      ring[i & 15] = RFRAG(kt, i + 16);
    }
#pragma unroll
    for (int n = 0; n < 4; ++n)
#pragma unroll
      for (int j = 0; j < 4; ++j) {
        int d = qi - (kt * 64 + n * 16 + fq * 4 + j);
        float e = (d >= 0 ? l2f : l2b) * fabsf((float)d);
        float w = __builtin_amdgcn_exp2f(e);
        s[n][j] *= (d == 0 ? 2.0f : w);
      }
    bf16x8 pa0 = pack8(s[0], s[1]), pa1 = pack8(s[2], s[3]);
#pragma unroll
    for (int v = 0; v < 32; ++v) {
      o[v & 15] = MFMA16(v < 16 ? pa0 : pa1, ring[v & 15], o[v & 15]);
      if (v < 16) ring[v & 15] = RFRAG(kt, 48 + v);
      else if (kt + 1 < NKT) ring[v & 15] = RFRAG(kt + 1, v - 16);
    }
  }
#undef RFRAG
  if (sample) {
    const u16* qs = p.rt_qs + ((long)bh * 1024 + qw) * 512;
    const u16* sb = p.s0t + (long)bh * 262144 + dvh * 16 * 512;
    const unsigned i_lane = fr * 512 + fq * 8;
#pragma unroll
    for (int dt = 0; dt < 16; ++dt) ring[dt] = *(const bf16x8*)(sb + dt * 512 + lane8);
    bf16x8 a = *(const bf16x8*)(qs + i_lane);
    for (int ks = 0; ks < 16; ++ks) {
      bf16x8 an = a;
      if (ks + 1 < 16) an = *(const bf16x8*)(qs + (ks + 1) * 32 + i_lane);
#pragma unroll
      for (int dt = 0; dt < 16; ++dt) {
        o[dt] = MFMA16(a, ring[dt], o[dt]);
        if (ks + 1 < 16) ring[dt] = *(const bf16x8*)(sb + ((ks + 1) * 32 + dt) * 512 + lane8);
      }
      a = an;
    }
  }
  float* s_st = (float*)(smem + 32768);
  float sm[4], sq[4];
#pragma unroll
  for (int j = 0; j < 4; ++j) {
    float a = 0.f, b = 0.f;
#pragma unroll
    for (int dt = 0; dt < 16; ++dt) { a += o[dt][j]; b += o[dt][j] * o[dt][j]; }
    a += __shfl_xor(a, 1); a += __shfl_xor(a, 2); a += __shfl_xor(a, 4); a += __shfl_xor(a, 8);
    b += __shfl_xor(b, 1); b += __shfl_xor(b, 2); b += __shfl_xor(b, 4); b += __shfl_xor(b, 8);
    sm[j] = a; sq[j] = b;
    if (fr == 0) { s_st[(wid * 16 + fq * 4 + j) * 2] = a; s_st[(wid * 16 + fq * 4 + j) * 2 + 1] = b; }
  }
  __syncthreads();
#pragma unroll
  for (int j = 0; j < 4; ++j) {
    float a = sm[j] + s_st[((wid ^ 1) * 16 + fq * 4 + j) * 2];
    float b = sq[j] + s_st[((wid ^ 1) * 16 + fq * 4 + j) * 2 + 1];
    float mean = a * (1.f / 512.f);
    float var = fmaxf(b * (1.f / 512.f) - mean * mean, 0.f);
    float rstd = rsqrtf(var + 1e-6f);
    const long rowu = (long)(tok0 + qw) * 2048 + hh * 512 + dvh * 256;
    const unsigned o_lane = (fq * 4 + j) * 2048 + fr;
    const float* gw = p.ret_gn_w + hh * 512 + dvh * 256;
#pragma unroll
    for (int dt = 0; dt < 16; ++dt) {
      float val = (o[dt][j] - mean) * rstd * gw[dt * 16 + fr] * bf2f(p.rt_sg[rowu + dt * 16 + o_lane]);
      p.rt_y[rowu + dt * 16 + o_lane] = f2bf(val);
    }
  }
  __syncthreads();
}

__device__ __forceinline__ void ret_state_item(const Params& p, int x, char* smem) {
  const int lane = tidx() & 63, wid = tidx() >> 6, wr = wid >> 1, wc = wid & 1;
  float* wl = (float*)(smem + wid * 16384);
  int mat = x >> 3, tile = x & 7, tmm = tile >> 2, tnn = tile & 3;
  f32x4 acc[4][4];
#pragma unroll
  for (int m = 0; m < 4; ++m)
#pragma unroll
    for (int n = 0; n < 4; ++n) acc[m][n] = f32x4{0.f, 0.f, 0.f, 0.f};
  const u16* ka = p.rt_kT + (long)mat * 65536 + (tmm * 8 + wr * 4) * 512;
  const u16* vb = p.rt_vF + (long)(mat >> 1) * 256 * 512 + (tnn * 8 + wc * 4) * 512;
  const unsigned lane8 = lane * 8;
#pragma unroll 2
  for (int kk = 0; kk < 8; ++kk) {
    bf16x8 af[4], bfr[4];
#pragma unroll
    for (int m = 0; m < 4; ++m) af[m] = *(const bf16x8*)(ka + kk * (16 * 512) + m * 512 + lane8);
#pragma unroll
    for (int n = 0; n < 4; ++n) bfr[n] = *(const bf16x8*)(vb + kk * (32 * 512) + n * 512 + lane8);
#pragma unroll
    for (int m = 0; m < 4; ++m)
#pragma unroll
      for (int n = 0; n < 4; ++n) acc[m][n] = MFMA16(af[m], bfr[n], acc[m][n]);
  }
  int bh = mat >> 1, dir = mat & 1, b = bh >> 2, hh = bh & 3;
  const int fr = lane & 15, fq = lane >> 4;
  float* outb = p.new_ret + ((long)((b * 2 + dir) * 4 + hh) * 256 + tmm * 128 + wr * 64) * 512 + tnn * 128 + wc * 64;
#pragma unroll
  for (int a = 0; a < 2; ++a) {
#pragma unroll
    for (int mm = 0; mm < 2; ++mm)
#pragma unroll
      for (int j = 0; j < 4; ++j)
#pragma unroll
        for (int n = 0; n < 4; ++n) wl[(mm * 16 + fq * 4 + j) * 68 + n * 16 + fr] = acc[2 * a + mm][n][j];
    LDSWAIT();
    rows_out_f32(wl, lane, [&](int row, int ch, float4 v) { *(float4*)(outb + (long)(a * 32 + row) * 512 + ch * 4) = v; });
    LDSWAIT();
  }
  __syncthreads();
}

__device__ __forceinline__ void ret_phase(const Params& p, char* smem) {
  for (int it = blockIdx.x; it < 3584; it += gridDim.x) {
    if (it < 512) ret_main_item<true>(p, it >> 5, it & 31, smem);
    else if (it < 1536) { int x = it - 512; ret_main_item<false>(p, x >> 3, x & 7, smem); }
    else ret_state_item(p, it - 1536, smem);
  }
}

__device__ __forceinline__ void mlp_spatial_phase(const Params& p, char* smem) {
  float* s_mu = (float*)smem;
  float* s_rs = s_mu + 128;
  const int tid = tidx(), lane = tid & 63, wid = tid >> 6, wr = wid >> 1, wc = wid & 1, fr = lane & 15, fq = lane >> 4;
  for (int item = blockIdx.x; item < 1536; item += gridDim.x) {
    int chunk = item >> 4, g = (item >> 1) & 7, dh = item & 1;
    if (tid < 128) {
      const float4* st = (const float4*)(p.ml_st + ((long)(chunk * 128 + tid) * 32) * 2);
      float a = 0.f, b = 0.f;
#pragma unroll
      for (int i = 0; i < 16; ++i) { float4 v = st[i]; a += v.x + v.z; b += v.y + v.w; }
      float mu = a * (1.f / 2048.f);
      float var = b * (1.f / 2048.f) - mu * mu;
      s_mu[tid] = mu;
      s_rs[tid] = rsqrtf(fmaxf(var, 0.f) + 1e-6f);
    }
    __syncthreads();
    f32x4 acc[4][4];
#pragma unroll
    for (int m = 0; m < 4; ++m)
#pragma unroll
      for (int n = 0; n < 4; ++n) acc[m][n] = f32x4{0.f, 0.f, 0.f, 0.f};
    const int cb = g * 256 + dh * 128 + wc * 64;
    float lw[4], lb[4];
#pragma unroll
    for (int n = 0; n < 4; ++n) { lw[n] = p.mlp_ln_w[cb + n * 16 + fr]; lb[n] = p.mlp_ln_b[cb + n * 16 + fr]; }
#pragma unroll
    for (int ks = 0; ks < 4; ++ks) {
      bf16x8 af[4], bfr[4];
#pragma unroll
      for (int m = 0; m < 4; ++m) {
        const u16* wrow = p.ws_bf + ((long)g * 128 + wr * 64 + m * 16 + fr) * 128 + fq * 4;
        bf16x4 w0 = *(const bf16x4*)(wrow + (2 * ks) * 16);
        bf16x4 w1 = *(const bf16x4*)(wrow + (2 * ks + 1) * 16);
        af[m] = __builtin_shufflevector(w0, w1, 0, 1, 2, 3, 4, 5, 6, 7);
      }
      float mu[8], rs[8];
#pragma unroll
      for (int e = 0; e < 8; ++e) { int jx = (2 * ks + (e >> 2)) * 16 + fq * 4 + (e & 3); mu[e] = s_mu[jx]; rs[e] = s_rs[jx]; }
#pragma unroll
      for (int n = 0; n < 4; ++n) {
        bf16x8 raw = *(const bf16x8*)(p.ml_vT + ((long)((chunk * 4 + ks) * 128 + (cb >> 4) + n) * 64 + lane) * 8);
        bf16x8 nv;
#pragma unroll
        for (int e = 0; e < 8; ++e) nv[e] = (short)f2bf((bf2f((u16)raw[e]) - mu[e]) * rs[e] * lw[n] + lb[n]);
        bfr[n] = nv;
      }
#pragma unroll
      for (int m = 0; m < 4; ++m)
#pragma unroll
        for (int n = 0; n < 4; ++n) acc[m][n] = MFMA16(af[m], bfr[n], acc[m][n]);
    }
#pragma unroll
    for (int m = 0; m < 4; ++m)
#pragma unroll
      for (int j = 0; j < 4; ++j) {
        int i = wr * 64 + m * 16 + fq * 4 + j;
        float bs = p.mlp_b_s[g * 128 + i];
        long rowb = (long)(chunk * 128 + i) * 2048;
#pragma unroll
        for (int n = 0; n < 4; ++n) {
          long idx = rowb + cb + n * 16 + fr;
          float sv = acc[m][n][j] + bs;
          p.ml_o[idx] = f2bf(bf2f(p.ml_gu[idx]) * sv * bf2f(p.ml_sg[idx]));
        }
      }
    __syncthreads();
  }
}


#define XB_TMO      128
#define XB_XCNT(j)  (256  + 64 * (j))
#define XB_XSUB(j)  (1280 + 64 * (j))
#define XB_XGEN(j)  (2304 + 64 * (j))
#define XB_TOP      3328
#define XB_TOPGEN   3392
#define XCD_BAR_WORDS 3456
#define XB_SPIN_CAP (1u << 22)
#define LAS __attribute__((address_space(3)))
__device__ __forceinline__ unsigned xb_ld(unsigned* p)              { return __hip_atomic_load(p, __ATOMIC_RELAXED, __HIP_MEMORY_SCOPE_AGENT); }
__device__ __forceinline__ unsigned xb_add(unsigned* p, unsigned v) { return __hip_atomic_fetch_add(p, v, __ATOMIC_RELAXED, __HIP_MEMORY_SCOPE_AGENT); }
__device__ __forceinline__ unsigned xb_xcc_id() { return (unsigned)__builtin_amdgcn_s_getreg((3 << 11) | 20) & 0xFu; }
#define XB_SPIN(cond, bar) do { unsigned _sp = 0; while (cond) { __builtin_amdgcn_s_sleep(1); \
    if ((++_sp & 255u) == 0u) { if (xb_ld(&(bar)[XB_TMO])) break; if (_sp > XB_SPIN_CAP) { atomicAdd(&(bar)[XB_TMO], 1u); break; } } } } while (0)
struct XcdBarrier { unsigned* bar; unsigned x; volatile LAS unsigned* st; };
__device__ __forceinline__ XcdBarrier xcd_barrier_post(unsigned* bar, volatile LAS unsigned* st) {
  XcdBarrier b; b.bar = bar; b.x = xb_xcc_id(); b.st = st;
  if (threadIdx.x == 0) (void)xb_add(&bar[XB_XCNT(b.x)], 1u);
  return b;
}
__device__ __forceinline__ void xcd_barrier_complete(unsigned* bar, unsigned x, unsigned& nloc, unsigned& nx) {
  const unsigned G = gridDim.x * gridDim.y * gridDim.z;
  unsigned sum, cnt, mine, sp = 0u;
  for (;;) {
    sum = 0u; cnt = 0u; mine = 0u;
#pragma unroll
    for (unsigned j = 0; j < 16; ++j) { const unsigned c = xb_ld(&bar[XB_XCNT(j)]); sum += c; cnt += (c > 0u) ? 1u : 0u; mine = (j == x) ? c : mine; }
    if (sum == G) break;
    __builtin_amdgcn_s_sleep(1);
    if ((++sp & 255u) == 0u) { if (xb_ld(&bar[XB_TMO])) break; if (sp > XB_SPIN_CAP) { atomicAdd(&bar[XB_TMO], 1u); break; } }
  }
  nloc = mine > 0u ? mine : 1u; nx = cnt > 0u ? cnt : 1u;
}
__device__ __forceinline__ void xcd_barrier(const XcdBarrier& b) {
  asm volatile("s_waitcnt vmcnt(0)" ::: "memory");
  __syncthreads();
  if (threadIdx.x == 0) {
    unsigned* bar = b.bar;
    __builtin_amdgcn_s_waitcnt(0);
    unsigned nloc = b.st[0], nx = b.st[1];
    if (nloc == 0u) { xcd_barrier_complete(bar, b.x, nloc, nx); b.st[0] = nloc; b.st[1] = nx; }
    const unsigned old = xb_add(&bar[XB_XSUB(b.x)], 1u);
    const unsigned gen = old / nloc;
    if (old + 1u == (gen + 1u) * nloc) {
      __builtin_amdgcn_fence(__ATOMIC_RELEASE, "agent");
      asm volatile("s_waitcnt vmcnt(0)" ::: "memory");
      const unsigned og = xb_add(&bar[XB_TOP], 1u);
      const unsigned tg = og / nx;
      if (og + 1u == (tg + 1u) * nx) xb_add(&bar[XB_TOPGEN], 1u);
      else XB_SPIN(xb_ld(&bar[XB_TOPGEN]) == tg, bar);
      __builtin_amdgcn_fence(__ATOMIC_ACQUIRE, "agent");
      xb_add(&bar[XB_XGEN(b.x)], 1u);
      asm volatile("s_waitcnt vmcnt(0)" ::: "memory");
    } else {
      XB_SPIN(xb_ld(&bar[XB_XGEN(b.x)]) == gen, bar);
      __builtin_amdgcn_fence(__ATOMIC_ACQUIRE, "agent");
      asm volatile("s_waitcnt vmcnt(0)" ::: "memory");
    }
  }
  __syncthreads();
}

__device__ __forceinline__ void run_phase(const Params& p, int ph, char* smem) {
  if (ph == 0) { prep_phase(p, smem); return; }
  const int layer = (ph - 1) >> 2, sub = (ph - 1) & 3;
  const int kind = layer % 3, lj = layer / 3;
  const float* xp = layer == 0 ? p.x_prompt : p.X;
  const float* xs = layer == 0 ? p.x_sample : p.X + (long)TP * 1024;
  float* xout = layer == 3 ? p.y_out : p.X;
  if (sub == 0) { norm_phase(p, layer, xp, xs); return; }
  if (sub == 1) {
    if (kind == 0) {
      const u16* W = p.wt_na_in + (long)lj * 4096 * 1024;
      for (int t = blockIdx.x; t < 96 * 32; t += gridDim.x) {
        int tn = t & 31, tm = t >> 5;
        f32x4 acc[4][4];
        gemm_core(p.h + (long)tm * 128 * 1024, 1024, W + (long)tn * 128 * 1024, 1024, 1024, smem, acc);
        epi_na_in(p, lj, tm, tn, acc, smem);
        __syncthreads();
      }
    } else {
      const u16* W = kind == 1 ? p.wt_ret_in : p.wt_mlp_in;
      for (int t = blockIdx.x; t < 96 * 48; t += gridDim.x) {
        int tn = t % 48, tm = t / 48;
        f32x4 acc[4][4];
        gemm_core(p.h + (long)tm * 128 * 1024, 1024, W + (long)tn * 128 * 1024, 1024, 1024, smem, acc);
        if (kind == 1) epi_ret_in(p, tm, tn, acc, smem); else epi_mlp_in(p, tm, tn, acc, smem);
        __syncthreads();
      }
    }
    return;
  }
  if (sub == 2) {
    if (kind == 0) na_attn_phase(p, lj, smem);
    else if (kind == 1) ret_phase(p, smem);
    else mlp_spatial_phase(p, smem);
    return;
  }
  {
    const u16* A; const u16* W; int K;
    if (kind == 0) { A = p.na_o; W = p.wt_na_out + (long)lj * 1024 * 1024; K = 1024; }
    else if (kind == 1) { A = p.rt_y; W = p.wt_ret_out; K = 2048; }
    else { A = p.ml_o; W = p.wt_mlp_out; K = 2048; }
    for (int t = blockIdx.x; t < 96 * 8; t += gridDim.x) {
      int tn = t & 7, tm = t >> 3;
      f32x4 acc[4][4];
      gemm_core(A + (long)tm * 128 * K, K, W + (long)tn * 128 * K, K, K, smem, acc);
      epi_resid(p, layer, xp, xs, xout, tm, tn, acc, smem);
      __syncthreads();
    }
  }
}

#define NPHASE 17
#ifndef PROBE_MASK
#define PROBE_MASK 0
#endif

__global__ void __launch_bounds__(256, 2) mega_kernel(Params p) {
  __shared__ __attribute__((aligned(16))) char smem[65536];
  __shared__ uint4 xb_words;
  cg::grid_group grid = cg::this_grid();
  if (threadIdx.x == 0) xb_words = make_uint4(0u, 0u, 0u, 0u);
  __syncthreads();
  XcdBarrier xb = xcd_barrier_post(p.bar, (volatile LAS unsigned*)&xb_words);
  if (p.bar == nullptr) grid.sync();
#pragma nounroll
  for (int ph = 0; ph < NPHASE; ++ph) {
    int phv = ph;
    asm volatile("" : "+s"(phv));
    run_phase(p, phv, smem);
#if PROBE_MASK
    {
      int sub = (ph - 1) & 3, kind = ((ph - 1) >> 2) % 3;
      int cls = ph == 0 ? 1 : (sub == 0 ? 2 : (sub == 1 ? 4 : (sub == 2 ? (8 << kind) : 64)));
      if (cls & PROBE_MASK) { xcd_barrier(xb); run_phase(p, phv, smem); }
    }
#endif
    if (ph + 1 < NPHASE) xcd_barrier(xb);
  }
}

#ifndef MULTI_LAUNCH
#define MULTI_LAUNCH 0
#endif

extern "C" void kernel_launch(void* const* d_in, const int* in_sizes, int n_in, void* d_out, int out_size, void* d_ws,
                              size_t ws_size, hipStream_t stream) {
  Params p{};
  p.x_prompt = (const float*)d_in[0];  p.x_sample = (const float*)d_in[1];
  p.cache_k = (const float*)d_in[2];   p.cache_v = (const float*)d_in[3];
  p.state_ret = (const float*)d_in[4]; p.c = (const float*)d_in[5];
  p.c_ctx = (const float*)d_in[6];     p.norm_w = (const float*)d_in[7];
  p.w_ada = (const float*)d_in[8];     p.b_ada = (const float*)d_in[9];
  p.na_w_in = (const float*)d_in[10];  p.na_w_out = (const float*)d_in[11];
  p.na_q_gain = (const float*)d_in[12]; p.na_k_gain = (const float*)d_in[13];
  p.na_rpb = (const float*)d_in[14];
  p.ret_w_in = (const float*)d_in[15]; p.ret_w_out = (const float*)d_in[16];
  p.ret_decay = (const float*)d_in[17]; p.ret_gn_w = (const float*)d_in[18];
  p.mlp_w_in = (const float*)d_in[19]; p.mlp_ln_w = (const float*)d_in[20];
  p.mlp_ln_b = (const float*)d_in[21]; p.mlp_w_s = (const float*)d_in[22];
  p.mlp_b_s = (const float*)d_in[23];  p.mlp_w_out = (const float*)d_in[24];
  float* out = (float*)d_out;
  p.y_out = out;
  p.new_k = out + (long)TT * 1024;
  p.new_v = p.new_k + (long)32 * 2 * 256 * 1024;
  p.new_ret = p.new_v + (long)32 * 2 * 256 * 1024;

  char* w = (char*)d_ws;
  size_t off = 0;
  auto take = [&](size_t bytes) { char* r = w + off; off += (bytes + 255) & ~(size_t)255; return r; };
  p.wt_na_in = (u16*)take((size_t)2 * 4096 * 1024 * 2);
  p.wt_na_out = (u16*)take((size_t)2 * 1024 * 1024 * 2);
  p.wt_ret_in = (u16*)take((size_t)6144 * 1024 * 2);
  p.wt_ret_out = (u16*)take((size_t)1024 * 2048 * 2);
  p.wt_mlp_in = (u16*)take((size_t)6144 * 1024 * 2);
  p.wt_mlp_out = (u16*)take((size_t)1024 * 2048 * 2);
  p.ws_bf = (u16*)take((size_t)8 * 128 * 128 * 2);
  p.ck_bf = (u16*)take((size_t)4 * 2 * 256 * 1024 * 2);
  p.cvt_bf = (u16*)take((size_t)4 * 2 * 256 * 1024 * 2);
  p.s0t = (u16*)take((size_t)16 * 512 * 512 * 2);
  p.mod = (float*)take((size_t)4 * 5 * 3072 * 4);
  p.ropetab = (float*)take((size_t)4096 * 2 * 4);
  p.dec = (float*)take(256);
  p.bar = (unsigned*)take((size_t)XCD_BAR_WORDS * 4);
  p.X = (float*)take((size_t)TT * 1024 * 4);
  p.h = (u16*)take((size_t)TT * 1024 * 2);
  size_t region = off;
  p.na_q = (u16*)take((size_t)TT * 1024 * 2);
  p.na_k = (u16*)take((size_t)TT * 1024 * 2);
  p.na_vT = (u16*)take((size_t)TT * 1024 * 2);
  p.na_sg = (u16*)take((size_t)TT * 1024 * 2);
  p.na_o = (u16*)take((size_t)TT * 1024 * 2);
  off = region;
  p.rt_q = (u16*)take((size_t)TT * 1024 * 2);
  p.rt_k = (u16*)take((size_t)TT * 1024 * 2);
  p.rt_qs = (u16*)take((size_t)16 * 1024 * 512 * 2);
  p.rt_kT = (u16*)take((size_t)256 * 256 * 256 * 2);
  p.rt_vT = (u16*)take((size_t)TP * 2048 * 2);
  p.rt_vF = (u16*)take((size_t)TT * 2048 * 2);
  p.rt_sg = (u16*)take((size_t)TT * 2048 * 2);
  p.rt_y = (u16*)take((size_t)TT * 2048 * 2);
  off = region;
  p.ml_gu = (u16*)take((size_t)TT * 2048 * 2);
  p.ml_vT = (u16*)take((size_t)TT * 2048 * 2);
  p.ml_sg = (u16*)take((size_t)TT * 2048 * 2);
  p.ml_o = (u16*)take((size_t)TT * 2048 * 2);
  p.ml_st = (float*)take((size_t)TT * 64 * 4);

  static int grid_blocks = 0;
  if (!grid_blocks) {
    int dev = 0, cus = 0, per_cu = 0;
    (void)hipGetDevice(&dev);
    (void)hipDeviceGetAttribute(&cus, hipDeviceAttributeMultiprocessorCount, dev);
    (void)hipOccupancyMaxActiveBlocksPerMultiprocessor(&per_cu, mega_kernel, 256, 0);
    if (per_cu > 2) per_cu = 2;
    if (per_cu < 1) per_cu = 1;
    grid_blocks = cus * per_cu;
  }
  (void)hipMemsetAsync(p.bar, 0, (size_t)XCD_BAR_WORDS * 4, stream);
  void* args[] = {&p};
  hipError_t e = hipLaunchCooperativeKernel((void*)mega_kernel, dim3(grid_blocks), dim3(256), args, 0, stream);
  if (e != hipSuccess) fprintf(stderr, "cooperative launch failed: %s (grid %d)\n", hipGetErrorString(e), grid_blocks);
}
```

```cpp
#include <hip/hip_runtime.h>
#include <hip/hip_cooperative_groups.h>
#include <cstdio>
namespace cg = cooperative_groups;

typedef unsigned short u16;
using bf16x8 = __attribute__((ext_vector_type(8))) short;
using bf16x4 = __attribute__((ext_vector_type(4))) short;
using f32x4  = __attribute__((ext_vector_type(4))) float;

#define TP 8192
#define TS 4096
#define TT 12288

struct Params {
  const float *x_prompt, *x_sample, *cache_k, *cache_v, *state_ret, *c, *c_ctx, *norm_w, *w_ada, *b_ada;
  const float *na_w_in, *na_w_out, *na_q_gain, *na_k_gain, *na_rpb;
  const float *ret_w_in, *ret_w_out, *ret_decay, *ret_gn_w;
  const float *mlp_w_in, *mlp_ln_w, *mlp_ln_b, *mlp_w_s, *mlp_b_s, *mlp_w_out;
  float* out;
  char* ws;
};
#define WSB_wt_na_in ((u16*)(p.ws + 0ULL))
#define WSB_wt_na_out ((u16*)(p.ws + 16777216ULL))
#define WSB_wt_ret_in ((u16*)(p.ws + 20971520ULL))
#define WSB_wt_ret_out ((u16*)(p.ws + 33554432ULL))
#define WSB_wt_mlp_in ((u16*)(p.ws + 37748736ULL))
#define WSB_wt_mlp_out ((u16*)(p.ws + 50331648ULL))
#define WSB_ws_bf ((u16*)(p.ws + 54525952ULL))
#define WSB_ck_bf ((u16*)(p.ws + 54788096ULL))
#define WSB_cvt_bf ((u16*)(p.ws + 58982400ULL))
#define WSB_s0t ((u16*)(p.ws + 63176704ULL))
#define WSB_mod ((float*)(p.ws + 71565312ULL))
#define WSB_ropetab ((float*)(p.ws + 71811072ULL))
#define WSB_dec ((float*)(p.ws + 71843840ULL))
#define WSB_bar ((unsigned*)(p.ws + 71844096ULL))
#define WSB_X ((float*)(p.ws + 71857920ULL))
#define WSB_h ((u16*)(p.ws + 122189568ULL))
#define WSB_na_q ((u16*)(p.ws + 147355392ULL))
#define WSB_na_k ((u16*)(p.ws + 172521216ULL))
#define WSB_na_vT ((u16*)(p.ws + 197687040ULL))
#define WSB_na_sg ((u16*)(p.ws + 222852864ULL))
#define WSB_na_o ((u16*)(p.ws + 248018688ULL))
#define WSB_rt_q ((u16*)(p.ws + 147355392ULL))
#define WSB_rt_k ((u16*)(p.ws + 172521216ULL))
#define WSB_rt_qs ((u16*)(p.ws + 197687040ULL))
#define WSB_rt_kT ((u16*)(p.ws + 214464256ULL))
#define WSB_rt_vF ((u16*)(p.ws + 248018688ULL))
#define WSB_rt_sg ((u16*)(p.ws + 298350336ULL))
#define WSB_rt_y ((u16*)(p.ws + 348681984ULL))
#define WSB_ml_gu ((u16*)(p.ws + 147355392ULL))
#define WSB_ml_vT ((u16*)(p.ws + 197687040ULL))
#define WSB_ml_sg ((u16*)(p.ws + 248018688ULL))
#define WSB_ml_o ((u16*)(p.ws + 298350336ULL))
#define WSB_ml_st ((float*)(p.ws + 348681984ULL))
#define WSB_y_out (p.out + 0ULL)
#define WSB_new_k (p.out + 12582912ULL)
#define WSB_new_v (p.out + 29360128ULL)
#define WSB_new_ret (p.out + 46137344ULL)


typedef unsigned u32x4_t __attribute__((ext_vector_type(4)));
typedef __bf16 bf16v2_t __attribute__((ext_vector_type(2)));
typedef float f32v2_t __attribute__((ext_vector_type(2)));
__device__ __forceinline__ unsigned pk2(float a, float b) {
  f32v2_t v = {a, b};
  bf16v2_t r = __builtin_convertvector(v, bf16v2_t);
  return __builtin_bit_cast(unsigned, r);
}
__device__ __forceinline__ u16 f2bf(float f) { return (u16)(pk2(f, f) & 0xffffu); }
__device__ __forceinline__ float bf2f(u16 h) { return __uint_as_float(((unsigned)h) << 16); }
__device__ __forceinline__ bf16x8 pack8(f32x4 a, f32x4 b) {
  u32x4_t r;
  r[0] = pk2(a[0], a[1]); r[1] = pk2(a[2], a[3]); r[2] = pk2(b[0], b[1]); r[3] = pk2(b[2], b[3]);
  return __builtin_bit_cast(bf16x8, r);
}
__device__ __forceinline__ void store4bf(u16* dst, float a, float b, float c, float d) {
  uint2 v; v.x = pk2(a, b); v.y = pk2(c, d);
  *(uint2*)dst = v;
}
__device__ __forceinline__ float silu_f(float x) { return x * __builtin_amdgcn_rcpf(1.f + __expf(-x)); }
__device__ __forceinline__ float gelu_f(float x) {
  float z = 0.7978845608028654f * (x + 0.044715f * x * x * x);
  float t = 1.f - 2.f * __builtin_amdgcn_rcpf(__expf(2.f * z) + 1.f);
  return 0.5f * x * (1.f + t);
}
__device__ __forceinline__ void st2bf(u16* base, int i0, int i1, float a, float b) {
  unsigned v = pk2(a, b);
  base[i0] = (u16)(v & 0xffffu);
  base[i1] = (u16)(v >> 16);
}
__device__ __forceinline__ int tidx() { int t = threadIdx.x; asm volatile("" : "+v"(t)); return t; }
#define MFMA16(a, b, c) __builtin_amdgcn_mfma_f32_16x16x32_bf16((a), (b), (c), 0, 0, 0)

__device__ __forceinline__ void gemm_core(const u16* __restrict__ A, long lda, const u16* __restrict__ B, long ldb,
                                          int K, char* smem, f32x4 (&acc)[4][4]) {
  const int tid = tidx(), lane = tid & 63, wid = tid >> 6, wr = wid >> 1, wc = wid & 1, fr = lane & 15, fq = lane >> 4;
#pragma unroll
  for (int m = 0; m < 4; ++m)
#pragma unroll
    for (int n = 0; n < 4; ++n) acc[m][n] = f32x4{0.f, 0.f, 0.f, 0.f};
  const int nk = K >> 6;
  const int r0 = tid >> 3, c0 = (tid & 7) ^ ((r0 >> 1) & 7);
  const u16* ap = A + (long)r0 * lda + c0 * 8;
  const u16* bp = B + (long)r0 * ldb + c0 * 8;
  const long sa32 = 32 * lda, sb32 = 32 * ldb;
  uint4 ga0, ga1, ga2, ga3, gb0, gb1, gb2, gb3, ha0, ha1, ha2, ha3, hb0, hb1, hb2, hb3;
  char* lw = smem + tid * 16;
#define GLOAD(P, kt) { P##a0 = *(const uint4*)(ap + (kt) * 64); P##a1 = *(const uint4*)(ap + sa32 + (kt) * 64); \
    P##a2 = *(const uint4*)(ap + 2 * sa32 + (kt) * 64); P##a3 = *(const uint4*)(ap + 3 * sa32 + (kt) * 64); \
    P##b0 = *(const uint4*)(bp + (kt) * 64); P##b1 = *(const uint4*)(bp + sb32 + (kt) * 64); \
    P##b2 = *(const uint4*)(bp + 2 * sb32 + (kt) * 64); P##b3 = *(const uint4*)(bp + 3 * sb32 + (kt) * 64); }
#define LWRITE(P, b) { char* l_ = lw + (b) * 32768; \
    *(uint4*)(l_) = P##a0; *(uint4*)(l_ + 4096) = P##a1; *(uint4*)(l_ + 8192) = P##a2; *(uint4*)(l_ + 12288) = P##a3; \
    *(uint4*)(l_ + 16384) = P##b0; *(uint4*)(l_ + 20480) = P##b1; *(uint4*)(l_ + 24576) = P##b2; *(uint4*)(l_ + 28672) = P##b3; }
  auto compute = [&](int b) {
    const char* sa = smem + b * 32768;
    const char* sb = sa + 16384;
#pragma unroll
    for (int ks = 0; ks < 2; ++ks) {
      bf16x8 af[4], bfr[4];
#pragma unroll
      for (int m = 0; m < 4; ++m) {
        int r = wr * 64 + m * 16 + fr;
        af[m] = *(const bf16x8*)(sa + (r * 8 + ((ks * 4 + fq) ^ ((r >> 1) & 7))) * 16);
      }
#pragma unroll
      for (int n = 0; n < 4; ++n) {
        int r = wc * 64 + n * 16 + fr;
        bfr[n] = *(const bf16x8*)(sb + (r * 8 + ((ks * 4 + fq) ^ ((r >> 1) & 7))) * 16);
      }
#pragma unroll
      for (int m = 0; m < 4; ++m)
#pragma unroll
        for (int n = 0; n < 4; ++n) acc[m][n] = MFMA16(af[m], bfr[n], acc[m][n]);
    }
  };
  GLOAD(g, 0);
  GLOAD(h, 1);
  LWRITE(g, 0);
  __syncthreads();
  for (int t = 0; t < nk; t += 2) {
    if (t + 2 < nk) GLOAD(g, t + 2);
    __builtin_amdgcn_sched_barrier(0);
    compute(0);
    __builtin_amdgcn_sched_barrier(0);
    LWRITE(h, 1);
    __syncthreads();
    if (t + 3 < nk) GLOAD(h, t + 3);
    __builtin_amdgcn_sched_barrier(0);
    compute(1);
    __builtin_amdgcn_sched_barrier(0);
    if (t + 2 < nk) LWRITE(g, 0);
    __syncthreads();
  }
#undef GLOAD
#undef LWRITE
}


__device__ __forceinline__ int swz4(int r) { return (4 - ((r >> 2) & 3)) & 3; }
__device__ __forceinline__ void gemm_core_w(const u16* __restrict__ A, long lda, const u16* __restrict__ B, long ldb,
                                            int K, char* smem, f32x4 (&acc)[4][8]) {
  const int tid = tidx(), lane = tid & 63, wid = tid >> 6, wr = wid >> 1, wc = wid & 1, fr = lane & 15, fq = lane >> 4;
#pragma unroll
  for (int m = 0; m < 4; ++m)
#pragma unroll
    for (int n = 0; n < 8; ++n) acc[m][n] = f32x4{0.f, 0.f, 0.f, 0.f};
  const int nk = K >> 5;
  const int r0 = tid >> 2, c0 = (tid & 3) ^ swz4(r0);
  const u16* ap = A + (long)r0 * lda + c0 * 8;
  const u16* bp = B + (long)r0 * ldb + c0 * 8;
  const long sa64 = 64 * lda, sb64 = 64 * ldb;
  uint4 ga0, ga1, gb0, gb1, gb2, gb3, ha0, ha1, hb0, hb1, hb2, hb3;
  char* lw = smem + tid * 16;
#define GLOADW(P, kt) { P##a0 = *(const uint4*)(ap + (kt) * 32); P##a1 = *(const uint4*)(ap + sa64 + (kt) * 32); \
    P##b0 = *(const uint4*)(bp + (kt) * 32); P##b1 = *(const uint4*)(bp + sb64 + (kt) * 32); \
    P##b2 = *(const uint4*)(bp + 2 * sb64 + (kt) * 32); P##b3 = *(const uint4*)(bp + 3 * sb64 + (kt) * 32); }
#define LWRITEW(P, b) { char* l_ = lw + (b) * 24576; \
    *(uint4*)(l_) = P##a0; *(uint4*)(l_ + 4096) = P##a1; \
    *(uint4*)(l_ + 8192) = P##b0; *(uint4*)(l_ + 12288) = P##b1; *(uint4*)(l_ + 16384) = P##b2; *(uint4*)(l_ + 20480) = P##b3; }
  auto compute = [&](int b) {
    const char* sa = smem + b * 24576;
    const char* sb = sa + 8192;
    bf16x8 af[4];
#pragma unroll
    for (int m = 0; m < 4; ++m) {
      int r = wr * 64 + m * 16 + fr;
      af[m] = *(const bf16x8*)(sa + (r * 4 + (fq ^ swz4(r))) * 16);
    }
#pragma unroll
    for (int nh = 0; nh < 2; ++nh) {
      bf16x8 bfr[4];
#pragma unroll
      for (int n = 0; n < 4; ++n) {
        int r = wc * 128 + (nh * 4 + n) * 16 + fr;
        bfr[n] = *(const bf16x8*)(sb + (r * 4 + (fq ^ swz4(r))) * 16);
      }
#pragma unroll
      for (int m = 0; m < 4; ++m)
#pragma unroll
        for (int n = 0; n < 4; ++n) acc[m][nh * 4 + n] = MFMA16(af[m], bfr[n], acc[m][nh * 4 + n]);
    }
  };
  GLOADW(g, 0);
  GLOADW(h, 1);
  LWRITEW(g, 0);
  __syncthreads();
  for (int t = 0; t < nk; t += 2) {
    if (t + 2 < nk) GLOADW(g, t + 2);
    __builtin_amdgcn_sched_barrier(0);
    compute(0);
    __builtin_amdgcn_sched_barrier(0);
    LWRITEW(h, 1);
    __syncthreads();
    if (t + 3 < nk) GLOADW(h, t + 3);
    __builtin_amdgcn_sched_barrier(0);
    compute(1);
    __builtin_amdgcn_sched_barrier(0);
    if (t + 2 < nk) LWRITEW(g, 0);
    __syncthreads();
  }
#undef GLOADW
#undef LWRITEW
}

__device__ __forceinline__ void adaln_item(const Params& p, int it, char* smem) {
  const int tid = tidx();
  int layer = it / 192, n0 = (it % 192) * 16;
  float* s_c = (float*)smem;
  float* s_p = s_c + 5120;
  for (int idx = tid; idx < 5120; idx += 256) {
    int v = idx >> 10, kk = idx & 1023;
    float cv = (v == 0) ? p.c_ctx[kk] : p.c[(v - 1) * 1024 + kk];
    s_c[idx] = silu_f(cv);
  }
  __syncthreads();
  int cl = tid & 3, ksl = tid >> 2;
  const float* w = p.w_ada + (long)layer * 1024 * 3072 + n0 + cl * 4;
  float4 a0 = {0, 0, 0, 0}, a1 = a0, a2 = a0, a3 = a0, a4 = a0;
#pragma unroll
  for (int kk = 0; kk < 16; ++kk) {
    int k = ksl * 16 + kk;
    float4 w4 = *(const float4*)(w + (long)k * 3072);
    float c0 = s_c[k], c1 = s_c[1024 + k], c2 = s_c[2048 + k], c3 = s_c[3072 + k], c4 = s_c[4096 + k];
    a0.x += c0 * w4.x; a0.y += c0 * w4.y; a0.z += c0 * w4.z; a0.w += c0 * w4.w;
    a1.x += c1 * w4.x; a1.y += c1 * w4.y; a1.z += c1 * w4.z; a1.w += c1 * w4.w;
    a2.x += c2 * w4.x; a2.y += c2 * w4.y; a2.z += c2 * w4.z; a2.w += c2 * w4.w;
    a3.x += c3 * w4.x; a3.y += c3 * w4.y; a3.z += c3 * w4.z; a3.w += c3 * w4.w;
    a4.x += c4 * w4.x; a4.y += c4 * w4.y; a4.z += c4 * w4.z; a4.w += c4 * w4.w;
  }
  *(float4*)(s_p + (ksl * 5 + 0) * 16 + cl * 4) = a0;
  *(float4*)(s_p + (ksl * 5 + 1) * 16 + cl * 4) = a1;
  *(float4*)(s_p + (ksl * 5 + 2) * 16 + cl * 4) = a2;
  *(float4*)(s_p + (ksl * 5 + 3) * 16 + cl * 4) = a3;
  *(float4*)(s_p + (ksl * 5 + 4) * 16 + cl * 4) = a4;
  __syncthreads();
  if (tid < 80) {
    int v = tid >> 4, col = tid & 15;
    float s = p.b_ada[layer * 3072 + n0 + col];
#pragma unroll 8
    for (int k2 = 0; k2 < 64; ++k2) s += s_p[(k2 * 5 + v) * 16 + col];
    WSB_mod[(layer * 5 + v) * 3072 + n0 + col] = s;
  }
  __syncthreads();
}

__device__ __forceinline__ void tr_tile(const float* __restrict__ src, long ld_src, u16* __restrict__ dst, long ld_dst,
                        int r0, int c0, int perm, char* smem) {
  float* tile = (float*)smem;
  const int tid = tidx();
  {
    int c4 = (tid & 15) * 4;
    int pcol = c0 + c4;
    int scol = pcol;
    if (perm) {
      int blk = pcol & ~127, w = pcol & 127;
      int r = w & 63;
      scol = blk + (r >> 5) * 64 + (w >> 6) * 32 + (r & 31);
    }
#pragma unroll
    for (int i = 0; i < 4; ++i) {
      int rr = (tid >> 4) + i * 16;
      float4 v = *(const float4*)(src + (long)(r0 + rr) * ld_src + scol);
      float* t = tile + rr * 65 + c4;
      t[0] = v.x; t[1] = v.y; t[2] = v.z; t[3] = v.w;
    }
  }
  __syncthreads();
  {
    int kc = (tid & 7) * 8;
#pragma unroll
    for (int i = 0; i < 2; ++i) {
      int pp = (tid >> 3) + i * 32;
      const float* t = tile + kc * 65 + pp;
      uint4 o;
      o.x = pk2(t[0], t[65]); o.y = pk2(t[130], t[195]); o.z = pk2(t[260], t[325]); o.w = pk2(t[390], t[455]);
      *(uint4*)(dst + (long)(c0 + pp) * ld_dst + r0 + kc) = o;
    }
  }
  __syncthreads();
}

__device__ __forceinline__ void tr_item(const Params& p, int x, char* smem) {
  if (x < 2048) {
    int bt = x >> 10, tt = x & 1023, rt = tt & 15, ct = tt >> 4;
    tr_tile(p.na_w_in + (long)bt * 1024 * 4096, 4096, WSB_wt_na_in + (long)bt * 4096 * 1024, 1024, rt * 64, ct * 64, 0, smem);
    return;
  }
  x -= 2048;
  if (x < 512) {
    int bt = x >> 8, tt = x & 255, rt = tt & 15, ct = tt >> 4;
    tr_tile(p.na_w_out + (long)bt * 1024 * 1024, 1024, WSB_wt_na_out + (long)bt * 1024 * 1024, 1024, rt * 64, ct * 64, 0, smem);
    return;
  }
  x -= 512;
  if (x < 1536) {
    int rt = x & 15, ct = x >> 4;
    tr_tile(p.ret_w_in, 6144, WSB_wt_ret_in, 1024, rt * 64, ct * 64, ct < 32 ? 1 : 0, smem);
    return;
  }
  x -= 1536;
  if (x < 512) {
    int rt = x & 31, ct = x >> 5;
    tr_tile(p.ret_w_out, 1024, WSB_wt_ret_out, 2048, rt * 64, ct * 64, 0, smem);
    return;
  }
  x -= 512;
  if (x < 1536) {
    int rt = x & 15, ct = x >> 4;
    tr_tile(p.mlp_w_in, 6144, WSB_wt_mlp_in, 1024, rt * 64, ct * 64, 0, smem);
    return;
  }
  x -= 1536;
  if (x < 512) {
    int rt = x & 31, ct = x >> 5;
    tr_tile(p.mlp_w_out, 1024, WSB_wt_mlp_out, 2048, rt * 64, ct * 64, 0, smem);
    return;
  }
  x -= 512;
  (void)x;
}

__device__ __forceinline__ void cv_item(const Params& p, int it) {
  const int tid = tidx();
  if (it < 128) {
    long base = (long)it * 1024 + tid * 4;
    float4 v = *(const float4*)(p.mlp_w_s + base);
    store4bf(WSB_ws_bf + base, v.x, v.y, v.z, v.w);
    return;
  }
  it -= 128;
  if (it < 1024) {
    int g = it * 256 + tid;
    int seq = g >> 11, r = g & 2047, lane = r & 63, f = r >> 6;
    int ks = f & 1, n = (f >> 1) & 3, kt = f >> 3, fr = lane & 15, fq = lane >> 4;
    int blj = seq >> 4, hh = seq & 15;
    int s = kt * 64 + n * 16 + fr, d0 = ks * 32 + fq * 8;
    const float* sp = p.cache_k + ((long)(blj * 256 + s) * 16 + hh) * 64 + d0;
    float4 a = *(const float4*)sp, b = *(const float4*)(sp + 4);
    uint4 o; o.x = pk2(a.x, a.y); o.y = pk2(a.z, a.w); o.z = pk2(b.x, b.y); o.w = pk2(b.z, b.w);
    *(uint4*)(WSB_ck_bf + (long)g * 8) = o;
    return;
  }
  it -= 1024;
  if (it < 1024) {
    int g = it * 256 + tid;
    int seq = g >> 11, r = g & 2047, lane = r & 63, f = r >> 6;
    int dt = f & 3, ks2 = (f >> 2) & 1, kt = f >> 3, fr = lane & 15, fq = lane >> 4;
    int blj = seq >> 4, hh = seq & 15;
    int dv = dt * 16 + fr, kA = kt * 64 + (2 * ks2) * 16 + fq * 4;
    const float* sp = p.cache_v + ((long)(blj * 256 + kA) * 16 + hh) * 64 + dv;
    uint4 o;
    o.x = pk2(sp[0], sp[1024]); o.y = pk2(sp[2048], sp[3072]);
    o.z = pk2(sp[16 * 1024], sp[17 * 1024]); o.w = pk2(sp[18 * 1024], sp[19 * 1024]);
    *(uint4*)(WSB_cvt_bf + (long)g * 8) = o;
    return;
  }
  it -= 1024;
  {
    int g = it * 256 + tid;
    int bh = g >> 15, r = g & 32767, lane = r & 63, f = r >> 6;
    int dtg = f & 31, ks = f >> 5, fr = lane & 15, fq = lane >> 4;
    int dv = dtg * 16 + fr, k0 = ks * 32 + fq * 8, dir = k0 >> 8, dk0 = k0 & 255;
    int b = bh >> 2, hh = bh & 3;
    const float* sp = p.state_ret + ((long)((b * 2 + dir) * 4 + hh) * 256 + dk0) * 512 + dv;
    uint4 o;
    o.x = pk2(sp[0], sp[512]); o.y = pk2(sp[1024], sp[1536]);
    o.z = pk2(sp[2048], sp[2560]); o.w = pk2(sp[3072], sp[3584]);
    *(uint4*)(WSB_s0t + (long)g * 8) = o;
  }
}

__device__ __forceinline__ void misc_item(const Params& p) {
  const int tid = tidx();
  for (int idx = tid; idx < 4096; idx += 256) {
    int pos = idx >> 6, i = idx & 63;
    float inv = __builtin_amdgcn_exp2f(-(float)i * (13.287712379549449f / 64.f));
    float ang = (float)pos * inv;
    WSB_ropetab[2 * idx] = __cosf(ang);
    WSB_ropetab[2 * idx + 1] = __sinf(ang);
  }
  if (tid < 8) {
    float x = p.ret_decay[tid];
    float y = __expf(-x);
    float lg1p = y * (1.f - y * (0.5f - y * (0.33333334f - y * (0.25f - y * (0.2f - y * 0.16666667f)))));
    if (y > 0.25f) lg1p = __logf(1.f + y);
    WSB_dec[tid] = -lg1p * 1.4426950408889634f;
  }
}

__device__ __forceinline__ void prep_phase(const Params& p, char* smem) {
  const int NADA = 768, NTR = 6656, NCV = 128 + 1024 + 1024 + 2048;
  for (int it = blockIdx.x; it < NADA + NTR + NCV + 1; it += gridDim.x) {
    if (it < NADA) adaln_item(p, it, smem);
    else if (it < NADA + NTR) tr_item(p, it - NADA, smem);
    else if (it < NADA + NTR + NCV) cv_item(p, it - NADA - NTR);
    else misc_item(p);
  }
}

__device__ __forceinline__ void norm_phase(const Params& p, int layer, const float* xp, const float* xs) {
  const int wave = tidx() >> 6, lane = tidx() & 63;
  const float* nw = p.norm_w + layer * 1024;
  for (int row = blockIdx.x * 4 + wave; row < TT; row += gridDim.x * 4) {
    const float* x = row < TP ? xp + (long)row * 1024 : xs + (long)(row - TP) * 1024;
    int mv = row < TP ? 0 : 1 + ((row - TP) >> 10);
    const float* md = WSB_mod + (long)(layer * 5 + mv) * 3072;
    float4 v[4];
    float ss = 0.f;
#pragma unroll
    for (int i = 0; i < 4; ++i) {
      v[i] = *(const float4*)(x + i * 256 + lane * 4);
      ss += v[i].x * v[i].x + v[i].y * v[i].y + v[i].z * v[i].z + v[i].w * v[i].w;
    }
#pragma unroll
    for (int o = 32; o > 0; o >>= 1) ss += __shfl_xor(ss, o);
    float r = rsqrtf(ss * (1.f / 1024.f) + 1e-6f);
#pragma unroll
    for (int i = 0; i < 4; ++i) {
      int c = i * 256 + lane * 4;
      float4 w4 = *(const float4*)(nw + c);
      float4 sh = *(const float4*)(md + c);
      float4 sc = *(const float4*)(md + 1024 + c);
      float o0 = (v[i].x * r * w4.x) * (1.f + sc.x) + sh.x;
      float o1 = (v[i].y * r * w4.y) * (1.f + sc.y) + sh.y;
      float o2 = (v[i].z * r * w4.z) * (1.f + sc.z) + sh.z;
      float o3 = (v[i].w * r * w4.w) * (1.f + sc.w) + sh.w;
      store4bf(WSB_h + (long)row * 1024 + c, o0, o1, o2, o3);
    }
  }
}

#define LDSWAIT() asm volatile("s_waitcnt lgkmcnt(0)" ::: "memory")

__device__ __forceinline__ void rows_out_bf16(const char* wl, int lane, u16* dst, long ld) {
#pragma unroll
  for (int i = 0; i < 8; ++i) {
    int row = (lane >> 3) + 8 * i, ch = lane & 7;
    uint4 v = *(const uint4*)(wl + row * 144 + ch * 16);
    *(uint4*)(dst + (long)row * ld + ch * 8) = v;
  }
}
__device__ __forceinline__ void rows_out_bf16_split(const char* wl, int lane, u16* dst, long ld, int gap) {
#pragma unroll
  for (int i = 0; i < 8; ++i) {
    int row = (lane >> 3) + 8 * i, ch = lane & 7;
    uint4 v = *(const uint4*)(wl + row * 144 + ch * 16);
    *(uint4*)(dst + (long)row * ld + (ch & 3) * 8 + (ch >> 2) * gap) = v;
  }
}
template <class F>
__device__ __forceinline__ void rows_out_f32(const float* wl, int lane, F f) {
#pragma unroll
  for (int i = 0; i < 8; ++i) {
    int row = (lane >> 4) + 4 * i, ch = lane & 15;
    float4 v = *(const float4*)(wl + row * 68 + ch * 4);
    f(row, ch, v);
  }
}

template <int NO, int NW>
__device__ __forceinline__ void epi_resid(const Params& p, int layer, const float* xp, const float* xs, float* xout,
                                          int tm, int tn, int wc, f32x4 (&acc)[4][NW], char* smem) {
  const int lane = tidx() & 63, wid = tidx() >> 6, wr = wid >> 1, fr = lane & 15, fq = lane >> 4;
  float* wl = (float*)(smem + wid * 16384);
  int mv = tm < 64 ? 0 : 1 + ((tm - 64) >> 3);
  const int ch = lane & 15;
  const int col = tn * 128 + wc * 64 + ch * 4;
  const float4 g4 = *(const float4*)(WSB_mod + (long)(layer * 5 + mv) * 3072 + 2048 + col);
  const int trow0 = tm * 128 + wr * 64;
  const float* xin = (trow0 < TP ? xp + (long)trow0 * 1024 : xs + (long)(trow0 - TP) * 1024) + col;
  float* xo = xout + (long)trow0 * 1024 + col;
#pragma unroll
  for (int a = 0; a < 2; ++a) {
#pragma unroll
    for (int mm = 0; mm < 2; ++mm)
#pragma unroll
      for (int j = 0; j < 4; ++j)
#pragma unroll
        for (int n = 0; n < 4; ++n) wl[(mm * 16 + fq * 4 + j) * 68 + n * 16 + fr] = acc[2 * a + mm][NO + (n)][j];
    LDSWAIT();
    rows_out_f32(wl, lane, [&](int row, int, float4 v) {
      long off = (long)(a * 32 + row) * 1024;
      float4 x = *(const float4*)(xin + off);
      float4 o;
      o.x = x.x + g4.x * v.x; o.y = x.y + g4.y * v.y; o.z = x.z + g4.z * v.z; o.w = x.w + g4.w * v.w;
      *(float4*)(xo + off) = o;
    });
    LDSWAIT();
  }
}

template <int NO, int NW>
__device__ __forceinline__ void epi_na_in(const Params& p, int lj, int tm, int tn, int wc, f32x4 (&acc)[4][NW], char* smem) {
  const int lane = tidx() & 63, wid = tidx() >> 6, wr = wid >> 1, fr = lane & 15, fq = lane >> 4;
  char* wl = smem + wid * 16384;
  u16* wl16 = (u16*)wl;
  float* wlf = (float*)wl;
  const int sec = tn >> 3;
  const int cbase = (tn & 7) * 128 + wc * 64;
  const int head = cbase >> 6;
  const int row0 = tm * 128 + wr * 64;
  int b, s0; long sb;
  if (row0 < TP) { b = row0 >> 8; s0 = row0 & 255; sb = (long)(b * 16 + head) * 256 * 64; }
  else { int ts = row0 - TP; b = ts >> 10; s0 = ts & 1023; sb = (long)TP * 1024 + (long)(b * 16 + head) * 1024 * 64; }
  const int kt = s0 >> 6;
  if (sec <= 1) {
    const float* gain = (sec == 0 ? p.na_q_gain : p.na_k_gain) + lj * 64;
    float g[4];
#pragma unroll
    for (int n = 0; n < 4; ++n) g[n] = gain[n * 16 + fr] * (sec == 0 ? 0.125f : 1.f);
#pragma unroll
    for (int m = 0; m < 4; ++m)
#pragma unroll
      for (int j = 0; j < 4; ++j) {
        float ss = 0.f;
#pragma unroll
        for (int n = 0; n < 4; ++n) ss += acc[m][NO + (n)][j] * acc[m][NO + (n)][j];
        ss += __shfl_xor(ss, 1); ss += __shfl_xor(ss, 2); ss += __shfl_xor(ss, 4); ss += __shfl_xor(ss, 8);
        float r = rsqrtf(ss * (1.f / 64.f) + 1e-6f);
#pragma unroll
        for (int n = 0; n < 4; ++n) acc[m][NO + (n)][j] *= r * g[n];
      }
#pragma unroll
    for (int m = 0; m < 4; ++m)
#pragma unroll
      for (int j = 0; j < 4; ++j)
#pragma unroll
        for (int n = 0; n < 4; n += 2) st2bf(wl16, (m * 16 + fq * 4 + j) * 72 + n * 16 + fr, (m * 16 + fq * 4 + j) * 72 + (n + 1) * 16 + fr, acc[m][NO + (n)][j], acc[m][NO + (n + 1)][j]);
    LDSWAIT();
    if (sec == 0) {
      rows_out_bf16(wl, lane, WSB_na_q + (long)row0 * 1024 + cbase, 1024);
    } else {
#pragma unroll
      for (int m = 0; m < 4; ++m)
#pragma unroll
        for (int ks = 0; ks < 2; ++ks) {
          uint4 v = *(const uint4*)(wl + (m * 16 + fr) * 144 + (ks * 32 + fq * 8) * 2);
          *(uint4*)(WSB_na_k + sb + (long)(((kt * 4 + m) * 2 + ks) * 64 + lane) * 8) = v;
        }
    }
    LDSWAIT();
    if (sec == 1 && row0 < TP) {
      float* nk = WSB_new_k + ((long)(b * 2 + lj) * 256 + s0) * 1024 + head * 64;
#pragma unroll
      for (int a = 0; a < 2; ++a) {
#pragma unroll
        for (int mm = 0; mm < 2; ++mm)
#pragma unroll
          for (int j = 0; j < 4; ++j)
#pragma unroll
            for (int n = 0; n < 4; ++n) wlf[(mm * 16 + fq * 4 + j) * 68 + n * 16 + fr] = acc[2 * a + mm][NO + (n)][j];
        LDSWAIT();
        rows_out_f32(wlf, lane, [&](int row, int ch, float4 v) { *(float4*)(nk + (long)(a * 32 + row) * 1024 + ch * 4) = v; });
        LDSWAIT();
      }
    }
  } else if (sec == 2) {
#pragma unroll
    for (int m = 0; m < 4; m += 2) {
#pragma unroll
      for (int n = 0; n < 4; ++n) {
        f32x4 a = acc[m][NO + (n)], a2 = acc[m + 1][NO + (n)];
        uint4 o; o.x = pk2(a[0], a[1]); o.y = pk2(a[2], a[3]); o.z = pk2(a2[0], a2[1]); o.w = pk2(a2[2], a2[3]);
        *(uint4*)(WSB_na_vT + sb + ((long)(((kt * 2 + (m >> 1)) * 4 + n) * 64 + lane)) * 8) = o;
      }
    }
    if (row0 < TP) {
      float* nv = WSB_new_v + ((long)(b * 2 + lj) * 256 + s0) * 1024 + head * 64;
#pragma unroll
      for (int a = 0; a < 2; ++a) {
#pragma unroll
        for (int mm = 0; mm < 2; ++mm)
#pragma unroll
          for (int j = 0; j < 4; ++j)
#pragma unroll
            for (int n = 0; n < 4; ++n) wlf[(mm * 16 + fq * 4 + j) * 68 + n * 16 + fr] = acc[2 * a + mm][NO + (n)][j];
        LDSWAIT();
        rows_out_f32(wlf, lane, [&](int row, int ch, float4 v) { *(float4*)(nv + (long)(a * 32 + row) * 1024 + ch * 4) = v; });
        LDSWAIT();
      }
    }
  } else {
#pragma unroll
    for (int m = 0; m < 4; ++m)
#pragma unroll
      for (int j = 0; j < 4; ++j)
#pragma unroll
        for (int n = 0; n < 4; n += 2) st2bf(wl16, (m * 16 + fq * 4 + j) * 72 + n * 16 + fr, (m * 16 + fq * 4 + j) * 72 + (n + 1) * 16 + fr, silu_f(acc[m][NO + (n)][j]), silu_f(acc[m][NO + (n + 1)][j]));
    LDSWAIT();
    rows_out_bf16(wl, lane, WSB_na_sg + (long)row0 * 1024 + cbase, 1024);
    LDSWAIT();
  }
}

template <int NO, int NW>
__device__ __forceinline__ void epi_ret_in(const Params& p, int tm, int tn, int wc, f32x4 (&acc)[4][NW], char* smem) {
  const int lane = tidx() & 63, wid = tidx() >> 6, wr = wid >> 1, fr = lane & 15, fq = lane >> 4;
  char* wl = smem + wid * 16384;
  u16* wl16 = (u16*)wl;
  const int row0 = tm * 128 + wr * 64;
  const bool sample = tm >= 64;
  if (tn < 16) {
    const bool isk = tn >= 8;
    const int blk = tn & 7, hh = blk >> 1, half = blk & 1;
    const float l2f = WSB_dec[hh], l2b = WSB_dec[4 + hh];
#pragma unroll
    for (int m = 0; m < 4; ++m)
#pragma unroll
      for (int j = 0; j < 4; ++j) {
        int t = row0 + m * 16 + fq * 4 + j;
        int nn = (t - TP) & 1023;
        int pos = half == 0 ? (nn >> 6) : (nn & 63);
#pragma unroll
        for (int n2 = 0; n2 < 2; ++n2) {
          int i = wc * 32 + n2 * 16 + fr;
          float x1 = acc[m][NO + (n2)][j], x2 = acc[m][NO + (n2 + 2)][j];
          float o1 = x1, o2 = x2;
          if (sample) {
            float2 cs = *(const float2*)(WSB_ropetab + 2 * (pos * 64 + i));
            o1 = x1 * cs.x - x2 * cs.y;
            o2 = x1 * cs.y + x2 * cs.x;
          }
          if (isk) { o1 *= 0.0625f; o2 *= 0.0625f; }
          acc[m][NO + (n2)][j] = o1; acc[m][NO + (n2 + 2)][j] = o2;
        }
      }
#pragma unroll
    for (int m = 0; m < 4; ++m)
#pragma unroll
      for (int j = 0; j < 4; ++j)
#pragma unroll
        for (int n = 0; n < 4; n += 2) st2bf(wl16, (m * 16 + fq * 4 + j) * 72 + (n >> 1) * 32 + fr, (m * 16 + fq * 4 + j) * 72 + (n >> 1) * 32 + 16 + fr, acc[m][NO + (n)][j], acc[m][NO + (n + 1)][j]);
    LDSWAIT();
    if (!isk) {
      rows_out_bf16_split(wl, lane, WSB_rt_q + (long)row0 * 1024 + hh * 256 + half * 128 + wc * 32, 1024, 64);
      LDSWAIT();
      if (sample) {
        int ts0 = row0 - TP, b = ts0 >> 10, nn0 = ts0 & 1023;
        u16* qs = WSB_rt_qs + ((long)(b * 4 + hh) * 1024 + nn0) * 512 + half * 128 + wc * 32;
#pragma unroll
        for (int dir = 0; dir < 2; ++dir) {
#pragma unroll
          for (int m = 0; m < 4; ++m)
#pragma unroll
            for (int j = 0; j < 4; ++j) {
              int nn = nn0 + m * 16 + fq * 4 + j;
              float w = dir == 0 ? exp2f(l2f * (float)(nn + 1)) : exp2f(l2b * (float)(1024 - nn));
#pragma unroll
              for (int n = 0; n < 4; n += 2) st2bf(wl16, (m * 16 + fq * 4 + j) * 72 + (n >> 1) * 32 + fr, (m * 16 + fq * 4 + j) * 72 + (n >> 1) * 32 + 16 + fr, acc[m][NO + (n)][j] * w, acc[m][NO + (n + 1)][j] * w);
            }
          LDSWAIT();
          rows_out_bf16_split(wl, lane, qs + dir * 256, 512, 64);
          LDSWAIT();
        }
      }
    } else {
      int s0; long sb;
      if (!sample) { s0 = row0 & 255; sb = (long)((row0 >> 8) * 4 + hh) * 256 * 256; }
      else { int ts = row0 - TP; s0 = ts & 1023; sb = (long)TP * 1024 + (long)((ts >> 10) * 4 + hh) * 1024 * 256; }
      const int kt = s0 >> 6;
#pragma unroll
      for (int m = 0; m < 4; ++m)
#pragma unroll
        for (int r = 0; r < 2; ++r) {
          uint4 v = *(const uint4*)(wl + (m * 16 + fr) * 144 + (r * 32 + fq * 8) * 2);
          *(uint4*)(WSB_rt_k + sb + (long)(((kt * 4 + m) * 8 + half * 4 + wc + 2 * r) * 64 + lane) * 8) = v;
        }
      LDSWAIT();
      if (!sample) {
        const int bh = (row0 >> 8) * 4 + hh;
#pragma unroll
        for (int m = 0; m < 4; m += 2) {
          float wf[8], wb[8];
#pragma unroll
          for (int e = 0; e < 8; ++e) {
            int s = s0 + (m + (e >> 2)) * 16 + fq * 4 + (e & 3);
            wf[e] = exp2f(l2f * (float)(255 - s));
            wb[e] = exp2f(l2b * (float)s);
          }
#pragma unroll
          for (int n = 0; n < 4; ++n) {
            int dk = half * 128 + (n >> 1) * 64 + wc * 32 + (n & 1) * 16;
            f32x4 a = acc[m][NO + (n)], a2 = acc[m + 1][NO + (n)];
            uint4 of, ob;
            of.x = pk2(a[0] * wf[0], a[1] * wf[1]); of.y = pk2(a[2] * wf[2], a[3] * wf[3]);
            of.z = pk2(a2[0] * wf[4], a2[1] * wf[5]); of.w = pk2(a2[2] * wf[6], a2[3] * wf[7]);
            ob.x = pk2(a[0] * wb[0], a[1] * wb[1]); ob.y = pk2(a[2] * wb[2], a[3] * wb[3]);
            ob.z = pk2(a2[0] * wb[4], a2[1] * wb[5]); ob.w = pk2(a2[2] * wb[6], a2[3] * wb[7]);
            long off = ((long)((kt * 2 + (m >> 1)) * 16 + (dk >> 4)) * 64 + lane) * 8;
            *(uint4*)(WSB_rt_kT + (long)(bh * 2 + 0) * 65536 + off) = of;
            *(uint4*)(WSB_rt_kT + (long)(bh * 2 + 1) * 65536 + off) = ob;
          }
        }
      }
    }
  } else if (tn < 32) {
    const int cv0 = (tn - 16) * 128 + wc * 64;
    const int hh = cv0 >> 9;
    int s0; long sb;
    if (!sample) { s0 = row0 & 255; sb = (long)((row0 >> 8) * 4 + hh) * 256 * 512; }
    else { int ts = row0 - TP; s0 = ts & 1023; sb = (long)TP * 2048 + (long)((ts >> 10) * 4 + hh) * 1024 * 512; }
    const int kt = s0 >> 6;
#pragma unroll
    for (int m = 0; m < 4; m += 2)
#pragma unroll
      for (int n = 0; n < 4; ++n) {
        int dvt = ((cv0 & 511) >> 4) + n;
        f32x4 a = acc[m][NO + (n)], a2 = acc[m + 1][NO + (n)];
        uint4 o; o.x = pk2(a[0], a[1]); o.y = pk2(a[2], a[3]); o.z = pk2(a2[0], a2[1]); o.w = pk2(a2[2], a2[3]);
        *(uint4*)(WSB_rt_vF + sb + ((long)((kt * 2 + (m >> 1)) * 32 + dvt) * 64 + lane) * 8) = o;
      }
  } else {
#pragma unroll
    for (int m = 0; m < 4; ++m)
#pragma unroll
      for (int j = 0; j < 4; ++j)
#pragma unroll
        for (int n = 0; n < 4; n += 2) st2bf(wl16, (m * 16 + fq * 4 + j) * 72 + n * 16 + fr, (m * 16 + fq * 4 + j) * 72 + (n + 1) * 16 + fr, silu_f(acc[m][NO + (n)][j]), silu_f(acc[m][NO + (n + 1)][j]));
    LDSWAIT();
    rows_out_bf16(wl, lane, WSB_rt_sg + (long)row0 * 2048 + (tn - 32) * 128 + wc * 64, 2048);
    LDSWAIT();
  }
}

template <int NO, int NW>
__device__ __forceinline__ void epi_ret_vg(const Params& p, int tm, int tn, int wc, f32x4 (&acc)[4][NW], char* smem) {
  const int lane = tidx() & 63, wid = tidx() >> 6, wr = wid >> 1, fr = lane & 15, fq = lane >> 4;
  char* wl = smem + wid * 16384;
  u16* wl16 = (u16*)wl;
  const int row0 = tm * 128 + wr * 64;
  const bool sample = tm >= 64;
  (void)fq; (void)fr; (void)wl16;
  if (tn < 32) {
    const int cv0 = (tn - 16) * 128 + wc * 64;
    const int hh = cv0 >> 9;
    int s0; long sb;
    if (!sample) { s0 = row0 & 255; sb = (long)((row0 >> 8) * 4 + hh) * 256 * 512; }
    else { int ts = row0 - TP; s0 = ts & 1023; sb = (long)TP * 2048 + (long)((ts >> 10) * 4 + hh) * 1024 * 512; }
    const int kt = s0 >> 6;
#pragma unroll
    for (int m = 0; m < 4; m += 2)
#pragma unroll
      for (int n = 0; n < 4; ++n) {
        int dvt = ((cv0 & 511) >> 4) + n;
        f32x4 a = acc[m][NO + (n)], a2 = acc[m + 1][NO + (n)];
        uint4 o; o.x = pk2(a[0], a[1]); o.y = pk2(a[2], a[3]); o.z = pk2(a2[0], a2[1]); o.w = pk2(a2[2], a2[3]);
        *(uint4*)(WSB_rt_vF + sb + ((long)((kt * 2 + (m >> 1)) * 32 + dvt) * 64 + lane) * 8) = o;
      }
  } else {
#pragma unroll
    for (int m = 0; m < 4; ++m)
#pragma unroll
      for (int j = 0; j < 4; ++j)
#pragma unroll
        for (int n = 0; n < 4; n += 2) st2bf(wl16, (m * 16 + fq * 4 + j) * 72 + n * 16 + fr, (m * 16 + fq * 4 + j) * 72 + (n + 1) * 16 + fr, silu_f(acc[m][NO + (n)][j]), silu_f(acc[m][NO + (n + 1)][j]));
    LDSWAIT();
    rows_out_bf16(wl, lane, WSB_rt_sg + (long)row0 * 2048 + (tn - 32) * 128 + wc * 64, 2048);
    LDSWAIT();
  }
}

template <int NO, int NW>
__device__ __forceinline__ void epi_mlp_in(const Params& p, int tm, int tn, int wc, f32x4 (&acc)[4][NW], char* smem) {
  const int lane = tidx() & 63, wid = tidx() >> 6, wr = wid >> 1, fr = lane & 15, fq = lane >> 4;
  char* wl = smem + wid * 16384;
  u16* wl16 = (u16*)wl;
  const int row0 = tm * 128 + wr * 64;
  if (tn < 16 || tn >= 32) {
    const bool isu = tn < 16;
    u16* dstb = isu ? WSB_ml_gu : WSB_ml_sg;
    const int c0 = (isu ? tn : tn - 32) * 128 + wc * 64;
#pragma unroll
    for (int m = 0; m < 4; ++m)
#pragma unroll
      for (int j = 0; j < 4; ++j)
#pragma unroll
        for (int n = 0; n < 4; n += 2) {
          float a = acc[m][NO + (n)][j], a1 = acc[m][NO + (n + 1)][j];
          st2bf(wl16, (m * 16 + fq * 4 + j) * 72 + n * 16 + fr, (m * 16 + fq * 4 + j) * 72 + (n + 1) * 16 + fr,
                isu ? gelu_f(a) : silu_f(a), isu ? gelu_f(a1) : silu_f(a1));
        }
    LDSWAIT();
    rows_out_bf16(wl, lane, dstb + (long)row0 * 2048 + c0, 2048);
    LDSWAIT();
  } else {
    const int c0 = (tn - 16) * 128 + wc * 64;
    float s1[4][4], s2[4][4];
#pragma unroll
    for (int m = 0; m < 4; ++m)
#pragma unroll
      for (int j = 0; j < 4; ++j) { s1[m][j] = 0.f; s2[m][j] = 0.f; }
#pragma unroll
    for (int m = 0; m < 4; ++m)
#pragma unroll
      for (int n = 0; n < 4; ++n)
#pragma unroll
        for (int j = 0; j < 4; ++j) {
          float gq = bf2f(f2bf(gelu_f(acc[m][NO + (n)][j])));
          acc[m][NO + (n)][j] = gq;
          s1[m][j] += gq; s2[m][j] += gq * gq;
        }
#pragma unroll
    for (int m = 0; m < 4; m += 2)
#pragma unroll
      for (int n = 0; n < 4; ++n) {
        f32x4 a = acc[m][NO + (n)], a2 = acc[m + 1][NO + (n)];
        uint4 o; o.x = pk2(a[0], a[1]); o.y = pk2(a[2], a[3]); o.z = pk2(a2[0], a2[1]); o.w = pk2(a2[2], a2[3]);
        int ks2 = wr * 2 + (m >> 1), ct = (c0 >> 4) + n;
        *(uint4*)(WSB_ml_vT + ((long)((tm * 4 + ks2) * 128 + ct) * 64 + lane) * 8) = o;
      }
#pragma unroll
    for (int m = 0; m < 4; ++m)
#pragma unroll
      for (int j = 0; j < 4; ++j) {
        float a = s1[m][j], b = s2[m][j];
        a += __shfl_xor(a, 1); a += __shfl_xor(a, 2); a += __shfl_xor(a, 4); a += __shfl_xor(a, 8);
        b += __shfl_xor(b, 1); b += __shfl_xor(b, 2); b += __shfl_xor(b, 4); b += __shfl_xor(b, 8);
        if (fr == 0) {
          int t = row0 + m * 16 + fq * 4 + j;
          float2 st; st.x = a; st.y = b;
          *(float2*)(WSB_ml_st + ((long)t * 32 + (tn - 16) * 2 + wc) * 2) = st;
        }
      }
  }
}

__device__ __forceinline__ void na_attn_phase(const Params& p, int lj, char* smem) {
  float* s_rpb = (float*)smem;
  const int tid = tidx(), lane = tid & 63, wid = tid >> 6, fr = lane & 15, fq = lane >> 4;
  const unsigned lane8 = lane * 8;
  for (int item0 = blockIdx.x; item0 < 1536; item0 += gridDim.x) {
    bool lat; int bhi, sub;
    if (gridDim.x == 512) {
      const int x = blockIdx.x & 7, slot = blockIdx.x >> 3, k = item0 >> 9;
      if (k == 0) { lat = true; bhi = x + 8 * (slot >> 3); sub = slot & 7; }
      else { lat = false; bhi = x + 8 * ((k - 1) * 32 + (slot >> 1)); sub = slot & 1; }
    } else {
      if (item0 < 512) { lat = true; bhi = item0 >> 3; sub = item0 & 7; }
      else { lat = false; bhi = (item0 - 512) >> 1; sub = (item0 - 512) & 1; }
    }
    const int b2 = bhi >> 4, h2 = bhi & 15;
    int tq[2], rr[2] = {0, 0}, rs[2] = {0, 0}, NTloc, NT;
    const u16 *kb2, *vb2, *ckb = nullptr, *cvb = nullptr;
    if (lat) {
      rr[0] = 2 * sub; rr[1] = 2 * sub + 1;
      rs[0] = min(max(rr[0] - 4, 0), 8); rs[1] = min(max(rr[1] - 4, 0), 8);
      NTloc = rs[1] - rs[0] + 8; NT = NTloc + 4;
      tq[0] = TP + b2 * 1024 + rr[0] * 64 + wid * 16; tq[1] = tq[0] + 64;
      kb2 = WSB_na_k + (long)TP * 1024 + (long)bhi * 1024 * 64 + rs[0] * 4096;
      vb2 = WSB_na_vT + (long)TP * 1024 + (long)bhi * 1024 * 64 + rs[0] * 4096;
      ckb = WSB_ck_bf + (long)((b2 * 2 + lj) * 16 + h2) * 256 * 64;
      cvb = WSB_cvt_bf + (long)((b2 * 2 + lj) * 16 + h2) * 256 * 64;
      const float* rp = p.na_rpb + (long)(lj * 16 + h2) * 465;
      for (int i = tid; i < 465; i += 256) s_rpb[i] = rp[i];
      __syncthreads();
    } else {
      NTloc = 0; NT = 4;
      tq[0] = b2 * 256 + sub * 128 + wid * 16; tq[1] = tq[0] + 64;
      kb2 = WSB_na_k + (long)bhi * 256 * 64;
      vb2 = WSB_na_vT + (long)bhi * 256 * 64;
    }
    const int cq = wid * 16 + fr;
    const int cstart = min(max(cq - 8, 0), 48);
    bf16x8 qf2[2][2];
    f32x4 o2[2][4];
    float l2[2] = {0.f, 0.f};
#pragma unroll
    for (int u = 0; u < 2; ++u) {
#pragma unroll
      for (int ks = 0; ks < 2; ++ks) qf2[u][ks] = *(const bf16x8*)(WSB_na_q + (long)(tq[u] + fr) * 1024 + h2 * 64 + ks * 32 + fq * 8);
#pragma unroll
      for (int dt = 0; dt < 4; ++dt) o2[u][dt] = f32x4{0.f, 0.f, 0.f, 0.f};
    }
    bf16x8 ring[16];
#pragma unroll
    for (int i = 0; i < 8; ++i) { ring[i] = *(const bf16x8*)(kb2 + i * 512 + lane8); ring[8 + i] = *(const bf16x8*)(vb2 + i * 512 + lane8); }
    for (int tau = 0; tau < NT; ++tau) {
      const bool more = tau + 1 < NT;
      const u16 *kn = kb2, *vn = vb2;
      if (more) {
        if (lat && tau + 1 >= NTloc) { kn = ckb + (tau + 1 - NTloc) * 4096; vn = cvb + (tau + 1 - NTloc) * 4096; }
        else { kn = kb2 + (tau + 1) * 4096; vn = vb2 + (tau + 1) * 4096; }
      }
      f32x4 s[2][4];
#pragma unroll
      for (int u = 0; u < 2; ++u)
#pragma unroll
        for (int n = 0; n < 4; ++n) s[u][n] = f32x4{0.f, 0.f, 0.f, 0.f};
#pragma unroll
      for (int i = 0; i < 8; ++i) {
        s[0][i >> 1] = MFMA16(ring[i], qf2[0][i & 1], s[0][i >> 1]);
        s[1][i >> 1] = MFMA16(ring[i], qf2[1][i & 1], s[1][i >> 1]);
        if (more) ring[i] = *(const bf16x8*)(kn + i * 512 + lane8);
      }
      if (lat && tau < NTloc) {
        const int jr = rs[0] + tau;
#pragma unroll
        for (int u = 0; u < 2; ++u) {
          const bool rowok = (jr >= rs[u]) && (jr < rs[u] + 8);
          const float* rb = s_rpb + min(max(jr - rr[u] + 7, 0), 14) * 31;
#pragma unroll
          for (int n = 0; n < 4; ++n)
#pragma unroll
            for (int j = 0; j < 4; ++j) {
              int ck = n * 16 + fq * 4 + j;
              bool valid = rowok && (ck >= cstart) && (ck < cstart + 16);
              int coff = min(max(ck - cq + 15, 0), 30);
              float e = __expf(s[u][n][j] + rb[coff]);
              float pv = valid ? e : 0.f;
              l2[u] += pv; s[u][n][j] = pv;
            }
        }
      } else {
#pragma unroll
        for (int u = 0; u < 2; ++u)
#pragma unroll
          for (int n = 0; n < 4; ++n)
#pragma unroll
            for (int j = 0; j < 4; ++j) { float pv = __expf(s[u][n][j]); l2[u] += pv; s[u][n][j] = pv; }
      }
      bf16x8 pa[2][2];
#pragma unroll
      for (int u = 0; u < 2; ++u) { pa[u][0] = pack8(s[u][0], s[u][1]); pa[u][1] = pack8(s[u][2], s[u][3]); }
#pragma unroll
      for (int v = 0; v < 8; ++v) {
        o2[0][v & 3] = MFMA16(pa[0][v >> 2], ring[8 + v], o2[0][v & 3]);
        o2[1][v & 3] = MFMA16(pa[1][v >> 2], ring[8 + v], o2[1][v & 3]);
        if (more) ring[8 + v] = *(const bf16x8*)(vn + v * 512 + lane8);
      }
    }
    if (lat) __syncthreads();
    float* wl = (float*)(smem + 4096 + wid * 4352);
#pragma unroll
    for (int u = 0; u < 2; ++u) {
      float lu = l2[u];
      lu += __shfl_xor(lu, 16);
      lu += __shfl_xor(lu, 32);
#pragma unroll
      for (int j = 0; j < 4; ++j) {
        float lq = __shfl(lu, fq * 4 + j);
        float inv = __builtin_amdgcn_rcpf(lq);
#pragma unroll
        for (int dt = 0; dt < 4; ++dt) wl[(fq * 4 + j) * 68 + dt * 16 + fr] = o2[u][dt][j] * inv;
      }
      LDSWAIT();
#pragma unroll
      for (int i = 0; i < 4; ++i) {
        int c = lane + 64 * i, row = c >> 4, ch = c & 15;
        float4 v = *(const float4*)(wl + row * 68 + ch * 4);
        long idx = (long)(tq[u] + row) * 1024 + h2 * 64 + ch * 4;
        uint2 sg = *(const uint2*)(WSB_na_sg + idx);
        store4bf(WSB_na_o + idx, v.x * __uint_as_float(sg.x << 16), v.y * __uint_as_float(sg.x & 0xffff0000u),
                 v.z * __uint_as_float(sg.y << 16), v.w * __uint_as_float(sg.y & 0xffff0000u));
      }
      LDSWAIT();
    }
  }
}

template <bool sample>
__device__ __forceinline__ void ret_main_item(const Params& p, int bh, int qt, char* smem) {
  const int tid = tidx();
  int lane = tid & 63;
  asm volatile("" : "+v"(lane));
  const int fr = lane & 15, fq = lane >> 4;
  const int wid = __builtin_amdgcn_readfirstlane(tid >> 6);
  const int dvh = wid & 1;
  constexpr int S = sample ? 1024 : 256;
  const int tok0 = sample ? TP + (bh >> 2) * 1024 : (bh >> 2) * 256;
  const int hh = bh & 3;
  const int qw = qt * 32 + (wid >> 1) * 16;
  const int qi = qw + fr;
  const float l2f = WSB_dec[hh], l2b = WSB_dec[4 + hh];
  const u16* vFb = (sample ? WSB_rt_vF + (long)TP * 2048 + (long)bh * 1024 * 512 : WSB_rt_vF + (long)bh * 256 * 512) + dvh * 16 * 512;
  const u16* kFb = sample ? WSB_rt_k + (long)TP * 1024 + (long)bh * 1024 * 256 : WSB_rt_k + (long)bh * 256 * 256;
  const unsigned k_lane = fr * 1024 + fq * 8;
  const unsigned lane8 = lane * 8;
  bf16x8* qlds = (bf16x8*)(smem + wid * 8192) + lane;
  {
    const u16* qg = WSB_rt_q + (long)(tok0 + qw) * 1024 + hh * 256;
#pragma unroll
    for (int ks = 0; ks < 8; ++ks) qlds[ks * 64] = *(const bf16x8*)(qg + ks * 32 + k_lane);
  }
  f32x4 o[16];
#pragma unroll
  for (int dt = 0; dt < 16; ++dt) o[dt] = f32x4{0.f, 0.f, 0.f, 0.f};
#define RFRAG(kt_, i_) ((i_) < 16 ? *(const bf16x8*)(kFb + (kt_) * 16384 + (dvh * 16 + (i_)) * 512 + lane8) \
                                  : *(const bf16x8*)(vFb + ((kt_) * 2 + (((i_) - 16) >> 4)) * 16384 + (((i_) - 16) & 15) * 512 + lane8))
  bf16x8* xbuf = (bf16x8*)(smem + 36864);
  bf16x8 ring[16];
#pragma unroll
  for (int i = 0; i < 16; ++i) ring[i] = RFRAG(0, i);
  constexpr int NKT = S / 64;
  for (int kt = 0; kt < NKT; ++kt) {
    f32x4 s[2];
    s[0] = f32x4{0.f, 0.f, 0.f, 0.f}; s[1] = s[0];
#pragma unroll
    for (int i = 0; i < 16; ++i) {
      s[i >> 3] = MFMA16(ring[i], qlds[(i & 7) * 64], s[i >> 3]);
      ring[i] = RFRAG(kt, i + 16);
    }
#pragma unroll
    for (int nl = 0; nl < 2; ++nl)
#pragma unroll
      for (int j = 0; j < 4; ++j) {
        int d = qi - (kt * 64 + (2 * dvh + nl) * 16 + fq * 4 + j);
        float e = (d >= 0 ? l2f : l2b) * fabsf((float)d);
        float w = __builtin_amdgcn_exp2f(e);
        s[nl][j] *= (d == 0 ? 2.0f : w);
      }
    bf16x8 pmine = pack8(s[0], s[1]);
    xbuf[((kt & 1) * 4 + wid) * 64 + lane] = pmine;
    __syncthreads();
    bf16x8 pother = xbuf[((kt & 1) * 4 + (wid ^ 1)) * 64 + lane];
    bf16x8 pa0 = dvh == 0 ? pmine : pother, pa1 = dvh == 0 ? pother : pmine;
#pragma unroll
    for (int v = 0; v < 32; ++v) {
      o[v & 15] = MFMA16(v < 16 ? pa0 : pa1, ring[v & 15], o[v & 15]);
      if (v < 16) ring[v & 15] = RFRAG(kt, 32 + v);
      else if (kt + 1 < NKT) ring[v & 15] = RFRAG(kt + 1, v - 16);
    }
  }
#undef RFRAG
  if (sample) {
    const u16* qs = WSB_rt_qs + ((long)bh * 1024 + qw) * 512;
    const u16* sb = WSB_s0t + (long)bh * 262144 + dvh * 16 * 512;
    const unsigned i_lane = fr * 512 + fq * 8;
#pragma unroll
    for (int dt = 0; dt < 16; ++dt) ring[dt] = *(const bf16x8*)(sb + dt * 512 + lane8);
    bf16x8 a = *(const bf16x8*)(qs + i_lane);
    for (int ks = 0; ks < 16; ++ks) {
      bf16x8 an = a;
      if (ks + 1 < 16) an = *(const bf16x8*)(qs + (ks + 1) * 32 + i_lane);
#pragma unroll
      for (int dt = 0; dt < 16; ++dt) {
        o[dt] = MFMA16(a, ring[dt], o[dt]);
        if (ks + 1 < 16) ring[dt] = *(const bf16x8*)(sb + ((ks + 1) * 32 + dt) * 512 + lane8);
      }
      a = an;
    }
  }
  float* s_st = (float*)(smem + 32768);
  float sm[4], sq[4];
#pragma unroll
  for (int j = 0; j < 4; ++j) {
    float a = 0.f, b = 0.f;
#pragma unroll
    for (int dt = 0; dt < 16; ++dt) { a += o[dt][j]; b += o[dt][j] * o[dt][j]; }
    a += __shfl_xor(a, 1); a += __shfl_xor(a, 2); a += __shfl_xor(a, 4); a += __shfl_xor(a, 8);
    b += __shfl_xor(b, 1); b += __shfl_xor(b, 2); b += __shfl_xor(b, 4); b += __shfl_xor(b, 8);
    sm[j] = a; sq[j] = b;
    if (fr == 0) { s_st[(wid * 16 + fq * 4 + j) * 2] = a; s_st[(wid * 16 + fq * 4 + j) * 2 + 1] = b; }
  }
  __syncthreads();
  float mean[4], rstd[4];
#pragma unroll
  for (int j = 0; j < 4; ++j) {
    float a = sm[j] + s_st[((wid ^ 1) * 16 + fq * 4 + j) * 2];
    float b = sq[j] + s_st[((wid ^ 1) * 16 + fq * 4 + j) * 2 + 1];
    mean[j] = a * (1.f / 512.f);
    float var = fmaxf(b * (1.f / 512.f) - mean[j] * mean[j], 0.f);
    rstd[j] = rsqrtf(var + 1e-6f);
  }
  {
    float* wl = (float*)(smem + wid * 8192);
    const long rowu = (long)(tok0 + qw) * 2048 + hh * 512 + dvh * 256;
    const float* gw = p.ret_gn_w + hh * 512 + dvh * 256;
#pragma unroll
    for (int pp = 0; pp < 4; ++pp) {
#pragma unroll
      for (int j = 0; j < 4; ++j)
#pragma unroll
        for (int d4 = 0; d4 < 4; ++d4) wl[(fq * 4 + j) * 68 + d4 * 16 + fr] = (o[pp * 4 + d4][j] - mean[j]) * rstd[j];
      LDSWAIT();
#pragma unroll
      for (int i = 0; i < 4; ++i) {
        int c = lane + 64 * i, row = c >> 4, ch = c & 15;
        float4 v = *(const float4*)(wl + row * 68 + ch * 4);
        int col = pp * 64 + ch * 4;
        float4 g4 = *(const float4*)(gw + col);
        long idx = rowu + (long)row * 2048 + col;
        uint2 sg = *(const uint2*)(WSB_rt_sg + idx);
        store4bf(WSB_rt_y + idx, v.x * g4.x * __uint_as_float(sg.x << 16), v.y * g4.y * __uint_as_float(sg.x & 0xffff0000u),
                 v.z * g4.z * __uint_as_float(sg.y << 16), v.w * g4.w * __uint_as_float(sg.y & 0xffff0000u));
      }
      LDSWAIT();
    }
  }
  __syncthreads();
}

__device__ __forceinline__ void ret_state_item(const Params& p, int x, char* smem) {
  const int lane = tidx() & 63, wid = tidx() >> 6, wr = wid >> 1, wc = wid & 1;
  float* wl = (float*)(smem + wid * 16384);
  int mat = x >> 3, tile = x & 7, tmm = tile >> 2, tnn = tile & 3;
  f32x4 acc[4][4];
#pragma unroll
  for (int m = 0; m < 4; ++m)
#pragma unroll
    for (int n = 0; n < 4; ++n) acc[m][n] = f32x4{0.f, 0.f, 0.f, 0.f};
  const u16* ka = WSB_rt_kT + (long)mat * 65536 + (tmm * 8 + wr * 4) * 512;
  const u16* vb = WSB_rt_vF + (long)(mat >> 1) * 256 * 512 + (tnn * 8 + wc * 4) * 512;
  const unsigned lane8 = lane * 8;
  bf16x8 afr[2][4], bfg[2][4];
#pragma unroll
  for (int m = 0; m < 4; ++m) { afr[0][m] = *(const bf16x8*)(ka + m * 512 + lane8); bfg[0][m] = *(const bf16x8*)(vb + m * 512 + lane8); }
#pragma unroll
  for (int kk = 0; kk < 8; ++kk) {
    if (kk + 1 < 8) {
#pragma unroll
      for (int m = 0; m < 4; ++m) {
        afr[(kk + 1) & 1][m] = *(const bf16x8*)(ka + (kk + 1) * (16 * 512) + m * 512 + lane8);
        bfg[(kk + 1) & 1][m] = *(const bf16x8*)(vb + (kk + 1) * (32 * 512) + m * 512 + lane8);
      }
    }
#pragma unroll
    for (int m = 0; m < 4; ++m)
#pragma unroll
      for (int n = 0; n < 4; ++n) acc[m][n] = MFMA16(afr[kk & 1][m], bfg[kk & 1][n], acc[m][n]);
  }
  int bh = mat >> 1, dir = mat & 1, b = bh >> 2, hh = bh & 3;
  const int fr = lane & 15, fq = lane >> 4;
  float* outb = WSB_new_ret + ((long)((b * 2 + dir) * 4 + hh) * 256 + tmm * 128 + wr * 64) * 512 + tnn * 128 + wc * 64;
#pragma unroll
  for (int a = 0; a < 2; ++a) {
#pragma unroll
    for (int mm = 0; mm < 2; ++mm)
#pragma unroll
      for (int j = 0; j < 4; ++j)
#pragma unroll
        for (int n = 0; n < 4; ++n) wl[(mm * 16 + fq * 4 + j) * 68 + n * 16 + fr] = acc[2 * a + mm][n][j];
    LDSWAIT();
    rows_out_f32(wl, lane, [&](int row, int ch, float4 v) { *(float4*)(outb + (long)(a * 32 + row) * 512 + ch * 4) = v; });
    LDSWAIT();
  }
  __syncthreads();
}

__device__ __forceinline__ void ret_phase(const Params& p, char* smem) {
  if (gridDim.x == 512) {
    const int x = blockIdx.x & 7, slot = blockIdx.x >> 3;
    ret_main_item<true>(p, x + 8 * (slot >> 5), slot & 31, smem);
    for (int rho = 0; rho < 2; ++rho) ret_main_item<false>(p, x + 8 * (rho * 8 + (slot >> 3)), slot & 7, smem);
    for (int rho = 0; rho < 4; ++rho) ret_state_item(p, (x + 8 * (rho * 8 + (slot >> 3))) * 8 + (slot & 7), smem);
    return;
  }
  for (int it = blockIdx.x; it < 3584; it += gridDim.x) {
    if (it < 512) ret_main_item<true>(p, it >> 5, it & 31, smem);
    else if (it < 1536) { int x = it - 512; ret_main_item<false>(p, x >> 3, x & 7, smem); }
    else ret_state_item(p, it - 1536, smem);
  }
}

__device__ __forceinline__ void mlp_spatial_phase(const Params& p, char* smem) {
  float* s_mu = (float*)smem;
  float* s_rs = s_mu + 128;
  const int tid = tidx(), lane = tid & 63, wid = tid >> 6, wr = wid >> 1, wc = wid & 1, fr = lane & 15, fq = lane >> 4;
  for (int item = blockIdx.x; item < 1536; item += gridDim.x) {
    int chunk = item >> 4, g = (item >> 1) & 7, dh = item & 1;
    if (tid < 128) {
      const float4* st = (const float4*)(WSB_ml_st + ((long)(chunk * 128 + tid) * 32) * 2);
      float a = 0.f, b = 0.f;
#pragma unroll
      for (int i = 0; i < 16; ++i) { float4 v = st[i]; a += v.x + v.z; b += v.y + v.w; }
      float mu = a * (1.f / 2048.f);
      float var = b * (1.f / 2048.f) - mu * mu;
      s_mu[tid] = mu;
      s_rs[tid] = rsqrtf(fmaxf(var, 0.f) + 1e-6f);
    }
    __syncthreads();
    f32x4 acc[4][4];
#pragma unroll
    for (int m = 0; m < 4; ++m)
#pragma unroll
      for (int n = 0; n < 4; ++n) acc[m][n] = f32x4{0.f, 0.f, 0.f, 0.f};
    const int cb = g * 256 + dh * 128 + wc * 64;
    float lw[4], lb[4];
#pragma unroll
    for (int n = 0; n < 4; ++n) { lw[n] = p.mlp_ln_w[cb + n * 16 + fr]; lb[n] = p.mlp_ln_b[cb + n * 16 + fr]; }
    bf16x4 wa[2][4][2];
    bf16x8 rawb[2][4];
    const u16* wbase = WSB_ws_bf + ((long)g * 128 + wr * 64 + fr) * 128 + fq * 4;
    const u16* vbase = WSB_ml_vT + ((long)(chunk * 4) * 128 + (cb >> 4)) * 512 + lane * 8;
#pragma unroll
    for (int m = 0; m < 4; ++m) { wa[0][m][0] = *(const bf16x4*)(wbase + m * 16 * 128); wa[0][m][1] = *(const bf16x4*)(wbase + m * 16 * 128 + 16); }
#pragma unroll
    for (int n = 0; n < 4; ++n) rawb[0][n] = *(const bf16x8*)(vbase + n * 512);
#pragma unroll
    for (int ks = 0; ks < 4; ++ks) {
      if (ks + 1 < 4) {
#pragma unroll
        for (int m = 0; m < 4; ++m) {
          wa[(ks + 1) & 1][m][0] = *(const bf16x4*)(wbase + m * 16 * 128 + (2 * ks + 2) * 16);
          wa[(ks + 1) & 1][m][1] = *(const bf16x4*)(wbase + m * 16 * 128 + (2 * ks + 3) * 16);
        }
#pragma unroll
        for (int n = 0; n < 4; ++n) rawb[(ks + 1) & 1][n] = *(const bf16x8*)(vbase + (long)(ks + 1) * 128 * 512 + n * 512);
      }
      bf16x8 af[4], bfr[4];
#pragma unroll
      for (int m = 0; m < 4; ++m) af[m] = __builtin_shufflevector(wa[ks & 1][m][0], wa[ks & 1][m][1], 0, 1, 2, 3, 4, 5, 6, 7);
      float mu[8], rs[8];
#pragma unroll
      for (int e = 0; e < 8; ++e) { int jx = (2 * ks + (e >> 2)) * 16 + fq * 4 + (e & 3); mu[e] = s_mu[jx]; rs[e] = s_rs[jx]; }
#pragma unroll
      for (int n = 0; n < 4; ++n) {
        bf16x8 raw = rawb[ks & 1][n];
        float v[8];
#pragma unroll
        for (int e = 0; e < 8; ++e) v[e] = (bf2f((u16)raw[e]) - mu[e]) * rs[e] * lw[n] + lb[n];
        u32x4_t pk;
        pk[0] = pk2(v[0], v[1]); pk[1] = pk2(v[2], v[3]); pk[2] = pk2(v[4], v[5]); pk[3] = pk2(v[6], v[7]);
        bfr[n] = __builtin_bit_cast(bf16x8, pk);
      }
#pragma unroll
      for (int m = 0; m < 4; ++m)
#pragma unroll
        for (int n = 0; n < 4; ++n) acc[m][n] = MFMA16(af[m], bfr[n], acc[m][n]);
    }
    {
      float* wl = (float*)(smem + 4096 + wid * 8704);
#pragma unroll
      for (int a = 0; a < 2; ++a) {
#pragma unroll
        for (int mm = 0; mm < 2; ++mm)
#pragma unroll
          for (int j = 0; j < 4; ++j) {
            float bs = p.mlp_b_s[g * 128 + wr * 64 + (2 * a + mm) * 16 + fq * 4 + j];
#pragma unroll
            for (int n = 0; n < 4; ++n) wl[(mm * 16 + fq * 4 + j) * 68 + n * 16 + fr] = acc[2 * a + mm][n][j] + bs;
          }
        LDSWAIT();
        rows_out_f32(wl, lane, [&](int row, int ch, float4 v) {
          long idx = (long)(chunk * 128 + wr * 64 + a * 32 + row) * 2048 + cb + ch * 4;
          uint2 gu = *(const uint2*)(WSB_ml_gu + idx), sg = *(const uint2*)(WSB_ml_sg + idx);
          store4bf(WSB_ml_o + idx,
                   __uint_as_float(gu.x << 16) * v.x * __uint_as_float(sg.x << 16),
                   __uint_as_float(gu.x & 0xffff0000u) * v.y * __uint_as_float(sg.x & 0xffff0000u),
                   __uint_as_float(gu.y << 16) * v.z * __uint_as_float(sg.y << 16),
                   __uint_as_float(gu.y & 0xffff0000u) * v.w * __uint_as_float(sg.y & 0xffff0000u));
        });
        LDSWAIT();
      }
    }
    __syncthreads();
  }
}


#define XB_TMO      128
#define XB_XCNT(j)  (256  + 64 * (j))
#define XB_XSUB(j)  (1280 + 64 * (j))
#define XB_XGEN(j)  (2304 + 64 * (j))
#define XB_TOP      3328
#define XB_TOPGEN   3392
#define XCD_BAR_WORDS 3456
#define XB_SPIN_CAP (1u << 22)
#define LAS __attribute__((address_space(3)))
__device__ __forceinline__ unsigned xb_ld(unsigned* p)              { return __hip_atomic_load(p, __ATOMIC_RELAXED, __HIP_MEMORY_SCOPE_AGENT); }
__device__ __forceinline__ unsigned xb_add(unsigned* p, unsigned v) { return __hip_atomic_fetch_add(p, v, __ATOMIC_RELAXED, __HIP_MEMORY_SCOPE_AGENT); }
__device__ __forceinline__ unsigned xb_xcc_id() { return (unsigned)__builtin_amdgcn_s_getreg((3 << 11) | 20) & 0xFu; }
#define XB_SPIN(cond, bar) do { unsigned _sp = 0; while (cond) { __builtin_amdgcn_s_sleep(1); \
    if ((++_sp & 255u) == 0u) { if (xb_ld(&(bar)[XB_TMO])) break; if (_sp > XB_SPIN_CAP) { atomicAdd(&(bar)[XB_TMO], 1u); break; } } } } while (0)
struct XcdBarrier { unsigned* bar; unsigned x; volatile LAS unsigned* st; };
__device__ __forceinline__ XcdBarrier xcd_barrier_post(unsigned* bar, volatile LAS unsigned* st) {
  XcdBarrier b; b.bar = bar; b.x = xb_xcc_id(); b.st = st;
  if (threadIdx.x == 0) (void)xb_add(&bar[XB_XCNT(b.x)], 1u);
  return b;
}
__device__ __forceinline__ void xcd_barrier_complete(unsigned* bar, unsigned x, unsigned& nloc, unsigned& nx) {
  const unsigned G = gridDim.x * gridDim.y * gridDim.z;
  unsigned sum, cnt, mine, sp = 0u;
  for (;;) {
    sum = 0u; cnt = 0u; mine = 0u;
#pragma unroll
    for (unsigned j = 0; j < 16; ++j) { const unsigned c = xb_ld(&bar[XB_XCNT(j)]); sum += c; cnt += (c > 0u) ? 1u : 0u; mine = (j == x) ? c : mine; }
    if (sum == G) break;
    __builtin_amdgcn_s_sleep(1);
    if ((++sp & 255u) == 0u) { if (xb_ld(&bar[XB_TMO])) break; if (sp > XB_SPIN_CAP) { atomicAdd(&bar[XB_TMO], 1u); break; } }
  }
  nloc = mine > 0u ? mine : 1u; nx = cnt > 0u ? cnt : 1u;
}
__device__ __forceinline__ void xcd_barrier(const XcdBarrier& b) {
  asm volatile("s_waitcnt vmcnt(0)" ::: "memory");
  __syncthreads();
  if (threadIdx.x == 0) {
    unsigned* bar = b.bar;
    __builtin_amdgcn_s_waitcnt(0);
    unsigned nloc = b.st[0], nx = b.st[1];
    if (nloc == 0u) { xcd_barrier_complete(bar, b.x, nloc, nx); b.st[0] = nloc; b.st[1] = nx; }
    const unsigned old = xb_add(&bar[XB_XSUB(b.x)], 1u);
    const unsigned gen = old / nloc;
    if (old + 1u == (gen + 1u) * nloc) {
      __builtin_amdgcn_fence(__ATOMIC_RELEASE, "agent");
      asm volatile("s_waitcnt vmcnt(0)" ::: "memory");
      const unsigned og = xb_add(&bar[XB_TOP], 1u);
      const unsigned tg = og / nx;
      if (og + 1u == (tg + 1u) * nx) xb_add(&bar[XB_TOPGEN], 1u);
      else XB_SPIN(xb_ld(&bar[XB_TOPGEN]) == tg, bar);
      __builtin_amdgcn_fence(__ATOMIC_ACQUIRE, "agent");
      xb_add(&bar[XB_XGEN(b.x)], 1u);
      asm volatile("s_waitcnt vmcnt(0)" ::: "memory");
    } else {
      XB_SPIN(xb_ld(&bar[XB_XGEN(b.x)]) == gen, bar);
      __builtin_amdgcn_fence(__ATOMIC_ACQUIRE, "agent");
      asm volatile("s_waitcnt vmcnt(0)" ::: "memory");
    }
  }
  __syncthreads();
}

__device__ __forceinline__ bool gemm_tile_map(int it, int ntm, int ntn, int& tm, int& tn) {
  if (gridDim.x == 512 && ntn == 8) {
    int x = blockIdx.x & 7, slot = blockIdx.x >> 3;
    int L = it * 64 + slot;
    if (L >= 96) return false;
    tm = x + 8 * (L >> 3); tn = L & 7;
    return true;
  }
  if (gridDim.x == 99999) {
    int x = blockIdx.x & 7, slot = blockIdx.x >> 3;
    int nsn = ntn >> 3, nst = (ntm >> 3) * nsn;
    int sg = it * 8 + x;
    if (sg >= nst) return false;
    int sn = sg % nsn, sm = sg / nsn;
    tm = sm * 8 + (slot >> 3); tn = sn * 8 + (slot & 7);
    return true;
  }
  int t = blockIdx.x + it * gridDim.x;
  if (t >= ntm * ntn) return false;
  tn = t % ntn; tm = t / ntn;
  return true;
}

__device__ __forceinline__ void run_phase(const Params& p, int ph, char* smem) {
  if (ph == 0) { prep_phase(p, smem); return; }
  const int layer = (ph - 1) >> 2, sub = (ph - 1) & 3;
  const int kind = layer % 3, lj = layer / 3;
  const float* xp = layer == 0 ? p.x_prompt : WSB_X;
  const float* xs = layer == 0 ? p.x_sample : WSB_X + (long)TP * 1024;
  float* xout = layer == 3 ? WSB_y_out : WSB_X;
  if (sub == 0) { norm_phase(p, layer, xp, xs); return; }
  if (sub == 1) {
    if (kind == 0) {
      const u16* W = WSB_wt_na_in + (long)lj * 4096 * 1024;
      const int wcw = (tidx() >> 6) & 1;
      for (int t = blockIdx.x; t < 96 * 16; t += gridDim.x) {
        int tn = t & 15, tm = t >> 4;
        f32x4 acc[4][8];
        gemm_core_w(WSB_h + (long)tm * 128 * 1024, 1024, W + (long)tn * 256 * 1024, 1024, 1024, smem, acc);
        epi_na_in<0>(p, lj, tm, 2 * tn + wcw, 0, acc, smem);
        epi_na_in<4>(p, lj, tm, 2 * tn + wcw, 1, acc, smem);
        __syncthreads();
      }
    } else {
      const u16* W = kind == 1 ? WSB_wt_ret_in : WSB_wt_mlp_in;
      const int wcw = (tidx() >> 6) & 1;
      if (kind == 1) {
        for (int t = blockIdx.x; t < 96 * 16; t += gridDim.x) {
          int tn = t & 15, tm = t >> 4;
          f32x4 acc[4][4];
          gemm_core(WSB_h + (long)tm * 128 * 1024, 1024, W + (long)tn * 128 * 1024, 1024, 1024, smem, acc);
          epi_ret_in<0>(p, tm, tn, wcw, acc, smem);
          __syncthreads();
        }
        for (int t = blockIdx.x; t < 96 * 16; t += gridDim.x) {
          int tw = t & 15, tm = t >> 4;
          f32x4 acc[4][8];
          gemm_core_w(WSB_h + (long)tm * 128 * 1024, 1024, W + (long)(2048 + tw * 256) * 1024, 1024, 1024, smem, acc);
          epi_ret_vg<0>(p, tm, 16 + 2 * tw + wcw, 0, acc, smem);
          epi_ret_vg<4>(p, tm, 16 + 2 * tw + wcw, 1, acc, smem);
          __syncthreads();
        }
      } else
      for (int t = blockIdx.x; t < 96 * 24; t += gridDim.x) {
        int tn = t % 24, tm = t / 24;
        f32x4 acc[4][8];
        gemm_core_w(WSB_h + (long)tm * 128 * 1024, 1024, W + (long)tn * 256 * 1024, 1024, 1024, smem, acc);
        epi_mlp_in<0>(p, tm, 2 * tn + wcw, 0, acc, smem);
        epi_mlp_in<4>(p, tm, 2 * tn + wcw, 1, acc, smem);
        __syncthreads();
      }
    }
    return;
  }
  if (sub == 2) {
    if (kind == 0) na_attn_phase(p, lj, smem);
    else if (kind == 1) ret_phase(p, smem);
    else mlp_spatial_phase(p, smem);
    return;
  }
  {
    const u16* A; const u16* W; int K;
    if (kind == 0) { A = WSB_na_o; W = WSB_wt_na_out + (long)lj * 1024 * 1024; K = 1024; }
    else if (kind == 1) { A = WSB_rt_y; W = WSB_wt_ret_out; K = 2048; }
    else { A = WSB_ml_o; W = WSB_wt_mlp_out; K = 2048; }
    const int wcw = (tidx() >> 6) & 1;
    if (gridDim.x == 512) {
      const int x = blockIdx.x & 7, slot = blockIdx.x >> 3;
      if (slot < 32) {
        int tm = x + 8 * (slot >> 2), tn = slot & 3;
        f32x4 acc[4][8];
        gemm_core_w(A + (long)tm * 128 * K, K, W + (long)tn * 256 * K, K, K, smem, acc);
        epi_resid<0>(p, layer, xp, xs, xout, tm, 2 * tn + wcw, 0, acc, smem);
        epi_resid<4>(p, layer, xp, xs, xout, tm, 2 * tn + wcw, 1, acc, smem);
      } else {
        int L = slot - 32;
        int tm = 64 + x + 8 * (L >> 3), tn = L & 7;
        f32x4 acc[4][4];
        gemm_core(A + (long)tm * 128 * K, K, W + (long)tn * 128 * K, K, K, smem, acc);
        epi_resid<0>(p, layer, xp, xs, xout, tm, tn, wcw, acc, smem);
      }
      __syncthreads();
    } else {
      int tm, tn;
      for (int it = 0; gemm_tile_map(it, 96, 8, tm, tn); ++it) {
        f32x4 acc[4][4];
        gemm_core(A + (long)tm * 128 * K, K, W + (long)tn * 128 * K, K, K, smem, acc);
        epi_resid<0>(p, layer, xp, xs, xout, tm, tn, wcw, acc, smem);
        __syncthreads();
      }
    }
  }
}

#define NPHASE 17
#ifndef PROBE_MASK
#define PROBE_MASK 0
#endif

__global__ void __launch_bounds__(256, 2) mega_kernel(Params p) {
  __shared__ __attribute__((aligned(16))) char smem[65536];
  __shared__ uint4 xb_words;
  cg::grid_group grid = cg::this_grid();
  if (threadIdx.x == 0) xb_words = make_uint4(0u, 0u, 0u, 0u);
  __syncthreads();
  XcdBarrier xb = xcd_barrier_post(WSB_bar, (volatile LAS unsigned*)&xb_words);
  {
    int never = 0;
    asm volatile("" : "+s"(never));
    if (never) grid.sync();
  }
#pragma nounroll
  for (int ph = 0; ph < NPHASE; ++ph) {
    int phv = ph;
    asm volatile("" : "+s"(phv));
    run_phase(p, phv, smem);
#if PROBE_MASK
    {
      int sub = (ph - 1) & 3, kind = ((ph - 1) >> 2) % 3;
      int cls = ph == 0 ? 1 : (sub == 0 ? 2 : (sub == 1 ? 4 : (sub == 2 ? (8 << kind) : 64)));
      if (cls & PROBE_MASK) { xcd_barrier(xb); run_phase(p, phv, smem); }
    }
#endif
    if (ph + 1 < NPHASE) xcd_barrier(xb);
  }
}

#ifndef MULTI_LAUNCH
#define MULTI_LAUNCH 0
#endif

extern "C" void kernel_launch(void* const* d_in, const int* in_sizes, int n_in, void* d_out, int out_size, void* d_ws,
                              size_t ws_size, hipStream_t stream) {
  Params p{};
  p.x_prompt = (const float*)d_in[0];  p.x_sample = (const float*)d_in[1];
  p.cache_k = (const float*)d_in[2];   p.cache_v = (const float*)d_in[3];
  p.state_ret = (const float*)d_in[4]; p.c = (const float*)d_in[5];
  p.c_ctx = (const float*)d_in[6];     p.norm_w = (const float*)d_in[7];
  p.w_ada = (const float*)d_in[8];     p.b_ada = (const float*)d_in[9];
  p.na_w_in = (const float*)d_in[10];  p.na_w_out = (const float*)d_in[11];
  p.na_q_gain = (const float*)d_in[12]; p.na_k_gain = (const float*)d_in[13];
  p.na_rpb = (const float*)d_in[14];
  p.ret_w_in = (const float*)d_in[15]; p.ret_w_out = (const float*)d_in[16];
  p.ret_decay = (const float*)d_in[17]; p.ret_gn_w = (const float*)d_in[18];
  p.mlp_w_in = (const float*)d_in[19]; p.mlp_ln_w = (const float*)d_in[20];
  p.mlp_ln_b = (const float*)d_in[21]; p.mlp_w_s = (const float*)d_in[22];
  p.mlp_b_s = (const float*)d_in[23];  p.mlp_w_out = (const float*)d_in[24];
  p.out = (float*)d_out;
  p.ws = (char*)d_ws;

  static int grid_blocks = 0;
  if (!grid_blocks) {
    int dev = 0, cus = 0, per_cu = 0;
    (void)hipGetDevice(&dev);
    (void)hipDeviceGetAttribute(&cus, hipDeviceAttributeMultiprocessorCount, dev);
    (void)hipOccupancyMaxActiveBlocksPerMultiprocessor(&per_cu, mega_kernel, 256, 0);
    if (per_cu > 2) per_cu = 2;
    if (per_cu < 1) per_cu = 1;
    grid_blocks = cus * per_cu;
  }
  (void)hipMemsetAsync(p.ws + 71844096ULL, 0, (size_t)XCD_BAR_WORDS * 4, stream);
  void* args[] = {&p};
  hipError_t e = hipLaunchCooperativeKernel((void*)mega_kernel, dim3(grid_blocks), dim3(256), args, 0, stream);
  if (e != hipSuccess) fprintf(stderr, "cooperative launch failed: %s (grid %d)\n", hipGetErrorString(e), grid_blocks);
}
```

```cpp
#include <hip/hip_runtime.h>
#include <hip/hip_cooperative_groups.h>
#include <cstdio>
namespace cg = cooperative_groups;

typedef unsigned short u16;
using bf16x8 = __attribute__((ext_vector_type(8))) short;
using bf16x4 = __attribute__((ext_vector_type(4))) short;
using f32x4  = __attribute__((ext_vector_type(4))) float;

#define TP 8192
#define TS 4096
#define TT 12288

struct Params {
  const float *x_prompt, *x_sample, *cache_k, *cache_v, *state_ret, *c, *c_ctx, *norm_w, *w_ada, *b_ada;
  const float *na_w_in, *na_w_out, *na_q_gain, *na_k_gain, *na_rpb;
  const float *ret_w_in, *ret_w_out, *ret_decay, *ret_gn_w;
  const float *mlp_w_in, *mlp_ln_w, *mlp_ln_b, *mlp_w_s, *mlp_b_s, *mlp_w_out;
  float* out;
  char* ws;
};
#define WSB_wt_na_in ((u16*)(p.ws + 0ULL))
#define WSB_wt_na_out ((u16*)(p.ws + 16777216ULL))
#define WSB_wt_ret_in ((u16*)(p.ws + 20971520ULL))
#define WSB_wt_ret_out ((u16*)(p.ws + 33554432ULL))
#define WSB_wt_mlp_in ((u16*)(p.ws + 37748736ULL))
#define WSB_wt_mlp_out ((u16*)(p.ws + 50331648ULL))
#define WSB_ws_bf ((u16*)(p.ws + 54525952ULL))
#define WSB_ck_bf ((u16*)(p.ws + 54788096ULL))
#define WSB_cvt_bf ((u16*)(p.ws + 58982400ULL))
#define WSB_s0t ((u16*)(p.ws + 63176704ULL))
#define WSB_mod ((float*)(p.ws + 71565312ULL))
#define WSB_ropetab ((float*)(p.ws + 71811072ULL))
#define WSB_dec ((float*)(p.ws + 71843840ULL))
#define WSB_bar ((unsigned*)(p.ws + 71844096ULL))
#define WSB_X ((float*)(p.ws + 71857920ULL))
#define WSB_h ((u16*)(p.ws + 122189568ULL))
#define WSB_na_q ((u16*)(p.ws + 147355392ULL))
#define WSB_na_k ((u16*)(p.ws + 172521216ULL))
#define WSB_na_vT ((u16*)(p.ws + 197687040ULL))
#define WSB_na_sg ((u16*)(p.ws + 222852864ULL))
#define WSB_na_o ((u16*)(p.ws + 248018688ULL))
#define WSB_rt_q ((u16*)(p.ws + 147355392ULL))
#define WSB_rt_k ((u16*)(p.ws + 172521216ULL))
#define WSB_rt_qs ((u16*)(p.ws + 197687040ULL))
#define WSB_rt_kT ((u16*)(p.ws + 214464256ULL))
#define WSB_rt_vF ((u16*)(p.ws + 248018688ULL))
#define WSB_rt_sg ((u16*)(p.ws + 298350336ULL))
#define WSB_rt_y ((u16*)(p.ws + 348681984ULL))
#define WSB_ml_gu ((u16*)(p.ws + 147355392ULL))
#define WSB_ml_vT ((u16*)(p.ws + 197687040ULL))
#define WSB_ml_sg ((u16*)(p.ws + 248018688ULL))
#define WSB_ml_o ((u16*)(p.ws + 298350336ULL))
#define WSB_ml_st ((float*)(p.ws + 348681984ULL))
#define WSB_y_out (p.out + 0ULL)
#define WSB_new_k (p.out + 12582912ULL)
#define WSB_new_v (p.out + 29360128ULL)
#define WSB_new_ret (p.out + 46137344ULL)


typedef unsigned u32x4_t __attribute__((ext_vector_type(4)));
typedef __bf16 bf16v2_t __attribute__((ext_vector_type(2)));
typedef float f32v2_t __attribute__((ext_vector_type(2)));
__device__ __forceinline__ unsigned pk2(float a, float b) {
  f32v2_t v = {a, b};
  bf16v2_t r = __builtin_convertvector(v, bf16v2_t);
  return __builtin_bit_cast(unsigned, r);
}
__device__ __forceinline__ u16 f2bf(float f) { return (u16)(pk2(f, f) & 0xffffu); }
__device__ __forceinline__ float bf2f(u16 h) { return __uint_as_float(((unsigned)h) << 16); }
__device__ __forceinline__ bf16x8 pack8(f32x4 a, f32x4 b) {
  u32x4_t r;
  r[0] = pk2(a[0], a[1]); r[1] = pk2(a[2], a[3]); r[2] = pk2(b[0], b[1]); r[3] = pk2(b[2], b[3]);
  return __builtin_bit_cast(bf16x8, r);
}
__device__ __forceinline__ void store4bf(u16* dst, float a, float b, float c, float d) {
  uint2 v; v.x = pk2(a, b); v.y = pk2(c, d);
  *(uint2*)dst = v;
}
__device__ __forceinline__ float silu_f(float x) { return x * __builtin_amdgcn_rcpf(1.f + __expf(-x)); }
__device__ __forceinline__ float gelu_f(float x) {
  float z = 0.7978845608028654f * (x + 0.044715f * x * x * x);
  float t = 1.f - 2.f * __builtin_amdgcn_rcpf(__expf(2.f * z) + 1.f);
  return 0.5f * x * (1.f + t);
}
__device__ __forceinline__ void st2bf(u16* base, int i0, int i1, float a, float b) {
  unsigned v = pk2(a, b);
  base[i0] = (u16)(v & 0xffffu);
  base[i1] = (u16)(v >> 16);
}
__device__ __forceinline__ int tidx() { int t = threadIdx.x; asm volatile("" : "+v"(t)); return t; }
#define MFMA16(a, b, c) __builtin_amdgcn_mfma_f32_16x16x32_bf16((a), (b), (c), 0, 0, 0)

__device__ __forceinline__ void gemm_core(const u16* __restrict__ A, long lda, const u16* __restrict__ B, long ldb,
                                          int K, char* smem, f32x4 (&acc)[4][4]) {
  const int tid = tidx(), lane = tid & 63, wid = tid >> 6, wr = wid >> 1, wc = wid & 1, fr = lane & 15, fq = lane >> 4;
#pragma unroll
  for (int m = 0; m < 4; ++m)
#pragma unroll
    for (int n = 0; n < 4; ++n) acc[m][n] = f32x4{0.f, 0.f, 0.f, 0.f};
  const int nk = K >> 6;
  const int r0 = tid >> 3, c0 = (tid & 7) ^ ((r0 >> 1) & 7);
  const u16* ap = A + (long)r0 * lda + c0 * 8;
  const u16* bp = B + (long)r0 * ldb + c0 * 8;
  const long sa32 = 32 * lda, sb32 = 32 * ldb;
  uint4 ga0, ga1, ga2, ga3, gb0, gb1, gb2, gb3, ha0, ha1, ha2, ha3, hb0, hb1, hb2, hb3;
  char* lw = smem + tid * 16;
#define GLOAD(P, kt) { P##a0 = *(const uint4*)(ap + (kt) * 64); P##a1 = *(const uint4*)(ap + sa32 + (kt) * 64); \
    P##a2 = *(const uint4*)(ap + 2 * sa32 + (kt) * 64); P##a3 = *(const uint4*)(ap + 3 * sa32 + (kt) * 64); \
    P##b0 = *(const uint4*)(bp + (kt) * 64); P##b1 = *(const uint4*)(bp + sb32 + (kt) * 64); \
    P##b2 = *(const uint4*)(bp + 2 * sb32 + (kt) * 64); P##b3 = *(const uint4*)(bp + 3 * sb32 + (kt) * 64); }
#define LWRITE(P, b) { char* l_ = lw + (b) * 32768; \
    *(uint4*)(l_) = P##a0; *(uint4*)(l_ + 4096) = P##a1; *(uint4*)(l_ + 8192) = P##a2; *(uint4*)(l_ + 12288) = P##a3; \
    *(uint4*)(l_ + 16384) = P##b0; *(uint4*)(l_ + 20480) = P##b1; *(uint4*)(l_ + 24576) = P##b2; *(uint4*)(l_ + 28672) = P##b3; }
  auto compute = [&](int b) {
    const char* sa = smem + b * 32768;
    const char* sb = sa + 16384;
#pragma unroll
    for (int ks = 0; ks < 2; ++ks) {
      bf16x8 af[4], bfr[4];
#pragma unroll
      for (int m = 0; m < 4; ++m) {
        int r = wr * 64 + m * 16 + fr;
        af[m] = *(const bf16x8*)(sa + (r * 8 + ((ks * 4 + fq) ^ ((r >> 1) & 7))) * 16);
      }
#pragma unroll
      for (int n = 0; n < 4; ++n) {
        int r = wc * 64 + n * 16 + fr;
        bfr[n] = *(const bf16x8*)(sb + (r * 8 + ((ks * 4 + fq) ^ ((r >> 1) & 7))) * 16);
      }
#pragma unroll
      for (int m = 0; m < 4; ++m)
#pragma unroll
        for (int n = 0; n < 4; ++n) acc[m][n] = MFMA16(af[m], bfr[n], acc[m][n]);
    }
  };
  GLOAD(g, 0);
  GLOAD(h, 1);
  LWRITE(g, 0);
  __syncthreads();
  for (int t = 0; t < nk; t += 2) {
    if (t + 2 < nk) GLOAD(g, t + 2);
    __builtin_amdgcn_sched_barrier(0);
    compute(0);
    __builtin_amdgcn_sched_barrier(0);
    LWRITE(h, 1);
    __syncthreads();
    if (t + 3 < nk) GLOAD(h, t + 3);
    __builtin_amdgcn_sched_barrier(0);
    compute(1);
    __builtin_amdgcn_sched_barrier(0);
    if (t + 2 < nk) LWRITE(g, 0);
    __syncthreads();
  }
#undef GLOAD
#undef LWRITE
}


__device__ __forceinline__ int swz4(int r) { return (4 - ((r >> 2) & 3)) & 3; }
__device__ __forceinline__ void gemm_core_w(const u16* __restrict__ A, long lda, const u16* __restrict__ B, long ldb,
                                            int K, char* smem, f32x4 (&acc)[4][8]) {
  const int tid = tidx(), lane = tid & 63, wid = tid >> 6, wr = wid >> 1, wc = wid & 1, fr = lane & 15, fq = lane >> 4;
#pragma unroll
  for (int m = 0; m < 4; ++m)
#pragma unroll
    for (int n = 0; n < 8; ++n) acc[m][n] = f32x4{0.f, 0.f, 0.f, 0.f};
  const int nk = K >> 5;
  const int r0 = tid >> 2, c0 = (tid & 3) ^ swz4(r0);
  const u16* ap = A + (long)r0 * lda + c0 * 8;
  const u16* bp = B + (long)r0 * ldb + c0 * 8;
  const long sa64 = 64 * lda, sb64 = 64 * ldb;
  uint4 ga0, ga1, gb0, gb1, gb2, gb3, ha0, ha1, hb0, hb1, hb2, hb3;
  char* lw = smem + tid * 16;
#define GLOADW(P, kt) { P##a0 = *(const uint4*)(ap + (kt) * 32); P##a1 = *(const uint4*)(ap + sa64 + (kt) * 32); \
    P##b0 = *(const uint4*)(bp + (kt) * 32); P##b1 = *(const uint4*)(bp + sb64 + (kt) * 32); \
    P##b2 = *(const uint4*)(bp + 2 * sb64 + (kt) * 32); P##b3 = *(const uint4*)(bp + 3 * sb64 + (kt) * 32); }
#define LWRITEW(P, b) { char* l_ = lw + (b) * 24576; \
    *(uint4*)(l_) = P##a0; *(uint4*)(l_ + 4096) = P##a1; \
    *(uint4*)(l_ + 8192) = P##b0; *(uint4*)(l_ + 12288) = P##b1; *(uint4*)(l_ + 16384) = P##b2; *(uint4*)(l_ + 20480) = P##b3; }
  auto compute = [&](int b) {
    const char* sa = smem + b * 24576;
    const char* sb = sa + 8192;
    bf16x8 af[4];
#pragma unroll
    for (int m = 0; m < 4; ++m) {
      int r = wr * 64 + m * 16 + fr;
      af[m] = *(const bf16x8*)(sa + (r * 4 + (fq ^ swz4(r))) * 16);
    }
#pragma unroll
    for (int nh = 0; nh < 2; ++nh) {
      bf16x8 bfr[4];
#pragma unroll
      for (int n = 0; n < 4; ++n) {
        int r = wc * 128 + (nh * 4 + n) * 16 + fr;
        bfr[n] = *(const bf16x8*)(sb + (r * 4 + (fq ^ swz4(r))) * 16);
      }
#pragma unroll
      for (int m = 0; m < 4; ++m)
#pragma unroll
        for (int n = 0; n < 4; ++n) acc[m][nh * 4 + n] = MFMA16(af[m], bfr[n], acc[m][nh * 4 + n]);
    }
  };
  GLOADW(g, 0);
  GLOADW(h, 1);
  LWRITEW(g, 0);
  __syncthreads();
  for (int t = 0; t < nk; t += 2) {
    if (t + 2 < nk) GLOADW(g, t + 2);
    __builtin_amdgcn_sched_barrier(0);
    compute(0);
    __builtin_amdgcn_sched_barrier(0);
    LWRITEW(h, 1);
    __syncthreads();
    if (t + 3 < nk) GLOADW(h, t + 3);
    __builtin_amdgcn_sched_barrier(0);
    compute(1);
    __builtin_amdgcn_sched_barrier(0);
    if (t + 2 < nk) LWRITEW(g, 0);
    __syncthreads();
  }
#undef GLOADW
#undef LWRITEW
}

__device__ __forceinline__ void adaln_item(const Params& p, int it, char* smem) {
  const int tid = tidx();
  int layer = it / 192, n0 = (it % 192) * 16;
  float* s_c = (float*)smem;
  float* s_p = s_c + 5120;
  for (int idx = tid; idx < 5120; idx += 256) {
    int v = idx >> 10, kk = idx & 1023;
    float cv = (v == 0) ? p.c_ctx[kk] : p.c[(v - 1) * 1024 + kk];
    s_c[idx] = silu_f(cv);
  }
  __syncthreads();
  int cl = tid & 3, ksl = tid >> 2;
  const float* w = p.w_ada + (long)layer * 1024 * 3072 + n0 + cl * 4;
  float4 a0 = {0, 0, 0, 0}, a1 = a0, a2 = a0, a3 = a0, a4 = a0;
#pragma unroll
  for (int kk = 0; kk < 16; ++kk) {
    int k = ksl * 16 + kk;
    float4 w4 = *(const float4*)(w + (long)k * 3072);
    float c0 = s_c[k], c1 = s_c[1024 + k], c2 = s_c[2048 + k], c3 = s_c[3072 + k], c4 = s_c[4096 + k];
    a0.x += c0 * w4.x; a0.y += c0 * w4.y; a0.z += c0 * w4.z; a0.w += c0 * w4.w;
    a1.x += c1 * w4.x; a1.y += c1 * w4.y; a1.z += c1 * w4.z; a1.w += c1 * w4.w;
    a2.x += c2 * w4.x; a2.y += c2 * w4.y; a2.z += c2 * w4.z; a2.w += c2 * w4.w;
    a3.x += c3 * w4.x; a3.y += c3 * w4.y; a3.z += c3 * w4.z; a3.w += c3 * w4.w;
    a4.x += c4 * w4.x; a4.y += c4 * w4.y; a4.z += c4 * w4.z; a4.w += c4 * w4.w;
  }
  *(float4*)(s_p + (ksl * 5 + 0) * 16 + cl * 4) = a0;
  *(float4*)(s_p + (ksl * 5 + 1) * 16 + cl * 4) = a1;
  *(float4*)(s_p + (ksl * 5 + 2) * 16 + cl * 4) = a2;
  *(float4*)(s_p + (ksl * 5 + 3) * 16 + cl * 4) = a3;
  *(float4*)(s_p + (ksl * 5 + 4) * 16 + cl * 4) = a4;
  __syncthreads();
  if (tid < 80) {
    int v = tid >> 4, col = tid & 15;
    float s = p.b_ada[layer * 3072 + n0 + col];
#pragma unroll 8
    for (int k2 = 0; k2 < 64; ++k2) s += s_p[(k2 * 5 + v) * 16 + col];
    WSB_mod[(layer * 5 + v) * 3072 + n0 + col] = s;
  }
  __syncthreads();
}

__device__ __forceinline__ void tr_tile(const float* __restrict__ src, long ld_src, u16* __restrict__ dst, long ld_dst,
                        int r0, int c0, int perm, char* smem) {
  float* tile = (float*)smem;
  const int tid = tidx();
  {
    int c4 = (tid & 15) * 4;
    int pcol = c0 + c4;
    int scol = pcol;
    if (perm) {
      int blk = pcol & ~127, w = pcol & 127;
      int r = w & 63;
      scol = blk + (r >> 5) * 64 + (w >> 6) * 32 + (r & 31);
    }
#pragma unroll
    for (int i = 0; i < 4; ++i) {
      int rr = (tid >> 4) + i * 16;
      float4 v = *(const float4*)(src + (long)(r0 + rr) * ld_src + scol);
      float* t = tile + rr * 65 + c4;
      t[0] = v.x; t[1] = v.y; t[2] = v.z; t[3] = v.w;
    }
  }
  __syncthreads();
  {
    int kc = (tid & 7) * 8;
#pragma unroll
    for (int i = 0; i < 2; ++i) {
      int pp = (tid >> 3) + i * 32;
      const float* t = tile + kc * 65 + pp;
      uint4 o;
      o.x = pk2(t[0], t[65]); o.y = pk2(t[130], t[195]); o.z = pk2(t[260], t[325]); o.w = pk2(t[390], t[455]);
      *(uint4*)(dst + (long)(c0 + pp) * ld_dst + r0 + kc) = o;
    }
  }
  __syncthreads();
}

__device__ __forceinline__ void tr_item(const Params& p, int x, char* smem) {
  if (x < 2048) {
    int bt = x >> 10, tt = x & 1023, rt = tt & 15, ct = tt >> 4;
    tr_tile(p.na_w_in + (long)bt * 1024 * 4096, 4096, WSB_wt_na_in + (long)bt * 4096 * 1024, 1024, rt * 64, ct * 64, 0, smem);
    return;
  }
  x -= 2048;
  if (x < 512) {
    int bt = x >> 8, tt = x & 255, rt = tt & 15, ct = tt >> 4;
    tr_tile(p.na_w_out + (long)bt * 1024 * 1024, 1024, WSB_wt_na_out + (long)bt * 1024 * 1024, 1024, rt * 64, ct * 64, 0, smem);
    return;
  }
  x -= 512;
  if (x < 1536) {
    int rt = x & 15, ct = x >> 4;
    tr_tile(p.ret_w_in, 6144, WSB_wt_ret_in, 1024, rt * 64, ct * 64, ct < 32 ? 1 : 0, smem);
    return;
  }
  x -= 1536;
  if (x < 512) {
    int rt = x & 31, ct = x >> 5;
    tr_tile(p.ret_w_out, 1024, WSB_wt_ret_out, 2048, rt * 64, ct * 64, 0, smem);
    return;
  }
  x -= 512;
  if (x < 1536) {
    int rt = x & 15, ct = x >> 4;
    tr_tile(p.mlp_w_in, 6144, WSB_wt_mlp_in, 1024, rt * 64, ct * 64, 0, smem);
    return;
  }
  x -= 1536;
  if (x < 512) {
    int rt = x & 31, ct = x >> 5;
    tr_tile(p.mlp_w_out, 1024, WSB_wt_mlp_out, 2048, rt * 64, ct * 64, 0, smem);
    return;
  }
  x -= 512;
  (void)x;
}

__device__ __forceinline__ void cv_item(const Params& p, int it) {
  const int tid = tidx();
  if (it < 128) {
    long base = (long)it * 1024 + tid * 4;
    float4 v = *(const float4*)(p.mlp_w_s + base);
    store4bf(WSB_ws_bf + base, v.x, v.y, v.z, v.w);
    return;
  }
  it -= 128;
  if (it < 1024) {
    int g = it * 256 + tid;
    int seq = g >> 11, r = g & 2047, lane = r & 63, f = r >> 6;
    int ks = f & 1, n = (f >> 1) & 3, kt = f >> 3, fr = lane & 15, fq = lane >> 4;
    int blj = seq >> 4, hh = seq & 15;
    int s = kt * 64 + n * 16 + fr, d0 = ks * 32 + fq * 8;
    const float* sp = p.cache_k + ((long)(blj * 256 + s) * 16 + hh) * 64 + d0;
    float4 a = *(const float4*)sp, b = *(const float4*)(sp + 4);
    uint4 o; o.x = pk2(a.x, a.y); o.y = pk2(a.z, a.w); o.z = pk2(b.x, b.y); o.w = pk2(b.z, b.w);
    *(uint4*)(WSB_ck_bf + (long)g * 8) = o;
    return;
  }
  it -= 1024;
  if (it < 1024) {
    int g = it * 256 + tid;
    int seq = g >> 11, r = g & 2047, lane = r & 63, f = r >> 6;
    int dt = f & 3, ks2 = (f >> 2) & 1, kt = f >> 3, fr = lane & 15, fq = lane >> 4;
    int blj = seq >> 4, hh = seq & 15;
    int dv = dt * 16 + fr, kA = kt * 64 + (2 * ks2) * 16 + fq * 4;
    const float* sp = p.cache_v + ((long)(blj * 256 + kA) * 16 + hh) * 64 + dv;
    uint4 o;
    o.x = pk2(sp[0], sp[1024]); o.y = pk2(sp[2048], sp[3072]);
    o.z = pk2(sp[16 * 1024], sp[17 * 1024]); o.w = pk2(sp[18 * 1024], sp[19 * 1024]);
    *(uint4*)(WSB_cvt_bf + (long)g * 8) = o;
    return;
  }
  it -= 1024;
  {
    int g = it * 256 + tid;
    int bh = g >> 15, r = g & 32767, lane = r & 63, f = r >> 6;
    int dtg = f & 31, ks = f >> 5, fr = lane & 15, fq = lane >> 4;
    int dv = dtg * 16 + fr, k0 = ks * 32 + fq * 8, dir = k0 >> 8, dk0 = k0 & 255;
    int b = bh >> 2, hh = bh & 3;
    const float* sp = p.state_ret + ((long)((b * 2 + dir) * 4 + hh) * 256 + dk0) * 512 + dv;
    uint4 o;
    o.x = pk2(sp[0], sp[512]); o.y = pk2(sp[1024], sp[1536]);
    o.z = pk2(sp[2048], sp[2560]); o.w = pk2(sp[3072], sp[3584]);
    *(uint4*)(WSB_s0t + (long)g * 8) = o;
  }
}

__device__ __forceinline__ void misc_item(const Params& p) {
  const int tid = tidx();
  for (int idx = tid; idx < 4096; idx += 256) {
    int pos = idx >> 6, i = idx & 63;
    float inv = __builtin_amdgcn_exp2f(-(float)i * (13.287712379549449f / 64.f));
    float ang = (float)pos * inv;
    WSB_ropetab[2 * idx] = __cosf(ang);
    WSB_ropetab[2 * idx + 1] = __sinf(ang);
  }
  if (tid < 8) {
    float x = p.ret_decay[tid];
    float y = __expf(-x);
    float lg1p = y * (1.f - y * (0.5f - y * (0.33333334f - y * (0.25f - y * (0.2f - y * 0.16666667f)))));
    if (y > 0.25f) lg1p = __logf(1.f + y);
    WSB_dec[tid] = -lg1p * 1.4426950408889634f;
  }
}

__device__ __forceinline__ void prep_phase(const Params& p, char* smem) {
  const int NADA = 768, NTR = 6656, NCV = 128 + 1024 + 1024 + 2048;
  for (int it = blockIdx.x; it < NADA + NTR + NCV + 1; it += gridDim.x) {
    if (it < NADA) adaln_item(p, it, smem);
    else if (it < NADA + NTR) tr_item(p, it - NADA, smem);
    else if (it < NADA + NTR + NCV) cv_item(p, it - NADA - NTR);
    else misc_item(p);
  }
}

__device__ __forceinline__ void norm_phase(const Params& p, int layer, const float* xp, const float* xs) {
  const int wave = tidx() >> 6, lane = tidx() & 63;
  const float* nw = p.norm_w + layer * 1024;
  for (int row = blockIdx.x * 4 + wave; row < TT; row += gridDim.x * 4) {
    const float* x = row < TP ? xp + (long)row * 1024 : xs + (long)(row - TP) * 1024;
    int mv = row < TP ? 0 : 1 + ((row - TP) >> 10);
    const float* md = WSB_mod + (long)(layer * 5 + mv) * 3072;
    float4 v[4];
    float ss = 0.f;
#pragma unroll
    for (int i = 0; i < 4; ++i) {
      v[i] = *(const float4*)(x + i * 256 + lane * 4);
      ss += v[i].x * v[i].x + v[i].y * v[i].y + v[i].z * v[i].z + v[i].w * v[i].w;
    }
#pragma unroll
    for (int o = 32; o > 0; o >>= 1) ss += __shfl_xor(ss, o);
    float r = rsqrtf(ss * (1.f / 1024.f) + 1e-6f);
#pragma unroll
    for (int i = 0; i < 4; ++i) {
      int c = i * 256 + lane * 4;
      float4 w4 = *(const float4*)(nw + c);
      float4 sh = *(const float4*)(md + c);
      float4 sc = *(const float4*)(md + 1024 + c);
      float o0 = (v[i].x * r * w4.x) * (1.f + sc.x) + sh.x;
      float o1 = (v[i].y * r * w4.y) * (1.f + sc.y) + sh.y;
      float o2 = (v[i].z * r * w4.z) * (1.f + sc.z) + sh.z;
      float o3 = (v[i].w * r * w4.w) * (1.f + sc.w) + sh.w;
      store4bf(WSB_h + (long)row * 1024 + c, o0, o1, o2, o3);
    }
  }
}

__device__ __forceinline__ void nt_store4(float* ptr, float4 v) { f32x4 t = {v.x, v.y, v.z, v.w}; __builtin_nontemporal_store(t, (f32x4*)ptr); }
#define LDSWAIT() asm volatile("s_waitcnt lgkmcnt(0)" ::: "memory")

__device__ __forceinline__ void rows_out_bf16(const char* wl, int lane, u16* dst, long ld) {
#pragma unroll
  for (int i = 0; i < 8; ++i) {
    int row = (lane >> 3) + 8 * i, ch = lane & 7;
    uint4 v = *(const uint4*)(wl + row * 144 + ch * 16);
    *(uint4*)(dst + (long)row * ld + ch * 8) = v;
  }
}
__device__ __forceinline__ void rows_out_bf16_split(const char* wl, int lane, u16* dst, long ld, int gap) {
#pragma unroll
  for (int i = 0; i < 8; ++i) {
    int row = (lane >> 3) + 8 * i, ch = lane & 7;
    uint4 v = *(const uint4*)(wl + row * 144 + ch * 16);
    *(uint4*)(dst + (long)row * ld + (ch & 3) * 8 + (ch >> 2) * gap) = v;
  }
}
template <class F>
__device__ __forceinline__ void rows_out_f32(const float* wl, int lane, F f) {
#pragma unroll
  for (int i = 0; i < 8; ++i) {
    int row = (lane >> 4) + 4 * i, ch = lane & 15;
    float4 v = *(const float4*)(wl + row * 68 + ch * 4);
    f(row, ch, v);
  }
}

template <int NO, int NW>
__device__ __forceinline__ void epi_resid(const Params& p, int layer, const float* xp, const float* xs, float* xout,
                                          int tm, int tn, int wc, f32x4 (&acc)[4][NW], char* smem) {
  const int lane = tidx() & 63, wid = tidx() >> 6, wr = wid >> 1, fr = lane & 15, fq = lane >> 4;
  float* wl = (float*)(smem + wid * 16384);
  int mv = tm < 64 ? 0 : 1 + ((tm - 64) >> 3);
  const int ch = lane & 15;
  const int col = tn * 128 + wc * 64 + ch * 4;
  const float4 g4 = *(const float4*)(WSB_mod + (long)(layer * 5 + mv) * 3072 + 2048 + col);
  const int trow0 = tm * 128 + wr * 64;
  const float* xin = (trow0 < TP ? xp + (long)trow0 * 1024 : xs + (long)(trow0 - TP) * 1024) + col;
  float* xo = xout + (long)trow0 * 1024 + col;
#pragma unroll
  for (int a = 0; a < 2; ++a) {
#pragma unroll
    for (int mm = 0; mm < 2; ++mm)
#pragma unroll
      for (int j = 0; j < 4; ++j)
#pragma unroll
        for (int n = 0; n < 4; ++n) wl[(mm * 16 + fq * 4 + j) * 68 + n * 16 + fr] = acc[2 * a + mm][NO + (n)][j];
    LDSWAIT();
    rows_out_f32(wl, lane, [&](int row, int, float4 v) {
      long off = (long)(a * 32 + row) * 1024;
      float4 x = *(const float4*)(xin + off);
      float4 o;
      o.x = x.x + g4.x * v.x; o.y = x.y + g4.y * v.y; o.z = x.z + g4.z * v.z; o.w = x.w + g4.w * v.w;
      *(float4*)(xo + off) = o;
    });
    LDSWAIT();
  }
}

template <int NO, int NW>
__device__ __forceinline__ void epi_na_in(const Params& p, int lj, int tm, int tn, int wc, f32x4 (&acc)[4][NW], char* smem) {
  const int lane = tidx() & 63, wid = tidx() >> 6, wr = wid >> 1, fr = lane & 15, fq = lane >> 4;
  char* wl = smem + wid * 16384;
  u16* wl16 = (u16*)wl;
  float* wlf = (float*)wl;
  const int sec = tn >> 3;
  const int cbase = (tn & 7) * 128 + wc * 64;
  const int head = cbase >> 6;
  const int row0 = tm * 128 + wr * 64;
  int b, s0; long sb;
  if (row0 < TP) { b = row0 >> 8; s0 = row0 & 255; sb = (long)(b * 16 + head) * 256 * 64; }
  else { int ts = row0 - TP; b = ts >> 10; s0 = ts & 1023; sb = (long)TP * 1024 + (long)(b * 16 + head) * 1024 * 64; }
  const int kt = s0 >> 6;
  if (sec <= 1) {
    const float* gain = (sec == 0 ? p.na_q_gain : p.na_k_gain) + lj * 64;
    float g[4];
#pragma unroll
    for (int n = 0; n < 4; ++n) g[n] = gain[n * 16 + fr] * (sec == 0 ? 0.125f : 1.f);
#pragma unroll
    for (int m = 0; m < 4; ++m)
#pragma unroll
      for (int j = 0; j < 4; ++j) {
        float ss = 0.f;
#pragma unroll
        for (int n = 0; n < 4; ++n) ss += acc[m][NO + (n)][j] * acc[m][NO + (n)][j];
        ss += __shfl_xor(ss, 1); ss += __shfl_xor(ss, 2); ss += __shfl_xor(ss, 4); ss += __shfl_xor(ss, 8);
        float r = rsqrtf(ss * (1.f / 64.f) + 1e-6f);
#pragma unroll
        for (int n = 0; n < 4; ++n) acc[m][NO + (n)][j] *= r * g[n];
      }
#pragma unroll
    for (int m = 0; m < 4; ++m)
#pragma unroll
      for (int j = 0; j < 4; ++j)
#pragma unroll
        for (int n = 0; n < 4; n += 2) st2bf(wl16, (m * 16 + fq * 4 + j) * 72 + n * 16 + fr, (m * 16 + fq * 4 + j) * 72 + (n + 1) * 16 + fr, acc[m][NO + (n)][j], acc[m][NO + (n + 1)][j]);
    LDSWAIT();
    if (sec == 0) {
      rows_out_bf16(wl, lane, WSB_na_q + (long)row0 * 1024 + cbase, 1024);
    } else {
#pragma unroll
      for (int m = 0; m < 4; ++m)
#pragma unroll
        for (int ks = 0; ks < 2; ++ks) {
          uint4 v = *(const uint4*)(wl + (m * 16 + fr) * 144 + (ks * 32 + fq * 8) * 2);
          *(uint4*)(WSB_na_k + sb + (long)(((kt * 4 + m) * 2 + ks) * 64 + lane) * 8) = v;
        }
    }
    LDSWAIT();
    if (sec == 1 && row0 < TP) {
      float* nk = WSB_new_k + ((long)(b * 2 + lj) * 256 + s0) * 1024 + head * 64;
#pragma unroll
      for (int a = 0; a < 2; ++a) {
#pragma unroll
        for (int mm = 0; mm < 2; ++mm)
#pragma unroll
          for (int j = 0; j < 4; ++j)
#pragma unroll
            for (int n = 0; n < 4; ++n) wlf[(mm * 16 + fq * 4 + j) * 68 + n * 16 + fr] = acc[2 * a + mm][NO + (n)][j];
        LDSWAIT();
        rows_out_f32(wlf, lane, [&](int row, int ch, float4 v) { nt_store4(nk + (long)(a * 32 + row) * 1024 + ch * 4, v); });
        LDSWAIT();
      }
    }
  } else if (sec == 2) {
#pragma unroll
    for (int m = 0; m < 4; m += 2) {
#pragma unroll
      for (int n = 0; n < 4; ++n) {
        f32x4 a = acc[m][NO + (n)], a2 = acc[m + 1][NO + (n)];
        uint4 o; o.x = pk2(a[0], a[1]); o.y = pk2(a[2], a[3]); o.z = pk2(a2[0], a2[1]); o.w = pk2(a2[2], a2[3]);
        *(uint4*)(WSB_na_vT + sb + ((long)(((kt * 2 + (m >> 1)) * 4 + n) * 64 + lane)) * 8) = o;
      }
    }
    if (row0 < TP) {
      float* nv = WSB_new_v + ((long)(b * 2 + lj) * 256 + s0) * 1024 + head * 64;
#pragma unroll
      for (int a = 0; a < 2; ++a) {
#pragma unroll
        for (int mm = 0; mm < 2; ++mm)
#pragma unroll
          for (int j = 0; j < 4; ++j)
#pragma unroll
            for (int n = 0; n < 4; ++n) wlf[(mm * 16 + fq * 4 + j) * 68 + n * 16 + fr] = acc[2 * a + mm][NO + (n)][j];
        LDSWAIT();
        rows_out_f32(wlf, lane, [&](int row, int ch, float4 v) { nt_store4(nv + (long)(a * 32 + row) * 1024 + ch * 4, v); });
        LDSWAIT();
      }
    }
  } else {
#pragma unroll
    for (int m = 0; m < 4; ++m)
#pragma unroll
      for (int j = 0; j < 4; ++j)
#pragma unroll
        for (int n = 0; n < 4; n += 2) st2bf(wl16, (m * 16 + fq * 4 + j) * 72 + n * 16 + fr, (m * 16 + fq * 4 + j) * 72 + (n + 1) * 16 + fr, silu_f(acc[m][NO + (n)][j]), silu_f(acc[m][NO + (n + 1)][j]));
    LDSWAIT();
    rows_out_bf16(wl, lane, WSB_na_sg + (long)row0 * 1024 + cbase, 1024);
    LDSWAIT();
  }
}

template <int NO, int NW>
__device__ __forceinline__ void epi_ret_in(const Params& p, int tm, int tn, int wc, f32x4 (&acc)[4][NW], char* smem) {
  const int lane = tidx() & 63, wid = tidx() >> 6, wr = wid >> 1, fr = lane & 15, fq = lane >> 4;
  char* wl = smem + wid * 16384;
  u16* wl16 = (u16*)wl;
  const int row0 = tm * 128 + wr * 64;
  const bool sample = tm >= 64;
  if (tn < 16) {
    const bool isk = tn >= 8;
    const int blk = tn & 7, hh = blk >> 1, half = blk & 1;
    const float l2f = WSB_dec[hh], l2b = WSB_dec[4 + hh];
#pragma unroll
    for (int m = 0; m < 4; ++m)
#pragma unroll
      for (int j = 0; j < 4; ++j) {
        int t = row0 + m * 16 + fq * 4 + j;
        int nn = (t - TP) & 1023;
        int pos = half == 0 ? (nn >> 6) : (nn & 63);
#pragma unroll
        for (int n2 = 0; n2 < 2; ++n2) {
          int i = wc * 32 + n2 * 16 + fr;
          float x1 = acc[m][NO + (n2)][j], x2 = acc[m][NO + (n2 + 2)][j];
          float o1 = x1, o2 = x2;
          if (sample) {
            float2 cs = *(const float2*)(WSB_ropetab + 2 * (pos * 64 + i));
            o1 = x1 * cs.x - x2 * cs.y;
            o2 = x1 * cs.y + x2 * cs.x;
          }
          if (isk) { o1 *= 0.0625f; o2 *= 0.0625f; }
          acc[m][NO + (n2)][j] = o1; acc[m][NO + (n2 + 2)][j] = o2;
        }
      }
#pragma unroll
    for (int m = 0; m < 4; ++m)
#pragma unroll
      for (int j = 0; j < 4; ++j)
#pragma unroll
        for (int n = 0; n < 4; n += 2) st2bf(wl16, (m * 16 + fq * 4 + j) * 72 + (n >> 1) * 32 + fr, (m * 16 + fq * 4 + j) * 72 + (n >> 1) * 32 + 16 + fr, acc[m][NO + (n)][j], acc[m][NO + (n + 1)][j]);
    LDSWAIT();
    if (!isk) {
      rows_out_bf16_split(wl, lane, WSB_rt_q + (long)row0 * 1024 + hh * 256 + half * 128 + wc * 32, 1024, 64);
      LDSWAIT();
      if (sample) {
        int ts0 = row0 - TP, b = ts0 >> 10, nn0 = ts0 & 1023;
        u16* qs = WSB_rt_qs + ((long)(b * 4 + hh) * 1024 + nn0) * 512 + half * 128 + wc * 32;
#pragma unroll
        for (int dir = 0; dir < 2; ++dir) {
#pragma unroll
          for (int m = 0; m < 4; ++m)
#pragma unroll
            for (int j = 0; j < 4; ++j) {
              int nn = nn0 + m * 16 + fq * 4 + j;
              float w = dir == 0 ? exp2f(l2f * (float)(nn + 1)) : exp2f(l2b * (float)(1024 - nn));
#pragma unroll
              for (int n = 0; n < 4; n += 2) st2bf(wl16, (m * 16 + fq * 4 + j) * 72 + (n >> 1) * 32 + fr, (m * 16 + fq * 4 + j) * 72 + (n >> 1) * 32 + 16 + fr, acc[m][NO + (n)][j] * w, acc[m][NO + (n + 1)][j] * w);
            }
          LDSWAIT();
          rows_out_bf16_split(wl, lane, qs + dir * 256, 512, 64);
          LDSWAIT();
        }
      }
    } else {
      int s0; long sb;
      if (!sample) { s0 = row0 & 255; sb = (long)((row0 >> 8) * 4 + hh) * 256 * 256; }
      else { int ts = row0 - TP; s0 = ts & 1023; sb = (long)TP * 1024 + (long)((ts >> 10) * 4 + hh) * 1024 * 256; }
      const int kt = s0 >> 6;
#pragma unroll
      for (int m = 0; m < 4; ++m)
#pragma unroll
        for (int r = 0; r < 2; ++r) {
          uint4 v = *(const uint4*)(wl + (m * 16 + fr) * 144 + (r * 32 + fq * 8) * 2);
          *(uint4*)(WSB_rt_k + sb + (long)(((kt * 4 + m) * 8 + half * 4 + wc + 2 * r) * 64 + lane) * 8) = v;
        }
      LDSWAIT();
      if (!sample) {
        const int bh = (row0 >> 8) * 4 + hh;
#pragma unroll
        for (int m = 0; m < 4; m += 2) {
          float wf[8], wb[8];
#pragma unroll
          for (int e = 0; e < 8; ++e) {
            int s = s0 + (m + (e >> 2)) * 16 + fq * 4 + (e & 3);
            wf[e] = exp2f(l2f * (float)(255 - s));
            wb[e] = exp2f(l2b * (float)s);
          }
#pragma unroll
          for (int n = 0; n < 4; ++n) {
            int dk = half * 128 + (n >> 1) * 64 + wc * 32 + (n & 1) * 16;
            f32x4 a = acc[m][NO + (n)], a2 = acc[m + 1][NO + (n)];
            uint4 of, ob;
            of.x = pk2(a[0] * wf[0], a[1] * wf[1]); of.y = pk2(a[2] * wf[2], a[3] * wf[3]);
            of.z = pk2(a2[0] * wf[4], a2[1] * wf[5]); of.w = pk2(a2[2] * wf[6], a2[3] * wf[7]);
            ob.x = pk2(a[0] * wb[0], a[1] * wb[1]); ob.y = pk2(a[2] * wb[2], a[3] * wb[3]);
            ob.z = pk2(a2[0] * wb[4], a2[1] * wb[5]); ob.w = pk2(a2[2] * wb[6], a2[3] * wb[7]);
            long off = ((long)((kt * 2 + (m >> 1)) * 16 + (dk >> 4)) * 64 + lane) * 8;
            *(uint4*)(WSB_rt_kT + (long)(bh * 2 + 0) * 65536 + off) = of;
            *(uint4*)(WSB_rt_kT + (long)(bh * 2 + 1) * 65536 + off) = ob;
          }
        }
      }
    }
  } else if (tn < 32) {
    const int cv0 = (tn - 16) * 128 + wc * 64;
    const int hh = cv0 >> 9;
    int s0; long sb;
    if (!sample) { s0 = row0 & 255; sb = (long)((row0 >> 8) * 4 + hh) * 256 * 512; }
    else { int ts = row0 - TP; s0 = ts & 1023; sb = (long)TP * 2048 + (long)((ts >> 10) * 4 + hh) * 1024 * 512; }
    const int kt = s0 >> 6;
#pragma unroll
    for (int m = 0; m < 4; m += 2)
#pragma unroll
      for (int n = 0; n < 4; ++n) {
        int dvt = ((cv0 & 511) >> 4) + n;
        f32x4 a = acc[m][NO + (n)], a2 = acc[m + 1][NO + (n)];
        uint4 o; o.x = pk2(a[0], a[1]); o.y = pk2(a[2], a[3]); o.z = pk2(a2[0], a2[1]); o.w = pk2(a2[2], a2[3]);
        *(uint4*)(WSB_rt_vF + sb + ((long)((kt * 2 + (m >> 1)) * 32 + dvt) * 64 + lane) * 8) = o;
      }
  } else {
#pragma unroll
    for (int m = 0; m < 4; ++m)
#pragma unroll
      for (int j = 0; j < 4; ++j)
#pragma unroll
        for (int n = 0; n < 4; n += 2) st2bf(wl16, (m * 16 + fq * 4 + j) * 72 + n * 16 + fr, (m * 16 + fq * 4 + j) * 72 + (n + 1) * 16 + fr, silu_f(acc[m][NO + (n)][j]), silu_f(acc[m][NO + (n + 1)][j]));
    LDSWAIT();
    rows_out_bf16(wl, lane, WSB_rt_sg + (long)row0 * 2048 + (tn - 32) * 128 + wc * 64, 2048);
    LDSWAIT();
  }
}

template <int NO, int NW>
__device__ __forceinline__ void epi_ret_vg(const Params& p, int tm, int tn, int wc, f32x4 (&acc)[4][NW], char* smem) {
  const int lane = tidx() & 63, wid = tidx() >> 6, wr = wid >> 1, fr = lane & 15, fq = lane >> 4;
  char* wl = smem + wid * 16384;
  u16* wl16 = (u16*)wl;
  const int row0 = tm * 128 + wr * 64;
  const bool sample = tm >= 64;
  (void)fq; (void)fr; (void)wl16;
  if (tn < 32) {
    const int cv0 = (tn - 16) * 128 + wc * 64;
    const int hh = cv0 >> 9;
    int s0; long sb;
    if (!sample) { s0 = row0 & 255; sb = (long)((row0 >> 8) * 4 + hh) * 256 * 512; }
    else { int ts = row0 - TP; s0 = ts & 1023; sb = (long)TP * 2048 + (long)((ts >> 10) * 4 + hh) * 1024 * 512; }
    const int kt = s0 >> 6;
#pragma unroll
    for (int m = 0; m < 4; m += 2)
#pragma unroll
      for (int n = 0; n < 4; ++n) {
        int dvt = ((cv0 & 511) >> 4) + n;
        f32x4 a = acc[m][NO + (n)], a2 = acc[m + 1][NO + (n)];
        uint4 o; o.x = pk2(a[0], a[1]); o.y = pk2(a[2], a[3]); o.z = pk2(a2[0], a2[1]); o.w = pk2(a2[2], a2[3]);
        *(uint4*)(WSB_rt_vF + sb + ((long)((kt * 2 + (m >> 1)) * 32 + dvt) * 64 + lane) * 8) = o;
      }
  } else {
#pragma unroll
    for (int m = 0; m < 4; ++m)
#pragma unroll
      for (int j = 0; j < 4; ++j)
#pragma unroll
        for (int n = 0; n < 4; n += 2) st2bf(wl16, (m * 16 + fq * 4 + j) * 72 + n * 16 + fr, (m * 16 + fq * 4 + j) * 72 + (n + 1) * 16 + fr, silu_f(acc[m][NO + (n)][j]), silu_f(acc[m][NO + (n + 1)][j]));
    LDSWAIT();
    rows_out_bf16(wl, lane, WSB_rt_sg + (long)row0 * 2048 + (tn - 32) * 128 + wc * 64, 2048);
    LDSWAIT();
  }
}

template <int NO, int NW>
__device__ __forceinline__ void epi_mlp_in(const Params& p, int tm, int tn, int wc, f32x4 (&acc)[4][NW], char* smem) {
  const int lane = tidx() & 63, wid = tidx() >> 6, wr = wid >> 1, fr = lane & 15, fq = lane >> 4;
  char* wl = smem + wid * 16384;
  u16* wl16 = (u16*)wl;
  const int row0 = tm * 128 + wr * 64;
  if (tn < 16 || tn >= 32) {
    const bool isu = tn < 16;
    u16* dstb = isu ? WSB_ml_gu : WSB_ml_sg;
    const int c0 = (isu ? tn : tn - 32) * 128 + wc * 64;
#pragma unroll
    for (int m = 0; m < 4; ++m)
#pragma unroll
      for (int j = 0; j < 4; ++j)
#pragma unroll
        for (int n = 0; n < 4; n += 2) {
          float a = acc[m][NO + (n)][j], a1 = acc[m][NO + (n + 1)][j];
          st2bf(wl16, (m * 16 + fq * 4 + j) * 72 + n * 16 + fr, (m * 16 + fq * 4 + j) * 72 + (n + 1) * 16 + fr,
                isu ? gelu_f(a) : silu_f(a), isu ? gelu_f(a1) : silu_f(a1));
        }
    LDSWAIT();
    rows_out_bf16(wl, lane, dstb + (long)row0 * 2048 + c0, 2048);
    LDSWAIT();
  } else {
    const int c0 = (tn - 16) * 128 + wc * 64;
    float s1[4][4], s2[4][4];
#pragma unroll
    for (int m = 0; m < 4; ++m)
#pragma unroll
      for (int j = 0; j < 4; ++j) { s1[m][j] = 0.f; s2[m][j] = 0.f; }
#pragma unroll
    for (int m = 0; m < 4; ++m)
#pragma unroll
      for (int n = 0; n < 4; ++n)
#pragma unroll
        for (int j = 0; j < 4; ++j) {
          float gq = bf2f(f2bf(gelu_f(acc[m][NO + (n)][j])));
          acc[m][NO + (n)][j] = gq;
          s1[m][j] += gq; s2[m][j] += gq * gq;
        }
#pragma unroll
    for (int m = 0; m < 4; m += 2)
#pragma unroll
      for (int n = 0; n < 4; ++n) {
        f32x4 a = acc[m][NO + (n)], a2 = acc[m + 1][NO + (n)];
        uint4 o; o.x = pk2(a[0], a[1]); o.y = pk2(a[2], a[3]); o.z = pk2(a2[0], a2[1]); o.w = pk2(a2[2], a2[3]);
        int ks2 = wr * 2 + (m >> 1), ct = (c0 >> 4) + n;
        *(uint4*)(WSB_ml_vT + ((long)((tm * 4 + ks2) * 128 + ct) * 64 + lane) * 8) = o;
      }
#pragma unroll
    for (int m = 0; m < 4; ++m)
#pragma unroll
      for (int j = 0; j < 4; ++j) {
        float a = s1[m][j], b = s2[m][j];
        a += __shfl_xor(a, 1); a += __shfl_xor(a, 2); a += __shfl_xor(a, 4); a += __shfl_xor(a, 8);
        b += __shfl_xor(b, 1); b += __shfl_xor(b, 2); b += __shfl_xor(b, 4); b += __shfl_xor(b, 8);
        if (fr == 0) {
          int t = row0 + m * 16 + fq * 4 + j;
          float2 st; st.x = a; st.y = b;
          *(float2*)(WSB_ml_st + ((long)t * 32 + (tn - 16) * 2 + wc) * 2) = st;
        }
      }
  }
}

__device__ __forceinline__ void na_attn_phase(const Params& p, int lj, char* smem) {
  float* s_rpb = (float*)smem;
  const int tid = tidx(), lane = tid & 63, wid = tid >> 6, fr = lane & 15, fq = lane >> 4;
  const unsigned lane8 = lane * 8;
  for (int item0 = blockIdx.x; item0 < 1536; item0 += gridDim.x) {
    bool lat; int bhi, sub;
    if (gridDim.x == 512) {
      const int x = blockIdx.x & 7, slot = blockIdx.x >> 3, k = item0 >> 9;
      if (k == 0) { lat = true; bhi = x + 8 * (slot >> 3); sub = slot & 7; }
      else { lat = false; bhi = x + 8 * ((k - 1) * 32 + (slot >> 1)); sub = slot & 1; }
    } else {
      if (item0 < 512) { lat = true; bhi = item0 >> 3; sub = item0 & 7; }
      else { lat = false; bhi = (item0 - 512) >> 1; sub = (item0 - 512) & 1; }
    }
    const int b2 = bhi >> 4, h2 = bhi & 15;
    int tq[2], rr[2] = {0, 0}, rs[2] = {0, 0}, NTloc, NT;
    const u16 *kb2, *vb2, *ckb = nullptr, *cvb = nullptr;
    if (lat) {
      rr[0] = 2 * sub; rr[1] = 2 * sub + 1;
      rs[0] = min(max(rr[0] - 4, 0), 8); rs[1] = min(max(rr[1] - 4, 0), 8);
      NTloc = rs[1] - rs[0] + 8; NT = NTloc + 4;
      tq[0] = TP + b2 * 1024 + rr[0] * 64 + wid * 16; tq[1] = tq[0] + 64;
      kb2 = WSB_na_k + (long)TP * 1024 + (long)bhi * 1024 * 64 + rs[0] * 4096;
      vb2 = WSB_na_vT + (long)TP * 1024 + (long)bhi * 1024 * 64 + rs[0] * 4096;
      ckb = WSB_ck_bf + (long)((b2 * 2 + lj) * 16 + h2) * 256 * 64;
      cvb = WSB_cvt_bf + (long)((b2 * 2 + lj) * 16 + h2) * 256 * 64;
      const float* rp = p.na_rpb + (long)(lj * 16 + h2) * 465;
      for (int i = tid; i < 465; i += 256) s_rpb[i] = rp[i];
      __syncthreads();
    } else {
      NTloc = 0; NT = 4;
      tq[0] = b2 * 256 + sub * 128 + wid * 16; tq[1] = tq[0] + 64;
      kb2 = WSB_na_k + (long)bhi * 256 * 64;
      vb2 = WSB_na_vT + (long)bhi * 256 * 64;
    }
    const int cq = wid * 16 + fr;
    const int cstart = min(max(cq - 8, 0), 48);
    bf16x8 qf2[2][2];
    f32x4 o2[2][4];
    float l2[2] = {0.f, 0.f};
#pragma unroll
    for (int u = 0; u < 2; ++u) {
#pragma unroll
      for (int ks = 0; ks < 2; ++ks) qf2[u][ks] = *(const bf16x8*)(WSB_na_q + (long)(tq[u] + fr) * 1024 + h2 * 64 + ks * 32 + fq * 8);
#pragma unroll
      for (int dt = 0; dt < 4; ++dt) o2[u][dt] = f32x4{0.f, 0.f, 0.f, 0.f};
    }
    bf16x8 ring[16];
#pragma unroll
    for (int i = 0; i < 8; ++i) { ring[i] = *(const bf16x8*)(kb2 + i * 512 + lane8); ring[8 + i] = *(const bf16x8*)(vb2 + i * 512 + lane8); }
    for (int tau = 0; tau < NT; ++tau) {
      const bool more = tau + 1 < NT;
      const u16 *kn = kb2, *vn = vb2;
      if (more) {
        if (lat && tau + 1 >= NTloc) { kn = ckb + (tau + 1 - NTloc) * 4096; vn = cvb + (tau + 1 - NTloc) * 4096; }
        else { kn = kb2 + (tau + 1) * 4096; vn = vb2 + (tau + 1) * 4096; }
      }
      f32x4 s[2][4];
#pragma unroll
      for (int u = 0; u < 2; ++u)
#pragma unroll
        for (int n = 0; n < 4; ++n) s[u][n] = f32x4{0.f, 0.f, 0.f, 0.f};
#pragma unroll
      for (int i = 0; i < 8; ++i) {
        s[0][i >> 1] = MFMA16(ring[i], qf2[0][i & 1], s[0][i >> 1]);
        s[1][i >> 1] = MFMA16(ring[i], qf2[1][i & 1], s[1][i >> 1]);
        if (more) ring[i] = *(const bf16x8*)(kn + i * 512 + lane8);
      }
      if (lat && tau < NTloc) {
        const int jr = rs[0] + tau;
#pragma unroll
        for (int u = 0; u < 2; ++u) {
          const bool rowok = (jr >= rs[u]) && (jr < rs[u] + 8);
          const float* rb = s_rpb + min(max(jr - rr[u] + 7, 0), 14) * 31;
#pragma unroll
          for (int n = 0; n < 4; ++n)
#pragma unroll
            for (int j = 0; j < 4; ++j) {
              int ck = n * 16 + fq * 4 + j;
              bool valid = rowok && (ck >= cstart) && (ck < cstart + 16);
              int coff = min(max(ck - cq + 15, 0), 30);
              float e = __expf(s[u][n][j] + rb[coff]);
              float pv = valid ? e : 0.f;
              l2[u] += pv; s[u][n][j] = pv;
            }
        }
      } else {
#pragma unroll
        for (int u = 0; u < 2; ++u)
#pragma unroll
          for (int n = 0; n < 4; ++n)
#pragma unroll
            for (int j = 0; j < 4; ++j) { float pv = __expf(s[u][n][j]); l2[u] += pv; s[u][n][j] = pv; }
      }
      bf16x8 pa[2][2];
#pragma unroll
      for (int u = 0; u < 2; ++u) { pa[u][0] = pack8(s[u][0], s[u][1]); pa[u][1] = pack8(s[u][2], s[u][3]); }
#pragma unroll
      for (int v = 0; v < 8; ++v) {
        o2[0][v & 3] = MFMA16(pa[0][v >> 2], ring[8 + v], o2[0][v & 3]);
        o2[1][v & 3] = MFMA16(pa[1][v >> 2], ring[8 + v], o2[1][v & 3]);
        if (more) ring[8 + v] = *(const bf16x8*)(vn + v * 512 + lane8);
      }
    }
    if (lat) __syncthreads();
    float* wl = (float*)(smem + 4096 + wid * 4352);
#pragma unroll
    for (int u = 0; u < 2; ++u) {
      float lu = l2[u];
      lu += __shfl_xor(lu, 16);
      lu += __shfl_xor(lu, 32);
#pragma unroll
      for (int j = 0; j < 4; ++j) {
        float lq = __shfl(lu, fq * 4 + j);
        float inv = __builtin_amdgcn_rcpf(lq);
#pragma unroll
        for (int dt = 0; dt < 4; ++dt) wl[(fq * 4 + j) * 68 + dt * 16 + fr] = o2[u][dt][j] * inv;
      }
      LDSWAIT();
#pragma unroll
      for (int i = 0; i < 4; ++i) {
        int c = lane + 64 * i, row = c >> 4, ch = c & 15;
        float4 v = *(const float4*)(wl + row * 68 + ch * 4);
        long idx = (long)(tq[u] + row) * 1024 + h2 * 64 + ch * 4;
        uint2 sg = *(const uint2*)(WSB_na_sg + idx);
        store4bf(WSB_na_o + idx, v.x * __uint_as_float(sg.x << 16), v.y * __uint_as_float(sg.x & 0xffff0000u),
                 v.z * __uint_as_float(sg.y << 16), v.w * __uint_as_float(sg.y & 0xffff0000u));
      }
      LDSWAIT();
    }
  }
}

template <bool sample>
__device__ __forceinline__ void ret_main_item(const Params& p, int bh, int qt, char* smem) {
  const int tid = tidx();
  int lane = tid & 63;
  asm volatile("" : "+v"(lane));
  const int fr = lane & 15, fq = lane >> 4;
  const int wid = __builtin_amdgcn_readfirstlane(tid >> 6);
  const int dvh = wid & 1;
  constexpr int S = sample ? 1024 : 256;
  const int tok0 = sample ? TP + (bh >> 2) * 1024 : (bh >> 2) * 256;
  const int hh = bh & 3;
  const int qw = qt * 32 + (wid >> 1) * 16;
  const int qi = qw + fr;
  const float l2f = WSB_dec[hh], l2b = WSB_dec[4 + hh];
  const u16* vFb = (sample ? WSB_rt_vF + (long)TP * 2048 + (long)bh * 1024 * 512 : WSB_rt_vF + (long)bh * 256 * 512) + dvh * 16 * 512;
  const u16* kFb = sample ? WSB_rt_k + (long)TP * 1024 + (long)bh * 1024 * 256 : WSB_rt_k + (long)bh * 256 * 256;
  const unsigned k_lane = fr * 1024 + fq * 8;
  const unsigned lane8 = lane * 8;
  bf16x8* qlds = (bf16x8*)(smem + wid * 8192) + lane;
  {
    const u16* qg = WSB_rt_q + (long)(tok0 + qw) * 1024 + hh * 256;
#pragma unroll
    for (int ks = 0; ks < 8; ++ks) qlds[ks * 64] = *(const bf16x8*)(qg + ks * 32 + k_lane);
  }
  f32x4 o[16];
#pragma unroll
  for (int dt = 0; dt < 16; ++dt) o[dt] = f32x4{0.f, 0.f, 0.f, 0.f};
#define RFRAG(kt_, i_) ((i_) < 16 ? *(const bf16x8*)(kFb + (kt_) * 16384 + (dvh * 16 + (i_)) * 512 + lane8) \
                                  : *(const bf16x8*)(vFb + ((kt_) * 2 + (((i_) - 16) >> 4)) * 16384 + (((i_) - 16) & 15) * 512 + lane8))
  bf16x8* xbuf = (bf16x8*)(smem + 36864);
  bf16x8 ring[16];
#pragma unroll
  for (int i = 0; i < 16; ++i) ring[i] = RFRAG(0, i);
  constexpr int NKT = S / 64;
  for (int kt = 0; kt < NKT; ++kt) {
    f32x4 s[2];
    s[0] = f32x4{0.f, 0.f, 0.f, 0.f}; s[1] = s[0];
#pragma unroll
    for (int i = 0; i < 16; ++i) {
      s[i >> 3] = MFMA16(ring[i], qlds[(i & 7) * 64], s[i >> 3]);
      ring[i] = RFRAG(kt, i + 16);
    }
#pragma unroll
    for (int nl = 0; nl < 2; ++nl)
#pragma unroll
      for (int j = 0; j < 4; ++j) {
        int d = qi - (kt * 64 + (2 * dvh + nl) * 16 + fq * 4 + j);
        float e = (d >= 0 ? l2f : l2b) * fabsf((float)d);
        float w = __builtin_amdgcn_exp2f(e);
        s[nl][j] *= (d == 0 ? 2.0f : w);
      }
    bf16x8 pmine = pack8(s[0], s[1]);
    xbuf[((kt & 1) * 4 + wid) * 64 + lane] = pmine;
    __syncthreads();
    bf16x8 pother = xbuf[((kt & 1) * 4 + (wid ^ 1)) * 64 + lane];
    bf16x8 pa0 = dvh == 0 ? pmine : pother, pa1 = dvh == 0 ? pother : pmine;
#pragma unroll
    for (int v = 0; v < 32; ++v) {
      o[v & 15] = MFMA16(v < 16 ? pa0 : pa1, ring[v & 15], o[v & 15]);
      if (v < 16) ring[v & 15] = RFRAG(kt, 32 + v);
      else if (kt + 1 < NKT) ring[v & 15] = RFRAG(kt + 1, v - 16);
    }
  }
#undef RFRAG
  if (sample) {
    const u16* qs = WSB_rt_qs + ((long)bh * 1024 + qw) * 512;
    const u16* sb = WSB_s0t + (long)bh * 262144 + dvh * 16 * 512;
    const unsigned i_lane = fr * 512 + fq * 8;
#pragma unroll
    for (int dt = 0; dt < 16; ++dt) ring[dt] = *(const bf16x8*)(sb + dt * 512 + lane8);
    bf16x8 a = *(const bf16x8*)(qs + i_lane);
    for (int ks = 0; ks < 16; ++ks) {
      bf16x8 an = a;
      if (ks + 1 < 16) an = *(const bf16x8*)(qs + (ks + 1) * 32 + i_lane);
#pragma unroll
      for (int dt = 0; dt < 16; ++dt) {
        o[dt] = MFMA16(a, ring[dt], o[dt]);
        if (ks + 1 < 16) ring[dt] = *(const bf16x8*)(sb + ((ks + 1) * 32 + dt) * 512 + lane8);
      }
      a = an;
    }
  }
  float* s_st = (float*)(smem + 32768);
  float sm[4], sq[4];
#pragma unroll
  for (int j = 0; j < 4; ++j) {
    float a = 0.f, b = 0.f;
#pragma unroll
    for (int dt = 0; dt < 16; ++dt) { a += o[dt][j]; b += o[dt][j] * o[dt][j]; }
    a += __shfl_xor(a, 1); a += __shfl_xor(a, 2); a += __shfl_xor(a, 4); a += __shfl_xor(a, 8);
    b += __shfl_xor(b, 1); b += __shfl_xor(b, 2); b += __shfl_xor(b, 4); b += __shfl_xor(b, 8);
    sm[j] = a; sq[j] = b;
    if (fr == 0) { s_st[(wid * 16 + fq * 4 + j) * 2] = a; s_st[(wid * 16 + fq * 4 + j) * 2 + 1] = b; }
  }
  __syncthreads();
  float mean[4], rstd[4];
#pragma unroll
  for (int j = 0; j < 4; ++j) {
    float a = sm[j] + s_st[((wid ^ 1) * 16 + fq * 4 + j) * 2];
    float b = sq[j] + s_st[((wid ^ 1) * 16 + fq * 4 + j) * 2 + 1];
    mean[j] = a * (1.f / 512.f);
    float var = fmaxf(b * (1.f / 512.f) - mean[j] * mean[j], 0.f);
    rstd[j] = rsqrtf(var + 1e-6f);
  }
  {
    float* wl = (float*)(smem + wid * 8192);
    const long rowu = (long)(tok0 + qw) * 2048 + hh * 512 + dvh * 256;
    const float* gw = p.ret_gn_w + hh * 512 + dvh * 256;
#pragma unroll
    for (int pp = 0; pp < 4; ++pp) {
#pragma unroll
      for (int j = 0; j < 4; ++j)
#pragma unroll
        for (int d4 = 0; d4 < 4; ++d4) wl[(fq * 4 + j) * 68 + d4 * 16 + fr] = (o[pp * 4 + d4][j] - mean[j]) * rstd[j];
      LDSWAIT();
#pragma unroll
      for (int i = 0; i < 4; ++i) {
        int c = lane + 64 * i, row = c >> 4, ch = c & 15;
        float4 v = *(const float4*)(wl + row * 68 + ch * 4);
        int col = pp * 64 + ch * 4;
        float4 g4 = *(const float4*)(gw + col);
        long idx = rowu + (long)row * 2048 + col;
        uint2 sg = *(const uint2*)(WSB_rt_sg + idx);
        store4bf(WSB_rt_y + idx, v.x * g4.x * __uint_as_float(sg.x << 16), v.y * g4.y * __uint_as_float(sg.x & 0xffff0000u),
                 v.z * g4.z * __uint_as_float(sg.y << 16), v.w * g4.w * __uint_as_float(sg.y & 0xffff0000u));
      }
      LDSWAIT();
    }
  }
  __syncthreads();
}

__device__ __forceinline__ void ret_state_item(const Params& p, int x, char* smem) {
  const int lane = tidx() & 63, wid = tidx() >> 6, wr = wid >> 1, wc = wid & 1;
  float* wl = (float*)(smem + wid * 16384);
  int mat = x >> 3, tile = x & 7, tmm = tile >> 2, tnn = tile & 3;
  f32x4 acc[4][4];
#pragma unroll
  for (int m = 0; m < 4; ++m)
#pragma unroll
    for (int n = 0; n < 4; ++n) acc[m][n] = f32x4{0.f, 0.f, 0.f, 0.f};
  const u16* ka = WSB_rt_kT + (long)mat * 65536 + (tmm * 8 + wr * 4) * 512;
  const u16* vb = WSB_rt_vF + (long)(mat >> 1) * 256 * 512 + (tnn * 8 + wc * 4) * 512;
  const unsigned lane8 = lane * 8;
  bf16x8 afr[2][4], bfg[2][4];
#pragma unroll
  for (int m = 0; m < 4; ++m) { afr[0][m] = *(const bf16x8*)(ka + m * 512 + lane8); bfg[0][m] = *(const bf16x8*)(vb + m * 512 + lane8); }
#pragma unroll
  for (int kk = 0; kk < 8; ++kk) {
    if (kk + 1 < 8) {
#pragma unroll
      for (int m = 0; m < 4; ++m) {
        afr[(kk + 1) & 1][m] = *(const bf16x8*)(ka + (kk + 1) * (16 * 512) + m * 512 + lane8);
        bfg[(kk + 1) & 1][m] = *(const bf16x8*)(vb + (kk + 1) * (32 * 512) + m * 512 + lane8);
      }
    }
#pragma unroll
    for (int m = 0; m < 4; ++m)
#pragma unroll
      for (int n = 0; n < 4; ++n) acc[m][n] = MFMA16(afr[kk & 1][m], bfg[kk & 1][n], acc[m][n]);
  }
  int bh = mat >> 1, dir = mat & 1, b = bh >> 2, hh = bh & 3;
  const int fr = lane & 15, fq = lane >> 4;
  float* outb = WSB_new_ret + ((long)((b * 2 + dir) * 4 + hh) * 256 + tmm * 128 + wr * 64) * 512 + tnn * 128 + wc * 64;
#pragma unroll
  for (int a = 0; a < 2; ++a) {
#pragma unroll
    for (int mm = 0; mm < 2; ++mm)
#pragma unroll
      for (int j = 0; j < 4; ++j)
#pragma unroll
        for (int n = 0; n < 4; ++n) wl[(mm * 16 + fq * 4 + j) * 68 + n * 16 + fr] = acc[2 * a + mm][n][j];
    LDSWAIT();
    rows_out_f32(wl, lane, [&](int row, int ch, float4 v) { nt_store4(outb + (long)(a * 32 + row) * 512 + ch * 4, v); });
    LDSWAIT();
  }
  __syncthreads();
}

__device__ __forceinline__ void ret_phase(const Params& p, char* smem) {
  if (gridDim.x == 512) {
    const int x = blockIdx.x & 7, slot = blockIdx.x >> 3;
    ret_main_item<true>(p, x + 8 * (slot >> 5), slot & 31, smem);
    for (int rho = 0; rho < 2; ++rho) ret_main_item<false>(p, x + 8 * (rho * 8 + (slot >> 3)), slot & 7, smem);
    for (int rho = 0; rho < 4; ++rho) ret_state_item(p, (x + 8 * (rho * 8 + (slot >> 3))) * 8 + (slot & 7), smem);
    return;
  }
  for (int it = blockIdx.x; it < 3584; it += gridDim.x) {
    if (it < 512) ret_main_item<true>(p, it >> 5, it & 31, smem);
    else if (it < 1536) { int x = it - 512; ret_main_item<false>(p, x >> 3, x & 7, smem); }
    else ret_state_item(p, it - 1536, smem);
  }
}

__device__ __forceinline__ void mlp_spatial_phase(const Params& p, char* smem) {
  float* s_mu = (float*)smem;
  float* s_rs = s_mu + 128;
  const int tid = tidx(), lane = tid & 63, wid = tid >> 6, wr = wid >> 1, wc = wid & 1, fr = lane & 15, fq = lane >> 4;
  for (int item = blockIdx.x; item < 1536; item += gridDim.x) {
    int chunk = item >> 4, g = (item >> 1) & 7, dh = item & 1;
    if (tid < 128) {
      const float4* st = (const float4*)(WSB_ml_st + ((long)(chunk * 128 + tid) * 32) * 2);
      float a = 0.f, b = 0.f;
#pragma unroll
      for (int i = 0; i < 16; ++i) { float4 v = st[i]; a += v.x + v.z; b += v.y + v.w; }
      float mu = a * (1.f / 2048.f);
      float var = b * (1.f / 2048.f) - mu * mu;
      s_mu[tid] = mu;
      s_rs[tid] = rsqrtf(fmaxf(var, 0.f) + 1e-6f);
    }
    __syncthreads();
    f32x4 acc[4][4];
#pragma unroll
    for (int m = 0; m < 4; ++m)
#pragma unroll
      for (int n = 0; n < 4; ++n) acc[m][n] = f32x4{0.f, 0.f, 0.f, 0.f};
    const int cb = g * 256 + dh * 128 + wc * 64;
    float lw[4], lb[4];
#pragma unroll
    for (int n = 0; n < 4; ++n) { lw[n] = p.mlp_ln_w[cb + n * 16 + fr]; lb[n] = p.mlp_ln_b[cb + n * 16 + fr]; }
    bf16x4 wa[2][4][2];
    bf16x8 rawb[2][4];
    const u16* wbase = WSB_ws_bf + ((long)g * 128 + wr * 64 + fr) * 128 + fq * 4;
    const u16* vbase = WSB_ml_vT + ((long)(chunk * 4) * 128 + (cb >> 4)) * 512 + lane * 8;
#pragma unroll
    for (int m = 0; m < 4; ++m) { wa[0][m][0] = *(const bf16x4*)(wbase + m * 16 * 128); wa[0][m][1] = *(const bf16x4*)(wbase + m * 16 * 128 + 16); }
#pragma unroll
    for (int n = 0; n < 4; ++n) rawb[0][n] = *(const bf16x8*)(vbase + n * 512);
#pragma unroll
    for (int ks = 0; ks < 4; ++ks) {
      if (ks + 1 < 4) {
#pragma unroll
        for (int m = 0; m < 4; ++m) {
          wa[(ks + 1) & 1][m][0] = *(const bf16x4*)(wbase + m * 16 * 128 + (2 * ks + 2) * 16);
          wa[(ks + 1) & 1][m][1] = *(const bf16x4*)(wbase + m * 16 * 128 + (2 * ks + 3) * 16);
        }
#pragma unroll
        for (int n = 0; n < 4; ++n) rawb[(ks + 1) & 1][n] = *(const bf16x8*)(vbase + (long)(ks + 1) * 128 * 512 + n * 512);
      }
      bf16x8 af[4], bfr[4];
#pragma unroll
      for (int m = 0; m < 4; ++m) af[m] = __builtin_shufflevector(wa[ks & 1][m][0], wa[ks & 1][m][1], 0, 1, 2, 3, 4, 5, 6, 7);
      float mu[8], rs[8];
#pragma unroll
      for (int e = 0; e < 8; ++e) { int jx = (2 * ks + (e >> 2)) * 16 + fq * 4 + (e & 3); mu[e] = s_mu[jx]; rs[e] = s_rs[jx]; }
#pragma unroll
      for (int n = 0; n < 4; ++n) {
        bf16x8 raw = rawb[ks & 1][n];
        float v[8];
#pragma unroll
        for (int e = 0; e < 8; ++e) v[e] = (bf2f((u16)raw[e]) - mu[e]) * rs[e] * lw[n] + lb[n];
        u32x4_t pk;
        pk[0] = pk2(v[0], v[1]); pk[1] = pk2(v[2], v[3]); pk[2] = pk2(v[4], v[5]); pk[3] = pk2(v[6], v[7]);
        bfr[n] = __builtin_bit_cast(bf16x8, pk);
      }
#pragma unroll
      for (int m = 0; m < 4; ++m)
#pragma unroll
        for (int n = 0; n < 4; ++n) acc[m][n] = MFMA16(af[m], bfr[n], acc[m][n]);
    }
    {
      float* wl = (float*)(smem + 4096 + wid * 8704);
#pragma unroll
      for (int a = 0; a < 2; ++a) {
#pragma unroll
        for (int mm = 0; mm < 2; ++mm)
#pragma unroll
          for (int j = 0; j < 4; ++j) {
            float bs = p.mlp_b_s[g * 128 + wr * 64 + (2 * a + mm) * 16 + fq * 4 + j];
#pragma unroll
            for (int n = 0; n < 4; ++n) wl[(mm * 16 + fq * 4 + j) * 68 + n * 16 + fr] = acc[2 * a + mm][n][j] + bs;
          }
        LDSWAIT();
        rows_out_f32(wl, lane, [&](int row, int ch, float4 v) {
          long idx = (long)(chunk * 128 + wr * 64 + a * 32 + row) * 2048 + cb + ch * 4;
          uint2 gu = *(const uint2*)(WSB_ml_gu + idx), sg = *(const uint2*)(WSB_ml_sg + idx);
          store4bf(WSB_ml_o + idx,
                   __uint_as_float(gu.x << 16) * v.x * __uint_as_float(sg.x << 16),
                   __uint_as_float(gu.x & 0xffff0000u) * v.y * __uint_as_float(sg.x & 0xffff0000u),
                   __uint_as_float(gu.y << 16) * v.z * __uint_as_float(sg.y << 16),
                   __uint_as_float(gu.y & 0xffff0000u) * v.w * __uint_as_float(sg.y & 0xffff0000u));
        });
        LDSWAIT();
      }
    }
    __syncthreads();
  }
}


#define XB_TMO      128
#define XB_XCNT(j)  (256  + 64 * (j))
#define XB_XSUB(j)  (1280 + 64 * (j))
#define XB_XGEN(j)  (2304 + 64 * (j))
#define XB_TOP      3328
#define XB_TOPGEN   3392
#define XCD_BAR_WORDS 3456
#define XB_SPIN_CAP (1u << 22)
#define LAS __attribute__((address_space(3)))
__device__ __forceinline__ unsigned xb_ld(unsigned* p)              { return __hip_atomic_load(p, __ATOMIC_RELAXED, __HIP_MEMORY_SCOPE_AGENT); }
__device__ __forceinline__ unsigned xb_add(unsigned* p, unsigned v) { return __hip_atomic_fetch_add(p, v, __ATOMIC_RELAXED, __HIP_MEMORY_SCOPE_AGENT); }
__device__ __forceinline__ unsigned xb_xcc_id() { return (unsigned)__builtin_amdgcn_s_getreg((3 << 11) | 20) & 0xFu; }
#define XB_SPIN(cond, bar) do { unsigned _sp = 0; while (cond) { __builtin_amdgcn_s_sleep(1); \
    if ((++_sp & 255u) == 0u) { if (xb_ld(&(bar)[XB_TMO])) break; if (_sp > XB_SPIN_CAP) { atomicAdd(&(bar)[XB_TMO], 1u); break; } } } } while (0)
struct XcdBarrier { unsigned* bar; unsigned x; volatile LAS unsigned* st; };
__device__ __forceinline__ XcdBarrier xcd_barrier_post(unsigned* bar, volatile LAS unsigned* st) {
  XcdBarrier b; b.bar = bar; b.x = xb_xcc_id(); b.st = st;
  if (threadIdx.x == 0) (void)xb_add(&bar[XB_XCNT(b.x)], 1u);
  return b;
}
__device__ __forceinline__ void xcd_barrier_complete(unsigned* bar, unsigned x, unsigned& nloc, unsigned& nx) {
  const unsigned G = gridDim.x * gridDim.y * gridDim.z;
  unsigned sum, cnt, mine, sp = 0u;
  for (;;) {
    sum = 0u; cnt = 0u; mine = 0u;
#pragma unroll
    for (unsigned j = 0; j < 16; ++j) { const unsigned c = xb_ld(&bar[XB_XCNT(j)]); sum += c; cnt += (c > 0u) ? 1u : 0u; mine = (j == x) ? c : mine; }
    if (sum == G) break;
    __builtin_amdgcn_s_sleep(1);
    if ((++sp & 255u) == 0u) { if (xb_ld(&bar[XB_TMO])) break; if (sp > XB_SPIN_CAP) { atomicAdd(&bar[XB_TMO], 1u); break; } }
  }
  nloc = mine > 0u ? mine : 1u; nx = cnt > 0u ? cnt : 1u;
}
__device__ __forceinline__ void xcd_barrier(const XcdBarrier& b) {
  asm volatile("s_waitcnt vmcnt(0)" ::: "memory");
  __syncthreads();
  if (threadIdx.x == 0) {
    unsigned* bar = b.bar;
    __builtin_amdgcn_s_waitcnt(0);
    unsigned nloc = b.st[0], nx = b.st[1];
    if (nloc == 0u) { xcd_barrier_complete(bar, b.x, nloc, nx); b.st[0] = nloc; b.st[1] = nx; }
    const unsigned old = xb_add(&bar[XB_XSUB(b.x)], 1u);
    const unsigned gen = old / nloc;
    if (old + 1u == (gen + 1u) * nloc) {
      __builtin_amdgcn_fence(__ATOMIC_RELEASE, "agent");
      asm volatile("s_waitcnt vmcnt(0)" ::: "memory");
      const unsigned og = xb_add(&bar[XB_TOP], 1u);
      const unsigned tg = og / nx;
      if (og + 1u == (tg + 1u) * nx) xb_add(&bar[XB_TOPGEN], 1u);
      else XB_SPIN(xb_ld(&bar[XB_TOPGEN]) == tg, bar);
      __builtin_amdgcn_fence(__ATOMIC_ACQUIRE, "agent");
      xb_add(&bar[XB_XGEN(b.x)], 1u);
      asm volatile("s_waitcnt vmcnt(0)" ::: "memory");
    } else {
      XB_SPIN(xb_ld(&bar[XB_XGEN(b.x)]) == gen, bar);
      __builtin_amdgcn_fence(__ATOMIC_ACQUIRE, "agent");
      asm volatile("s_waitcnt vmcnt(0)" ::: "memory");
    }
  }
  __syncthreads();
}

__device__ __forceinline__ bool gemm_tile_map(int it, int ntm, int ntn, int& tm, int& tn) {
  if (gridDim.x == 512 && ntn == 8) {
    int x = blockIdx.x & 7, slot = blockIdx.x >> 3;
    int L = it * 64 + slot;
    if (L >= 96) return false;
    tm = x + 8 * (L >> 3); tn = L & 7;
    return true;
  }
  if (gridDim.x == 99999) {
    int x = blockIdx.x & 7, slot = blockIdx.x >> 3;
    int nsn = ntn >> 3, nst = (ntm >> 3) * nsn;
    int sg = it * 8 + x;
    if (sg >= nst) return false;
    int sn = sg % nsn, sm = sg / nsn;
    tm = sm * 8 + (slot >> 3); tn = sn * 8 + (slot & 7);
    return true;
  }
  int t = blockIdx.x + it * gridDim.x;
  if (t >= ntm * ntn) return false;
  tn = t % ntn; tm = t / ntn;
  return true;
}

__device__ __forceinline__ void run_phase(const Params& p, int ph, char* smem) {
  if (ph == 0) { prep_phase(p, smem); return; }
  const int layer = (ph - 1) >> 2, sub = (ph - 1) & 3;
  const int kind = layer % 3, lj = layer / 3;
  const float* xp = layer == 0 ? p.x_prompt : WSB_X;
  const float* xs = layer == 0 ? p.x_sample : WSB_X + (long)TP * 1024;
  float* xout = layer == 3 ? WSB_y_out : WSB_X;
  if (sub == 0) { norm_phase(p, layer, xp, xs); return; }
  if (sub == 1) {
    if (kind == 0) {
      const u16* W = WSB_wt_na_in + (long)lj * 4096 * 1024;
      const int wcw = (tidx() >> 6) & 1;
      for (int t = blockIdx.x; t < 96 * 16; t += gridDim.x) {
        int tn = t & 15, tm = t >> 4;
        if (gridDim.x == 512) {
          int L = (t >> 9) * 64 + (blockIdx.x >> 3);
          tm = (blockIdx.x & 7) + 8 * (L >> 4); tn = L & 15;
        }
        f32x4 acc[4][8];
        gemm_core_w(WSB_h + (long)tm * 128 * 1024, 1024, W + (long)tn * 256 * 1024, 1024, 1024, smem, acc);
        epi_na_in<0>(p, lj, tm, 2 * tn + wcw, 0, acc, smem);
        epi_na_in<4>(p, lj, tm, 2 * tn + wcw, 1, acc, smem);
        __syncthreads();
      }
    } else {
      const u16* W = kind == 1 ? WSB_wt_ret_in : WSB_wt_mlp_in;
      const int wcw = (tidx() >> 6) & 1;
      if (kind == 1) {
        for (int t = blockIdx.x; t < 96 * 16; t += gridDim.x) {
          int tn = t & 15, tm = t >> 4;
          if (gridDim.x == 512) { int L = (t >> 9) * 64 + (blockIdx.x >> 3); tm = (blockIdx.x & 7) + 8 * (L >> 4); tn = L & 15; }
          f32x4 acc[4][4];
          gemm_core(WSB_h + (long)tm * 128 * 1024, 1024, W + (long)tn * 128 * 1024, 1024, 1024, smem, acc);
          epi_ret_in<0>(p, tm, tn, wcw, acc, smem);
          __syncthreads();
        }
        for (int t = blockIdx.x; t < 96 * 16; t += gridDim.x) {
          int tw = t & 15, tm = t >> 4;
          if (gridDim.x == 512) { int L = (t >> 9) * 64 + (blockIdx.x >> 3); tm = (blockIdx.x & 7) + 8 * (L >> 4); tw = L & 15; }
          f32x4 acc[4][8];
          gemm_core_w(WSB_h + (long)tm * 128 * 1024, 1024, W + (long)(2048 + tw * 256) * 1024, 1024, 1024, smem, acc);
          epi_ret_vg<0>(p, tm, 16 + 2 * tw + wcw, 0, acc, smem);
          epi_ret_vg<4>(p, tm, 16 + 2 * tw + wcw, 1, acc, smem);
          __syncthreads();
        }
      } else
      for (int t = blockIdx.x; t < 96 * 24; t += gridDim.x) {
        int tn = t % 24, tm = t / 24;
        f32x4 acc[4][8];
        gemm_core_w(WSB_h + (long)tm * 128 * 1024, 1024, W + (long)tn * 256 * 1024, 1024, 1024, smem, acc);
        epi_mlp_in<0>(p, tm, 2 * tn + wcw, 0, acc, smem);
        epi_mlp_in<4>(p, tm, 2 * tn + wcw, 1, acc, smem);
        __syncthreads();
      }
    }
    return;
  }
  if (sub == 2) {
    if (kind == 0) na_attn_phase(p, lj, smem);
    else if (kind == 1) ret_phase(p, smem);
    else mlp_spatial_phase(p, smem);
    return;
  }
  {
    const u16* A; const u16* W; int K;
    if (kind == 0) { A = WSB_na_o; W = WSB_wt_na_out + (long)lj * 1024 * 1024; K = 1024; }
    else if (kind == 1) { A = WSB_rt_y; W = WSB_wt_ret_out; K = 2048; }
    else { A = WSB_ml_o; W = WSB_wt_mlp_out; K = 2048; }
    const int wcw = (tidx() >> 6) & 1;
    if (gridDim.x == 512) {
      const int x = blockIdx.x & 7, slot = blockIdx.x >> 3;
      if (slot < 32) {
        int tm = x + 8 * (slot >> 2), tn = slot & 3;
        f32x4 acc[4][8];
        gemm_core_w(A + (long)tm * 128 * K, K, W + (long)tn * 256 * K, K, K, smem, acc);
        epi_resid<0>(p, layer, xp, xs, xout, tm, 2 * tn + wcw, 0, acc, smem);
        epi_resid<4>(p, layer, xp, xs, xout, tm, 2 * tn + wcw, 1, acc, smem);
      } else {
        int L = slot - 32;
        int tm = 64 + x + 8 * (L >> 3), tn = L & 7;
        f32x4 acc[4][4];
        gemm_core(A + (long)tm * 128 * K, K, W + (long)tn * 128 * K, K, K, smem, acc);
        epi_resid<0>(p, layer, xp, xs, xout, tm, tn, wcw, acc, smem);
      }
      __syncthreads();
    } else {
      int tm, tn;
      for (int it = 0; gemm_tile_map(it, 96, 8, tm, tn); ++it) {
        f32x4 acc[4][4];
        gemm_core(A + (long)tm * 128 * K, K, W + (long)tn * 128 * K, K, K, smem, acc);
        epi_resid<0>(p, layer, xp, xs, xout, tm, tn, wcw, acc, smem);
        __syncthreads();
      }
    }
  }
}

#define NPHASE 17
#ifndef PROBE_MASK
#define PROBE_MASK 0
#endif

__global__ void __launch_bounds__(256, 2) mega_kernel(Params p) {
  __shared__ __attribute__((aligned(16))) char smem[65536];
  __shared__ uint4 xb_words;
  cg::grid_group grid = cg::this_grid();
  if (threadIdx.x == 0) xb_words = make_uint4(0u, 0u, 0u, 0u);
  __syncthreads();
  XcdBarrier xb = xcd_barrier_post(WSB_bar, (volatile LAS unsigned*)&xb_words);
  {
    int never = 0;
    asm volatile("" : "+s"(never));
    if (never) grid.sync();
  }
#pragma nounroll
  for (int ph = 0; ph < NPHASE; ++ph) {
    int phv = ph;
    asm volatile("" : "+s"(phv));
    run_phase(p, phv, smem);
#if PROBE_MASK
    {
      int sub = (ph - 1) & 3, kind = ((ph - 1) >> 2) % 3;
      int cls = ph == 0 ? 1 : (sub == 0 ? 2 : (sub == 1 ? 4 : (sub == 2 ? (8 << kind) : 64)));
      if (cls & PROBE_MASK) { xcd_barrier(xb); run_phase(p, phv, smem); }
    }
#endif
    if (ph + 1 < NPHASE) xcd_barrier(xb);
  }
}

#ifndef MULTI_LAUNCH
#define MULTI_LAUNCH 0
#endif

extern "C" void kernel_launch(void* const* d_in, const int* in_sizes, int n_in, void* d_out, int out_size, void* d_ws,
                              size_t ws_size, hipStream_t stream) {
  Params p{};
  p.x_prompt = (const float*)d_in[0];  p.x_sample = (const float*)d_in[1];
  p.cache_k = (const float*)d_in[2];   p.cache_v = (const float*)d_in[3];
  p.state_ret = (const float*)d_in[4]; p.c = (const float*)d_in[5];
  p.c_ctx = (const float*)d_in[6];     p.norm_w = (const float*)d_in[7];
  p.w_ada = (const float*)d_in[8];     p.b_ada = (const float*)d_in[9];
  p.na_w_in = (const float*)d_in[10];  p.na_w_out = (const float*)d_in[11];
  p.na_q_gain = (const float*)d_in[12]; p.na_k_gain = (const float*)d_in[13];
  p.na_rpb = (const float*)d_in[14];
  p.ret_w_in = (const float*)d_in[15]; p.ret_w_out = (const float*)d_in[16];
  p.ret_decay = (const float*)d_in[17]; p.ret_gn_w = (const float*)d_in[18];
  p.mlp_w_in = (const float*)d_in[19]; p.mlp_ln_w = (const float*)d_in[20];
  p.mlp_ln_b = (const float*)d_in[21]; p.mlp_w_s = (const float*)d_in[22];
  p.mlp_b_s = (const float*)d_in[23];  p.mlp_w_out = (const float*)d_in[24];
  p.out = (float*)d_out;
  p.ws = (char*)d_ws;

  static int grid_blocks = 0;
  if (!grid_blocks) {
    int dev = 0, cus = 0, per_cu = 0;
    (void)hipGetDevice(&dev);
    (void)hipDeviceGetAttribute(&cus, hipDeviceAttributeMultiprocessorCount, dev);
    (void)hipOccupancyMaxActiveBlocksPerMultiprocessor(&per_cu, mega_kernel, 256, 0);
    if (per_cu > 2) per_cu = 2;
    if (per_cu < 1) per_cu = 1;
    grid_blocks = cus * per_cu;
  }
  (void)hipMemsetAsync(p.ws + 71844096ULL, 0, (size_t)XCD_BAR_WORDS * 4, stream);
  void* args[] = {&p};
  hipError_t e = hipLaunchCooperativeKernel((void*)mega_kernel, dim3(grid_blocks), dim3(256), args, 0, stream);
  if (e != hipSuccess) fprintf(stderr, "cooperative launch failed: %s (grid %d)\n", hipGetErrorString(e), grid_blocks);
}
```

```cpp
#include <hip/hip_runtime.h>
#include <hip/hip_cooperative_groups.h>
#include <cstdio>
namespace cg = cooperative_groups;

typedef unsigned short u16;
using bf16x8 = __attribute__((ext_vector_type(8))) short;
using bf16x4 = __attribute__((ext_vector_type(4))) short;
using f32x4  = __attribute__((ext_vector_type(4))) float;

#define TP 8192
#define TS 4096
#define TT 12288

struct Params {
  const float *x_prompt, *x_sample, *cache_k, *cache_v, *state_ret, *c, *c_ctx, *norm_w, *w_ada, *b_ada;
  const float *na_w_in, *na_w_out, *na_q_gain, *na_k_gain, *na_rpb;
  const float *ret_w_in, *ret_w_out, *ret_decay, *ret_gn_w;
  const float *mlp_w_in, *mlp_ln_w, *mlp_ln_b, *mlp_w_s, *mlp_b_s, *mlp_w_out;
  float* out;
  char* ws;
};
#define WSB_wt_na_in ((u16*)(p.ws + 0ULL))
#define WSB_wt_na_out ((u16*)(p.ws + 16777216ULL))
#define WSB_wt_ret_in ((u16*)(p.ws + 20971520ULL))
#define WSB_wt_ret_out ((u16*)(p.ws + 33554432ULL))
#define WSB_wt_mlp_in ((u16*)(p.ws + 37748736ULL))
#define WSB_wt_mlp_out ((u16*)(p.ws + 50331648ULL))
#define WSB_ws_bf ((u16*)(p.ws + 54525952ULL))
#define WSB_ck_bf ((u16*)(p.ws + 54788096ULL))
#define WSB_cvt_bf ((u16*)(p.ws + 58982400ULL))
#define WSB_s0t ((u16*)(p.ws + 63176704ULL))
#define WSB_mod ((float*)(p.ws + 71565312ULL))
#define WSB_ropetab ((float*)(p.ws + 71811072ULL))
#define WSB_dec ((float*)(p.ws + 71843840ULL))
#define WSB_bar ((unsigned*)(p.ws + 71844096ULL))
#define WSB_X ((float*)(p.ws + 71857920ULL))
#define WSB_h ((u16*)(p.ws + 122189568ULL))
#define WSB_na_q ((u16*)(p.ws + 147355392ULL))
#define WSB_na_k ((u16*)(p.ws + 172521216ULL))
#define WSB_na_vT ((u16*)(p.ws + 197687040ULL))
#define WSB_na_sg ((u16*)(p.ws + 222852864ULL))
#define WSB_na_o ((u16*)(p.ws + 248018688ULL))
#define WSB_rt_q ((u16*)(p.ws + 147355392ULL))
#define WSB_rt_k ((u16*)(p.ws + 172521216ULL))
#define WSB_rt_qs ((u16*)(p.ws + 197687040ULL))
#define WSB_rt_kT ((u16*)(p.ws + 214464256ULL))
#define WSB_rt_vF ((u16*)(p.ws + 248018688ULL))
#define WSB_rt_sg ((u16*)(p.ws + 298350336ULL))
#define WSB_rt_y ((u16*)(p.ws + 348681984ULL))
#define WSB_ml_gu ((u16*)(p.ws + 147355392ULL))
#define WSB_ml_vT ((u16*)(p.ws + 197687040ULL))
#define WSB_ml_sg ((u16*)(p.ws + 248018688ULL))
#define WSB_ml_o ((u16*)(p.ws + 298350336ULL))
#define WSB_ml_st ((float*)(p.ws + 348681984ULL))
#define WSB_y_out (p.out + 0ULL)
#define WSB_new_k (p.out + 12582912ULL)
#define WSB_new_v (p.out + 29360128ULL)
#define WSB_new_ret (p.out + 46137344ULL)


typedef unsigned u32x4_t __attribute__((ext_vector_type(4)));
typedef __bf16 bf16v2_t __attribute__((ext_vector_type(2)));
typedef float f32v2_t __attribute__((ext_vector_type(2)));
__device__ __forceinline__ unsigned pk2(float a, float b) {
  f32v2_t v = {a, b};
  bf16v2_t r = __builtin_convertvector(v, bf16v2_t);
  return __builtin_bit_cast(unsigned, r);
}
__device__ __forceinline__ u16 f2bf(float f) { return (u16)(pk2(f, f) & 0xffffu); }
__device__ __forceinline__ float bf2f(u16 h) { return __uint_as_float(((unsigned)h) << 16); }
__device__ __forceinline__ bf16x8 pack8(f32x4 a, f32x4 b) {
  u32x4_t r;
  r[0] = pk2(a[0], a[1]); r[1] = pk2(a[2], a[3]); r[2] = pk2(b[0], b[1]); r[3] = pk2(b[2], b[3]);
  return __builtin_bit_cast(bf16x8, r);
}
__device__ __forceinline__ void store4bf(u16* dst, float a, float b, float c, float d) {
  uint2 v; v.x = pk2(a, b); v.y = pk2(c, d);
  *(uint2*)dst = v;
}
__device__ __forceinline__ float silu_f(float x) { return x * __builtin_amdgcn_rcpf(1.f + __expf(-x)); }
__device__ __forceinline__ float gelu_f(float x) {
  float z = 0.7978845608028654f * (x + 0.044715f * x * x * x);
  float t = 1.f - 2.f * __builtin_amdgcn_rcpf(__expf(2.f * z) + 1.f);
  return 0.5f * x * (1.f + t);
}
__device__ __forceinline__ void st2bf(u16* base, int i0, int i1, float a, float b) {
  unsigned v = pk2(a, b);
  base[i0] = (u16)(v & 0xffffu);
  base[i1] = (u16)(v >> 16);
}
__device__ __forceinline__ int tidx() { int t = threadIdx.x; asm volatile("" : "+v"(t)); return t; }
#define MFMA16(a, b, c) __builtin_amdgcn_mfma_f32_16x16x32_bf16((a), (b), (c), 0, 0, 0)

__device__ __forceinline__ void gemm_core(const u16* __restrict__ A, long lda, const u16* __restrict__ B, long ldb,
                                          int K, char* smem, f32x4 (&acc)[4][4]) {
  const int tid = tidx(), lane = tid & 63, wid = tid >> 6, wr = wid >> 1, wc = wid & 1, fr = lane & 15, fq = lane >> 4;
#pragma unroll
  for (int m = 0; m < 4; ++m)
#pragma unroll
    for (int n = 0; n < 4; ++n) acc[m][n] = f32x4{0.f, 0.f, 0.f, 0.f};
  const int nk = K >> 6;
  const int r0 = tid >> 3, c0 = (tid & 7) ^ ((r0 >> 1) & 7);
  const u16* ap = A + (long)r0 * lda + c0 * 8;
  const u16* bp = B + (long)r0 * ldb + c0 * 8;
  const long sa32 = 32 * lda, sb32 = 32 * ldb;
  uint4 ga0, ga1, ga2, ga3, gb0, gb1, gb2, gb3, ha0, ha1, ha2, ha3, hb0, hb1, hb2, hb3;
  char* lw = smem + tid * 16;
#define GLOAD(P, kt) { P##a0 = *(const uint4*)(ap + (kt) * 64); P##a1 = *(const uint4*)(ap + sa32 + (kt) * 64); \
    P##a2 = *(const uint4*)(ap + 2 * sa32 + (kt) * 64); P##a3 = *(const uint4*)(ap + 3 * sa32 + (kt) * 64); \
    P##b0 = *(const uint4*)(bp + (kt) * 64); P##b1 = *(const uint4*)(bp + sb32 + (kt) * 64); \
    P##b2 = *(const uint4*)(bp + 2 * sb32 + (kt) * 64); P##b3 = *(const uint4*)(bp + 3 * sb32 + (kt) * 64); }
#define LWRITE(P, b) { char* l_ = lw + (b) * 32768; \
    *(uint4*)(l_) = P##a0; *(uint4*)(l_ + 4096) = P##a1; *(uint4*)(l_ + 8192) = P##a2; *(uint4*)(l_ + 12288) = P##a3; \
    *(uint4*)(l_ + 16384) = P##b0; *(uint4*)(l_ + 20480) = P##b1; *(uint4*)(l_ + 24576) = P##b2; *(uint4*)(l_ + 28672) = P##b3; }
  auto compute = [&](int b) {
    const char* sa = smem + b * 32768;
    const char* sb = sa + 16384;
#pragma unroll
    for (int ks = 0; ks < 2; ++ks) {
      bf16x8 af[4], bfr[4];
#pragma unroll
      for (int m = 0; m < 4; ++m) {
        int r = wr * 64 + m * 16 + fr;
        af[m] = *(const bf16x8*)(sa + (r * 8 + ((ks * 4 + fq) ^ ((r >> 1) & 7))) * 16);
      }
#pragma unroll
      for (int n = 0; n < 4; ++n) {
        int r = wc * 64 + n * 16 + fr;
        bfr[n] = *(const bf16x8*)(sb + (r * 8 + ((ks * 4 + fq) ^ ((r >> 1) & 7))) * 16);
      }
#pragma unroll
      for (int m = 0; m < 4; ++m)
#pragma unroll
        for (int n = 0; n < 4; ++n) acc[m][n] = MFMA16(af[m], bfr[n], acc[m][n]);
    }
  };
  GLOAD(g, 0);
  GLOAD(h, 1);
  LWRITE(g, 0);
  __syncthreads();
  for (int t = 0; t < nk; t += 2) {
    if (t + 2 < nk) GLOAD(g, t + 2);
    __builtin_amdgcn_sched_barrier(0);
    compute(0);
    __builtin_amdgcn_sched_barrier(0);
    LWRITE(h, 1);
    __syncthreads();
    if (t + 3 < nk) GLOAD(h, t + 3);
    __builtin_amdgcn_sched_barrier(0);
    compute(1);
    __builtin_amdgcn_sched_barrier(0);
    if (t + 2 < nk) LWRITE(g, 0);
    __syncthreads();
  }
#undef GLOAD
#undef LWRITE
}


__device__ __forceinline__ int swz4(int r) { return (4 - ((r >> 2) & 3)) & 3; }
__device__ __forceinline__ void gemm_core_w(const u16* __restrict__ A, long lda, const u16* __restrict__ B, long ldb,
                                            int K, char* smem, f32x4 (&acc)[4][8]) {
  const int tid = tidx(), lane = tid & 63, wid = tid >> 6, wr = wid >> 1, wc = wid & 1, fr = lane & 15, fq = lane >> 4;
#pragma unroll
  for (int m = 0; m < 4; ++m)
#pragma unroll
    for (int n = 0; n < 8; ++n) acc[m][n] = f32x4{0.f, 0.f, 0.f, 0.f};
  const int nk = K >> 5;
  const int r0 = tid >> 2, c0 = (tid & 3) ^ swz4(r0);
  const u16* ap = A + (long)r0 * lda + c0 * 8;
  const u16* bp = B + (long)r0 * ldb + c0 * 8;
  const long sa64 = 64 * lda, sb64 = 64 * ldb;
  uint4 ga0, ga1, gb0, gb1, gb2, gb3, ha0, ha1, hb0, hb1, hb2, hb3;
  char* lw = smem + tid * 16;
#define GLOADW(P, kt) { P##a0 = *(const uint4*)(ap + (kt) * 32); P##a1 = *(const uint4*)(ap + sa64 + (kt) * 32); \
    P##b0 = *(const uint4*)(bp + (kt) * 32); P##b1 = *(const uint4*)(bp + sb64 + (kt) * 32); \
    P##b2 = *(const uint4*)(bp + 2 * sb64 + (kt) * 32); P##b3 = *(const uint4*)(bp + 3 * sb64 + (kt) * 32); }
#define LWRITEW(P, b) { char* l_ = lw + (b) * 24576; \
    *(uint4*)(l_) = P##a0; *(uint4*)(l_ + 4096) = P##a1; \
    *(uint4*)(l_ + 8192) = P##b0; *(uint4*)(l_ + 12288) = P##b1; *(uint4*)(l_ + 16384) = P##b2; *(uint4*)(l_ + 20480) = P##b3; }
  auto compute = [&](int b) {
    const char* sa = smem + b * 24576;
    const char* sb = sa + 8192;
    bf16x8 af[4];
#pragma unroll
    for (int m = 0; m < 4; ++m) {
      int r = wr * 64 + m * 16 + fr;
      af[m] = *(const bf16x8*)(sa + (r * 4 + (fq ^ swz4(r))) * 16);
    }
#pragma unroll
    for (int nh = 0; nh < 2; ++nh) {
      bf16x8 bfr[4];
#pragma unroll
      for (int n = 0; n < 4; ++n) {
        int r = wc * 128 + (nh * 4 + n) * 16 + fr;
        bfr[n] = *(const bf16x8*)(sb + (r * 4 + (fq ^ swz4(r))) * 16);
      }
#pragma unroll
      for (int m = 0; m < 4; ++m)
#pragma unroll
        for (int n = 0; n < 4; ++n) acc[m][nh * 4 + n] = MFMA16(af[m], bfr[n], acc[m][nh * 4 + n]);
    }
  };
  GLOADW(g, 0);
  GLOADW(h, 1);
  LWRITEW(g, 0);
  __syncthreads();
  for (int t = 0; t < nk; t += 2) {
    if (t + 2 < nk) GLOADW(g, t + 2);
    __builtin_amdgcn_sched_barrier(0);
    compute(0);
    __builtin_amdgcn_sched_barrier(0);
    LWRITEW(h, 1);
    __syncthreads();
    if (t + 3 < nk) GLOADW(h, t + 3);
    __builtin_amdgcn_sched_barrier(0);
    compute(1);
    __builtin_amdgcn_sched_barrier(0);
    if (t + 2 < nk) LWRITEW(g, 0);
    __syncthreads();
  }
#undef GLOADW
#undef LWRITEW
}

__device__ __forceinline__ void adaln_item(const Params& p, int it, char* smem) {
  const int tid = tidx();
  int layer = it / 192, n0 = (it % 192) * 16;
  float* s_c = (float*)smem;
  float* s_p = s_c + 5120;
  for (int idx = tid; idx < 5120; idx += 256) {
    int v = idx >> 10, kk = idx & 1023;
    float cv = (v == 0) ? p.c_ctx[kk] : p.c[(v - 1) * 1024 + kk];
    s_c[idx] = silu_f(cv);
  }
  __syncthreads();
  int cl = tid & 3, ksl = tid >> 2;
  const float* w = p.w_ada + (long)layer * 1024 * 3072 + n0 + cl * 4;
  float4 a0 = {0, 0, 0, 0}, a1 = a0, a2 = a0, a3 = a0, a4 = a0;
#pragma unroll
  for (int kk = 0; kk < 16; ++kk) {
    int k = ksl * 16 + kk;
    float4 w4 = *(const float4*)(w + (long)k * 3072);
    float c0 = s_c[k], c1 = s_c[1024 + k], c2 = s_c[2048 + k], c3 = s_c[3072 + k], c4 = s_c[4096 + k];
    a0.x += c0 * w4.x; a0.y += c0 * w4.y; a0.z += c0 * w4.z; a0.w += c0 * w4.w;
    a1.x += c1 * w4.x; a1.y += c1 * w4.y; a1.z += c1 * w4.z; a1.w += c1 * w4.w;
    a2.x += c2 * w4.x; a2.y += c2 * w4.y; a2.z += c2 * w4.z; a2.w += c2 * w4.w;
    a3.x += c3 * w4.x; a3.y += c3 * w4.y; a3.z += c3 * w4.z; a3.w += c3 * w4.w;
    a4.x += c4 * w4.x; a4.y += c4 * w4.y; a4.z += c4 * w4.z; a4.w += c4 * w4.w;
  }
  *(float4*)(s_p + (ksl * 5 + 0) * 16 + cl * 4) = a0;
  *(float4*)(s_p + (ksl * 5 + 1) * 16 + cl * 4) = a1;
  *(float4*)(s_p + (ksl * 5 + 2) * 16 + cl * 4) = a2;
  *(float4*)(s_p + (ksl * 5 + 3) * 16 + cl * 4) = a3;
  *(float4*)(s_p + (ksl * 5 + 4) * 16 + cl * 4) = a4;
  __syncthreads();
  if (tid < 80) {
    int v = tid >> 4, col = tid & 15;
    float s = p.b_ada[layer * 3072 + n0 + col];
#pragma unroll 8
    for (int k2 = 0; k2 < 64; ++k2) s += s_p[(k2 * 5 + v) * 16 + col];
    WSB_mod[(layer * 5 + v) * 3072 + n0 + col] = s;
  }
  __syncthreads();
}

__device__ __forceinline__ void tr_tile(const float* __restrict__ src, long ld_src, u16* __restrict__ dst, long ld_dst,
                        int r0, int c0, int perm, char* smem) {
  float* tile = (float*)smem;
  const int tid = tidx();
  {
    int c4 = (tid & 15) * 4;
    int pcol = c0 + c4;
    int scol = pcol;
    if (perm) {
      int blk = pcol & ~127, w = pcol & 127;
      int r = w & 63;
      scol = blk + (r >> 5) * 64 + (w >> 6) * 32 + (r & 31);
    }
#pragma unroll
    for (int i = 0; i < 4; ++i) {
      int rr = (tid >> 4) + i * 16;
      f32x4 vt = __builtin_nontemporal_load((const f32x4*)(src + (long)(r0 + rr) * ld_src + scol));
      float4 v; v.x = vt[0]; v.y = vt[1]; v.z = vt[2]; v.w = vt[3];
      float* t = tile + rr * 65 + c4;
      t[0] = v.x; t[1] = v.y; t[2] = v.z; t[3] = v.w;
    }
  }
  __syncthreads();
  {
    int kc = (tid & 7) * 8;
#pragma unroll
    for (int i = 0; i < 2; ++i) {
      int pp = (tid >> 3) + i * 32;
      const float* t = tile + kc * 65 + pp;
      uint4 o;
      o.x = pk2(t[0], t[65]); o.y = pk2(t[130], t[195]); o.z = pk2(t[260], t[325]); o.w = pk2(t[390], t[455]);
      *(uint4*)(dst + (long)(c0 + pp) * ld_dst + r0 + kc) = o;
    }
  }
  __syncthreads();
}

__device__ __forceinline__ void tr_item(const Params& p, int x, char* smem) {
  if (x < 2048) {
    int bt = x >> 10, tt = x & 1023, rt = tt & 15, ct = tt >> 4;
    tr_tile(p.na_w_in + (long)bt * 1024 * 4096, 4096, WSB_wt_na_in + (long)bt * 4096 * 1024, 1024, rt * 64, ct * 64, 0, smem);
    return;
  }
  x -= 2048;
  if (x < 512) {
    int bt = x >> 8, tt = x & 255, rt = tt & 15, ct = tt >> 4;
    tr_tile(p.na_w_out + (long)bt * 1024 * 1024, 1024, WSB_wt_na_out + (long)bt * 1024 * 1024, 1024, rt * 64, ct * 64, 0, smem);
    return;
  }
  x -= 512;
  if (x < 1536) {
    int rt = x & 15, ct = x >> 4;
    tr_tile(p.ret_w_in, 6144, WSB_wt_ret_in, 1024, rt * 64, ct * 64, ct < 32 ? 1 : 0, smem);
    return;
  }
  x -= 1536;
  if (x < 512) {
    int rt = x & 31, ct = x >> 5;
    tr_tile(p.ret_w_out, 1024, WSB_wt_ret_out, 2048, rt * 64, ct * 64, 0, smem);
    return;
  }
  x -= 512;
  if (x < 1536) {
    int rt = x & 15, ct = x >> 4;
    tr_tile(p.mlp_w_in, 6144, WSB_wt_mlp_in, 1024, rt * 64, ct * 64, 0, smem);
    return;
  }
  x -= 1536;
  if (x < 512) {
    int rt = x & 31, ct = x >> 5;
    tr_tile(p.mlp_w_out, 1024, WSB_wt_mlp_out, 2048, rt * 64, ct * 64, 0, smem);
    return;
  }
  x -= 512;
  (void)x;
}

__device__ __forceinline__ void cv_item(const Params& p, int it) {
  const int tid = tidx();
  if (it < 128) {
    long base = (long)it * 1024 + tid * 4;
    float4 v = *(const float4*)(p.mlp_w_s + base);
    store4bf(WSB_ws_bf + base, v.x, v.y, v.z, v.w);
    return;
  }
  it -= 128;
  if (it < 1024) {
    int g = it * 256 + tid;
    int seq = g >> 11, r = g & 2047, lane = r & 63, f = r >> 6;
    int ks = f & 1, n = (f >> 1) & 3, kt = f >> 3, fr = lane & 15, fq = lane >> 4;
    int blj = seq >> 4, hh = seq & 15;
    int s = kt * 64 + n * 16 + fr, d0 = ks * 32 + fq * 8;
    const float* sp = p.cache_k + ((long)(blj * 256 + s) * 16 + hh) * 64 + d0;
    float4 a = *(const float4*)sp, b = *(const float4*)(sp + 4);
    uint4 o; o.x = pk2(a.x, a.y); o.y = pk2(a.z, a.w); o.z = pk2(b.x, b.y); o.w = pk2(b.z, b.w);
    *(uint4*)(WSB_ck_bf + (long)g * 8) = o;
    return;
  }
  it -= 1024;
  if (it < 1024) {
    int g = it * 256 + tid;
    int seq = g >> 11, r = g & 2047, lane = r & 63, f = r >> 6;
    int dt = f & 3, ks2 = (f >> 2) & 1, kt = f >> 3, fr = lane & 15, fq = lane >> 4;
    int blj = seq >> 4, hh = seq & 15;
    int dv = dt * 16 + fr, kA = kt * 64 + (2 * ks2) * 16 + fq * 4;
    const float* sp = p.cache_v + ((long)(blj * 256 + kA) * 16 + hh) * 64 + dv;
    uint4 o;
    o.x = pk2(sp[0], sp[1024]); o.y = pk2(sp[2048], sp[3072]);
    o.z = pk2(sp[16 * 1024], sp[17 * 1024]); o.w = pk2(sp[18 * 1024], sp[19 * 1024]);
    *(uint4*)(WSB_cvt_bf + (long)g * 8) = o;
    return;
  }
  it -= 1024;
  {
    int g = it * 256 + tid;
    int bh = g >> 15, r = g & 32767, lane = r & 63, f = r >> 6;
    int dtg = f & 31, ks = f >> 5, fr = lane & 15, fq = lane >> 4;
    int dv = dtg * 16 + fr, k0 = ks * 32 + fq * 8, dir = k0 >> 8, dk0 = k0 & 255;
    int b = bh >> 2, hh = bh & 3;
    const float* sp = p.state_ret + ((long)((b * 2 + dir) * 4 + hh) * 256 + dk0) * 512 + dv;
    uint4 o;
    o.x = pk2(sp[0], sp[512]); o.y = pk2(sp[1024], sp[1536]);
    o.z = pk2(sp[2048], sp[2560]); o.w = pk2(sp[3072], sp[3584]);
    *(uint4*)(WSB_s0t + (long)g * 8) = o;
  }
}

__device__ __forceinline__ void misc_item(const Params& p) {
  const int tid = tidx();
  for (int idx = tid; idx < 4096; idx += 256) {
    int pos = idx >> 6, i = idx & 63;
    float inv = __builtin_amdgcn_exp2f(-(float)i * (13.287712379549449f / 64.f));
    float ang = (float)pos * inv;
    WSB_ropetab[2 * idx] = __cosf(ang);
    WSB_ropetab[2 * idx + 1] = __sinf(ang);
  }
  if (tid < 8) {
    float x = p.ret_decay[tid];
    float y = __expf(-x);
    float lg1p = y * (1.f - y * (0.5f - y * (0.33333334f - y * (0.25f - y * (0.2f - y * 0.16666667f)))));
    if (y > 0.25f) lg1p = __logf(1.f + y);
    WSB_dec[tid] = -lg1p * 1.4426950408889634f;
  }
}

__device__ __forceinline__ void prep_phase(const Params& p, char* smem) {
  const int NADA = 768, NTR = 6656, NCV = 128 + 1024 + 1024 + 2048;
  for (int it = blockIdx.x; it < NADA + NTR + NCV + 1; it += gridDim.x) {
    if (it < NADA) adaln_item(p, it, smem);
    else if (it < NADA + NTR) tr_item(p, it - NADA, smem);
    else if (it < NADA + NTR + NCV) cv_item(p, it - NADA - NTR);
    else misc_item(p);
  }
}

__device__ __forceinline__ void norm_phase(const Params& p, int layer, const float* xp, const float* xs) {
  const int wave = tidx() >> 6, lane = tidx() & 63;
  const float* nw = p.norm_w + layer * 1024;
  for (int row = blockIdx.x * 4 + wave; row < TT; row += gridDim.x * 4) {
    const float* x = row < TP ? xp + (long)row * 1024 : xs + (long)(row - TP) * 1024;
    int mv = row < TP ? 0 : 1 + ((row - TP) >> 10);
    const float* md = WSB_mod + (long)(layer * 5 + mv) * 3072;
    float4 v[4];
    float ss = 0.f;
#pragma unroll
    for (int i = 0; i < 4; ++i) {
      v[i] = *(const float4*)(x + i * 256 + lane * 4);
      ss += v[i].x * v[i].x + v[i].y * v[i].y + v[i].z * v[i].z + v[i].w * v[i].w;
    }
#pragma unroll
    for (int o = 32; o > 0; o >>= 1) ss += __shfl_xor(ss, o);
    float r = rsqrtf(ss * (1.f / 1024.f) + 1e-6f);
#pragma unroll
    for (int i = 0; i < 4; ++i) {
      int c = i * 256 + lane * 4;
      float4 w4 = *(const float4*)(nw + c);
      float4 sh = *(const float4*)(md + c);
      float4 sc = *(const float4*)(md + 1024 + c);
      float o0 = (v[i].x * r * w4.x) * (1.f + sc.x) + sh.x;
      float o1 = (v[i].y * r * w4.y) * (1.f + sc.y) + sh.y;
      float o2 = (v[i].z * r * w4.z) * (1.f + sc.z) + sh.z;
      float o3 = (v[i].w * r * w4.w) * (1.f + sc.w) + sh.w;
      store4bf(WSB_h + (long)row * 1024 + c, o0, o1, o2, o3);
    }
  }
}

__device__ __forceinline__ void nt_store4(float* ptr, float4 v) { f32x4 t = {v.x, v.y, v.z, v.w}; __builtin_nontemporal_store(t, (f32x4*)ptr); }
#define LDSWAIT() asm volatile("s_waitcnt lgkmcnt(0)" ::: "memory")

__device__ __forceinline__ void rows_out_bf16(const char* wl, int lane, u16* dst, long ld) {
#pragma unroll
  for (int i = 0; i < 8; ++i) {
    int row = (lane >> 3) + 8 * i, ch = lane & 7;
    uint4 v = *(const uint4*)(wl + row * 144 + ch * 16);
    *(uint4*)(dst + (long)row * ld + ch * 8) = v;
  }
}
__device__ __forceinline__ void rows_out_bf16_split(const char* wl, int lane, u16* dst, long ld, int gap) {
#pragma unroll
  for (int i = 0; i < 8; ++i) {
    int row = (lane >> 3) + 8 * i, ch = lane & 7;
    uint4 v = *(const uint4*)(wl + row * 144 + ch * 16);
    *(uint4*)(dst + (long)row * ld + (ch & 3) * 8 + (ch >> 2) * gap) = v;
  }
}
template <class F>
__device__ __forceinline__ void rows_out_f32(const float* wl, int lane, F f) {
#pragma unroll
  for (int i = 0; i < 8; ++i) {
    int row = (lane >> 4) + 4 * i, ch = lane & 15;
    float4 v = *(const float4*)(wl + row * 68 + ch * 4);
    f(row, ch, v);
  }
}

template <int NO, int NW>
__device__ __forceinline__ void epi_resid(const Params& p, int layer, const float* xp, const float* xs, float* xout,
                                          int tm, int tn, int wc, f32x4 (&acc)[4][NW], char* smem) {
  const int lane = tidx() & 63, wid = tidx() >> 6, wr = wid >> 1, fr = lane & 15, fq = lane >> 4;
  float* wl = (float*)(smem + wid * 16384);
  int mv = tm < 64 ? 0 : 1 + ((tm - 64) >> 3);
  const int ch = lane & 15;
  const int col = tn * 128 + wc * 64 + ch * 4;
  const float4 g4 = *(const float4*)(WSB_mod + (long)(layer * 5 + mv) * 3072 + 2048 + col);
  const int trow0 = tm * 128 + wr * 64;
  const float* xin = (trow0 < TP ? xp + (long)trow0 * 1024 : xs + (long)(trow0 - TP) * 1024) + col;
  float* xo = xout + (long)trow0 * 1024 + col;
#pragma unroll
  for (int a = 0; a < 2; ++a) {
#pragma unroll
    for (int mm = 0; mm < 2; ++mm)
#pragma unroll
      for (int j = 0; j < 4; ++j)
#pragma unroll
        for (int n = 0; n < 4; ++n) wl[(mm * 16 + fq * 4 + j) * 68 + n * 16 + fr] = acc[2 * a + mm][NO + (n)][j];
    LDSWAIT();
    rows_out_f32(wl, lane, [&](int row, int, float4 v) {
      long off = (long)(a * 32 + row) * 1024;
      float4 x = *(const float4*)(xin + off);
      float4 o;
      o.x = x.x + g4.x * v.x; o.y = x.y + g4.y * v.y; o.z = x.z + g4.z * v.z; o.w = x.w + g4.w * v.w;
      *(float4*)(xo + off) = o;
    });
    LDSWAIT();
  }
}

template <int NO, int NW>
__device__ __forceinline__ void epi_na_in(const Params& p, int lj, int tm, int tn, int wc, f32x4 (&acc)[4][NW], char* smem) {
  const int lane = tidx() & 63, wid = tidx() >> 6, wr = wid >> 1, fr = lane & 15, fq = lane >> 4;
  char* wl = smem + wid * 16384;
  u16* wl16 = (u16*)wl;
  float* wlf = (float*)wl;
  const int sec = tn >> 3;
  const int cbase = (tn & 7) * 128 + wc * 64;
  const int head = cbase >> 6;
  const int row0 = tm * 128 + wr * 64;
  int b, s0; long sb;
  if (row0 < TP) { b = row0 >> 8; s0 = row0 & 255; sb = (long)(b * 16 + head) * 256 * 64; }
  else { int ts = row0 - TP; b = ts >> 10; s0 = ts & 1023; sb = (long)TP * 1024 + (long)(b * 16 + head) * 1024 * 64; }
  const int kt = s0 >> 6;
  if (sec <= 1) {
    const float* gain = (sec == 0 ? p.na_q_gain : p.na_k_gain) + lj * 64;
    float g[4];
#pragma unroll
    for (int n = 0; n < 4; ++n) g[n] = gain[n * 16 + fr] * (sec == 0 ? 0.125f : 1.f);
#pragma unroll
    for (int m = 0; m < 4; ++m)
#pragma unroll
      for (int j = 0; j < 4; ++j) {
        float ss = 0.f;
#pragma unroll
        for (int n = 0; n < 4; ++n) ss += acc[m][NO + (n)][j] * acc[m][NO + (n)][j];
        ss += __shfl_xor(ss, 1); ss += __shfl_xor(ss, 2); ss += __shfl_xor(ss, 4); ss += __shfl_xor(ss, 8);
        float r = rsqrtf(ss * (1.f / 64.f) + 1e-6f);
#pragma unroll
        for (int n = 0; n < 4; ++n) acc[m][NO + (n)][j] *= r * g[n];
      }
#pragma unroll
    for (int m = 0; m < 4; ++m)
#pragma unroll
      for (int j = 0; j < 4; ++j)
#pragma unroll
        for (int n = 0; n < 4; n += 2) st2bf(wl16, (m * 16 + fq * 4 + j) * 72 + n * 16 + fr, (m * 16 + fq * 4 + j) * 72 + (n + 1) * 16 + fr, acc[m][NO + (n)][j], acc[m][NO + (n + 1)][j]);
    LDSWAIT();
    if (sec == 0) {
      rows_out_bf16(wl, lane, WSB_na_q + (long)row0 * 1024 + cbase, 1024);
    } else {
#pragma unroll
      for (int m = 0; m < 4; ++m)
#pragma unroll
        for (int ks = 0; ks < 2; ++ks) {
          uint4 v = *(const uint4*)(wl + (m * 16 + fr) * 144 + (ks * 32 + fq * 8) * 2);
          *(uint4*)(WSB_na_k + sb + (long)(((kt * 4 + m) * 2 + ks) * 64 + lane) * 8) = v;
        }
    }
    LDSWAIT();
    if (sec == 1 && row0 < TP) {
      float* nk = WSB_new_k + ((long)(b * 2 + lj) * 256 + s0) * 1024 + head * 64;
#pragma unroll
      for (int a = 0; a < 2; ++a) {
#pragma unroll
        for (int mm = 0; mm < 2; ++mm)
#pragma unroll
          for (int j = 0; j < 4; ++j)
#pragma unroll
            for (int n = 0; n < 4; ++n) wlf[(mm * 16 + fq * 4 + j) * 68 + n * 16 + fr] = acc[2 * a + mm][NO + (n)][j];
        LDSWAIT();
        rows_out_f32(wlf, lane, [&](int row, int ch, float4 v) { nt_store4(nk + (long)(a * 32 + row) * 1024 + ch * 4, v); });
        LDSWAIT();
      }
    }
  } else if (sec == 2) {
#pragma unroll
    for (int m = 0; m < 4; m += 2) {
#pragma unroll
      for (int n = 0; n < 4; ++n) {
        f32x4 a = acc[m][NO + (n)], a2 = acc[m + 1][NO + (n)];
        uint4 o; o.x = pk2(a[0], a[1]); o.y = pk2(a[2], a[3]); o.z = pk2(a2[0], a2[1]); o.w = pk2(a2[2], a2[3]);
        *(uint4*)(WSB_na_vT + sb + ((long)(((kt * 2 + (m >> 1)) * 4 + n) * 64 + lane)) * 8) = o;
      }
    }
    if (row0 < TP) {
      float* nv = WSB_new_v + ((long)(b * 2 + lj) * 256 + s0) * 1024 + head * 64;
#pragma unroll
      for (int a = 0; a < 2; ++a) {
#pragma unroll
        for (int mm = 0; mm < 2; ++mm)
#pragma unroll
          for (int j = 0; j < 4; ++j)
#pragma unroll
            for (int n = 0; n < 4; ++n) wlf[(mm * 16 + fq * 4 + j) * 68 + n * 16 + fr] = acc[2 * a + mm][NO + (n)][j];
        LDSWAIT();
        rows_out_f32(wlf, lane, [&](int row, int ch, float4 v) { nt_store4(nv + (long)(a * 32 + row) * 1024 + ch * 4, v); });
        LDSWAIT();
      }
    }
  } else {
#pragma unroll
    for (int m = 0; m < 4; ++m)
#pragma unroll
      for (int j = 0; j < 4; ++j)
#pragma unroll
        for (int n = 0; n < 4; n += 2) st2bf(wl16, (m * 16 + fq * 4 + j) * 72 + n * 16 + fr, (m * 16 + fq * 4 + j) * 72 + (n + 1) * 16 + fr, silu_f(acc[m][NO + (n)][j]), silu_f(acc[m][NO + (n + 1)][j]));
    LDSWAIT();
    rows_out_bf16(wl, lane, WSB_na_sg + (long)row0 * 1024 + cbase, 1024);
    LDSWAIT();
  }
}

template <int NO, int NW>
__device__ __forceinline__ void epi_ret_in(const Params& p, int tm, int tn, int wc, f32x4 (&acc)[4][NW], char* smem) {
  const int lane = tidx() & 63, wid = tidx() >> 6, wr = wid >> 1, fr = lane & 15, fq = lane >> 4;
  char* wl = smem + wid * 16384;
  u16* wl16 = (u16*)wl;
  const int row0 = tm * 128 + wr * 64;
  const bool sample = tm >= 64;
  if (tn < 16) {
    const bool isk = tn >= 8;
    const int blk = tn & 7, hh = blk >> 1, half = blk & 1;
    const float l2f = WSB_dec[hh], l2b = WSB_dec[4 + hh];
#pragma unroll
    for (int m = 0; m < 4; ++m)
#pragma unroll
      for (int j = 0; j < 4; ++j) {
        int t = row0 + m * 16 + fq * 4 + j;
        int nn = (t - TP) & 1023;
        int pos = half == 0 ? (nn >> 6) : (nn & 63);
#pragma unroll
        for (int n2 = 0; n2 < 2; ++n2) {
          int i = wc * 32 + n2 * 16 + fr;
          float x1 = acc[m][NO + (n2)][j], x2 = acc[m][NO + (n2 + 2)][j];
          float o1 = x1, o2 = x2;
          if (sample) {
            float2 cs = *(const float2*)(WSB_ropetab + 2 * (pos * 64 + i));
            o1 = x1 * cs.x - x2 * cs.y;
            o2 = x1 * cs.y + x2 * cs.x;
          }
          if (isk) { o1 *= 0.0625f; o2 *= 0.0625f; }
          acc[m][NO + (n2)][j] = o1; acc[m][NO + (n2 + 2)][j] = o2;
        }
      }
#pragma unroll
    for (int m = 0; m < 4; ++m)
#pragma unroll
      for (int j = 0; j < 4; ++j)
#pragma unroll
        for (int n = 0; n < 4; n += 2) st2bf(wl16, (m * 16 + fq * 4 + j) * 72 + (n >> 1) * 32 + fr, (m * 16 + fq * 4 + j) * 72 + (n >> 1) * 32 + 16 + fr, acc[m][NO + (n)][j], acc[m][NO + (n + 1)][j]);
    LDSWAIT();
    if (!isk) {
      rows_out_bf16_split(wl, lane, WSB_rt_q + (long)row0 * 1024 + hh * 256 + half * 128 + wc * 32, 1024, 64);
      LDSWAIT();
      if (sample) {
        int ts0 = row0 - TP, b = ts0 >> 10, nn0 = ts0 & 1023;
        u16* qs = WSB_rt_qs + ((long)(b * 4 + hh) * 1024 + nn0) * 512 + half * 128 + wc * 32;
#pragma unroll
        for (int dir = 0; dir < 2; ++dir) {
#pragma unroll
          for (int m = 0; m < 4; ++m)
#pragma unroll
            for (int j = 0; j < 4; ++j) {
              int nn = nn0 + m * 16 + fq * 4 + j;
              float w = dir == 0 ? exp2f(l2f * (float)(nn + 1)) : exp2f(l2b * (float)(1024 - nn));
#pragma unroll
              for (int n = 0; n < 4; n += 2) st2bf(wl16, (m * 16 + fq * 4 + j) * 72 + (n >> 1) * 32 + fr, (m * 16 + fq * 4 + j) * 72 + (n >> 1) * 32 + 16 + fr, acc[m][NO + (n)][j] * w, acc[m][NO + (n + 1)][j] * w);
            }
          LDSWAIT();
          rows_out_bf16_split(wl, lane, qs + dir * 256, 512, 64);
          LDSWAIT();
        }
      }
    } else {
      int s0; long sb;
      if (!sample) { s0 = row0 & 255; sb = (long)((row0 >> 8) * 4 + hh) * 256 * 256; }
      else { int ts = row0 - TP; s0 = ts & 1023; sb = (long)TP * 1024 + (long)((ts >> 10) * 4 + hh) * 1024 * 256; }
      const int kt = s0 >> 6;
#pragma unroll
      for (int m = 0; m < 4; ++m)
#pragma unroll
        for (int r = 0; r < 2; ++r) {
          uint4 v = *(const uint4*)(wl + (m * 16 + fr) * 144 + (r * 32 + fq * 8) * 2);
          *(uint4*)(WSB_rt_k + sb + (long)(((kt * 4 + m) * 8 + half * 4 + wc + 2 * r) * 64 + lane) * 8) = v;
        }
      LDSWAIT();
      if (!sample) {
        const int bh = (row0 >> 8) * 4 + hh;
#pragma unroll
        for (int m = 0; m < 4; m += 2) {
          float wf[8], wb[8];
#pragma unroll
          for (int e = 0; e < 8; ++e) {
            int s = s0 + (m + (e >> 2)) * 16 + fq * 4 + (e & 3);
            wf[e] = exp2f(l2f * (float)(255 - s));
            wb[e] = exp2f(l2b * (float)s);
          }
#pragma unroll
          for (int n = 0; n < 4; ++n) {
            int dk = half * 128 + (n >> 1) * 64 + wc * 32 + (n & 1) * 16;
            f32x4 a = acc[m][NO + (n)], a2 = acc[m + 1][NO + (n)];
            uint4 of, ob;
            of.x = pk2(a[0] * wf[0], a[1] * wf[1]); of.y = pk2(a[2] * wf[2], a[3] * wf[3]);
            of.z = pk2(a2[0] * wf[4], a2[1] * wf[5]); of.w = pk2(a2[2] * wf[6], a2[3] * wf[7]);
            ob.x = pk2(a[0] * wb[0], a[1] * wb[1]); ob.y = pk2(a[2] * wb[2], a[3] * wb[3]);
            ob.z = pk2(a2[0] * wb[4], a2[1] * wb[5]); ob.w = pk2(a2[2] * wb[6], a2[3] * wb[7]);
            long off = ((long)((kt * 2 + (m >> 1)) * 16 + (dk >> 4)) * 64 + lane) * 8;
            *(uint4*)(WSB_rt_kT + (long)(bh * 2 + 0) * 65536 + off) = of;
            *(uint4*)(WSB_rt_kT + (long)(bh * 2 + 1) * 65536 + off) = ob;
          }
        }
      }
    }
  } else if (tn < 32) {
    const int cv0 = (tn - 16) * 128 + wc * 64;
    const int hh = cv0 >> 9;
    int s0; long sb;
    if (!sample) { s0 = row0 & 255; sb = (long)((row0 >> 8) * 4 + hh) * 256 * 512; }
    else { int ts = row0 - TP; s0 = ts & 1023; sb = (long)TP * 2048 + (long)((ts >> 10) * 4 + hh) * 1024 * 512; }
    const int kt = s0 >> 6;
#pragma unroll
    for (int m = 0; m < 4; m += 2)
#pragma unroll
      for (int n = 0; n < 4; ++n) {
        int dvt = ((cv0 & 511) >> 4) + n;
        f32x4 a = acc[m][NO + (n)], a2 = acc[m + 1][NO + (n)];
        uint4 o; o.x = pk2(a[0], a[1]); o.y = pk2(a[2], a[3]); o.z = pk2(a2[0], a2[1]); o.w = pk2(a2[2], a2[3]);
        *(uint4*)(WSB_rt_vF + sb + ((long)((kt * 2 + (m >> 1)) * 32 + dvt) * 64 + lane) * 8) = o;
      }
  } else {
#pragma unroll
    for (int m = 0; m < 4; ++m)
#pragma unroll
      for (int j = 0; j < 4; ++j)
#pragma unroll
        for (int n = 0; n < 4; n += 2) st2bf(wl16, (m * 16 + fq * 4 + j) * 72 + n * 16 + fr, (m * 16 + fq * 4 + j) * 72 + (n + 1) * 16 + fr, silu_f(acc[m][NO + (n)][j]), silu_f(acc[m][NO + (n + 1)][j]));
    LDSWAIT();
    rows_out_bf16(wl, lane, WSB_rt_sg + (long)row0 * 2048 + (tn - 32) * 128 + wc * 64, 2048);
    LDSWAIT();
  }
}

template <int NO, int NW>
__device__ __forceinline__ void epi_ret_vg(const Params& p, int tm, int tn, int wc, f32x4 (&acc)[4][NW], char* smem) {
  const int lane = tidx() & 63, wid = tidx() >> 6, wr = wid >> 1, fr = lane & 15, fq = lane >> 4;
  char* wl = smem + wid * 16384;
  u16* wl16 = (u16*)wl;
  const int row0 = tm * 128 + wr * 64;
  const bool sample = tm >= 64;
  (void)fq; (void)fr; (void)wl16;
  if (tn < 32) {
    const int cv0 = (tn - 16) * 128 + wc * 64;
    const int hh = cv0 >> 9;
    int s0; long sb;
    if (!sample) { s0 = row0 & 255; sb = (long)((row0 >> 8) * 4 + hh) * 256 * 512; }
    else { int ts = row0 - TP; s0 = ts & 1023; sb = (long)TP * 2048 + (long)((ts >> 10) * 4 + hh) * 1024 * 512; }
    const int kt = s0 >> 6;
#pragma unroll
    for (int m = 0; m < 4; m += 2)
#pragma unroll
      for (int n = 0; n < 4; ++n) {
        int dvt = ((cv0 & 511) >> 4) + n;
        f32x4 a = acc[m][NO + (n)], a2 = acc[m + 1][NO + (n)];
        uint4 o; o.x = pk2(a[0], a[1]); o.y = pk2(a[2], a[3]); o.z = pk2(a2[0], a2[1]); o.w = pk2(a2[2], a2[3]);
        *(uint4*)(WSB_rt_vF + sb + ((long)((kt * 2 + (m >> 1)) * 32 + dvt) * 64 + lane) * 8) = o;
      }
  } else {
#pragma unroll
    for (int m = 0; m < 4; ++m)
#pragma unroll
      for (int j = 0; j < 4; ++j)
#pragma unroll
        for (int n = 0; n < 4; n += 2) st2bf(wl16, (m * 16 + fq * 4 + j) * 72 + n * 16 + fr, (m * 16 + fq * 4 + j) * 72 + (n + 1) * 16 + fr, silu_f(acc[m][NO + (n)][j]), silu_f(acc[m][NO + (n + 1)][j]));
    LDSWAIT();
    rows_out_bf16(wl, lane, WSB_rt_sg + (long)row0 * 2048 + (tn - 32) * 128 + wc * 64, 2048);
    LDSWAIT();
  }
}

template <int NO, int NW>
__device__ __forceinline__ void epi_mlp_in(const Params& p, int tm, int tn, int wc, f32x4 (&acc)[4][NW], char* smem) {
  const int lane = tidx() & 63, wid = tidx() >> 6, wr = wid >> 1, fr = lane & 15, fq = lane >> 4;
  char* wl = smem + wid * 16384;
  u16* wl16 = (u16*)wl;
  const int row0 = tm * 128 + wr * 64;
  if (tn < 16 || tn >= 32) {
    const bool isu = tn < 16;
    u16* dstb = isu ? WSB_ml_gu : WSB_ml_sg;
    const int c0 = (isu ? tn : tn - 32) * 128 + wc * 64;
#pragma unroll
    for (int m = 0; m < 4; ++m)
#pragma unroll
      for (int j = 0; j < 4; ++j)
#pragma unroll
        for (int n = 0; n < 4; n += 2) {
          float a = acc[m][NO + (n)][j], a1 = acc[m][NO + (n + 1)][j];
          st2bf(wl16, (m * 16 + fq * 4 + j) * 72 + n * 16 + fr, (m * 16 + fq * 4 + j) * 72 + (n + 1) * 16 + fr,
                isu ? gelu_f(a) : silu_f(a), isu ? gelu_f(a1) : silu_f(a1));
        }
    LDSWAIT();
    rows_out_bf16(wl, lane, dstb + (long)row0 * 2048 + c0, 2048);
    LDSWAIT();
  } else {
    const int c0 = (tn - 16) * 128 + wc * 64;
    float s1[4][4], s2[4][4];
#pragma unroll
    for (int m = 0; m < 4; ++m)
#pragma unroll
      for (int j = 0; j < 4; ++j) { s1[m][j] = 0.f; s2[m][j] = 0.f; }
#pragma unroll
    for (int m = 0; m < 4; ++m)
#pragma unroll
      for (int n = 0; n < 4; ++n)
#pragma unroll
        for (int j = 0; j < 4; ++j) {
          float gq = bf2f(f2bf(gelu_f(acc[m][NO + (n)][j])));
          acc[m][NO + (n)][j] = gq;
          s1[m][j] += gq; s2[m][j] += gq * gq;
        }
#pragma unroll
    for (int m = 0; m < 4; m += 2)
#pragma unroll
      for (int n = 0; n < 4; ++n) {
        f32x4 a = acc[m][NO + (n)], a2 = acc[m + 1][NO + (n)];
        uint4 o; o.x = pk2(a[0], a[1]); o.y = pk2(a[2], a[3]); o.z = pk2(a2[0], a2[1]); o.w = pk2(a2[2], a2[3]);
        int ks2 = wr * 2 + (m >> 1), ct = (c0 >> 4) + n;
        *(uint4*)(WSB_ml_vT + ((long)((tm * 4 + ks2) * 128 + ct) * 64 + lane) * 8) = o;
      }
#pragma unroll
    for (int m = 0; m < 4; ++m)
#pragma unroll
      for (int j = 0; j < 4; ++j) {
        float a = s1[m][j], b = s2[m][j];
        a += __shfl_xor(a, 1); a += __shfl_xor(a, 2); a += __shfl_xor(a, 4); a += __shfl_xor(a, 8);
        b += __shfl_xor(b, 1); b += __shfl_xor(b, 2); b += __shfl_xor(b, 4); b += __shfl_xor(b, 8);
        if (fr == 0) {
          int t = row0 + m * 16 + fq * 4 + j;
          float2 st; st.x = a; st.y = b;
          *(float2*)(WSB_ml_st + ((long)t * 32 + (tn - 16) * 2 + wc) * 2) = st;
        }
      }
  }
}

__device__ __forceinline__ void na_attn_phase(const Params& p, int lj, char* smem) {
  float* s_rpb = (float*)smem;
  const int tid = tidx(), lane = tid & 63, wid = tid >> 6, fr = lane & 15, fq = lane >> 4;
  const unsigned lane8 = lane * 8;
  for (int item0 = blockIdx.x; item0 < 1536; item0 += gridDim.x) {
    bool lat; int bhi, sub;
    if (gridDim.x == 512) {
      const int x = blockIdx.x & 7, slot = blockIdx.x >> 3, k = item0 >> 9;
      if (k == 0) { lat = true; bhi = x + 8 * (slot >> 3); sub = slot & 7; }
      else { lat = false; bhi = x + 8 * ((k - 1) * 32 + (slot >> 1)); sub = slot & 1; }
    } else {
      if (item0 < 512) { lat = true; bhi = item0 >> 3; sub = item0 & 7; }
      else { lat = false; bhi = (item0 - 512) >> 1; sub = (item0 - 512) & 1; }
    }
    const int b2 = bhi >> 4, h2 = bhi & 15;
    int tq[2], rr[2] = {0, 0}, rs[2] = {0, 0}, NTloc, NT;
    const u16 *kb2, *vb2, *ckb = nullptr, *cvb = nullptr;
    if (lat) {
      rr[0] = 2 * sub; rr[1] = 2 * sub + 1;
      rs[0] = min(max(rr[0] - 4, 0), 8); rs[1] = min(max(rr[1] - 4, 0), 8);
      NTloc = rs[1] - rs[0] + 8; NT = NTloc + 4;
      tq[0] = TP + b2 * 1024 + rr[0] * 64 + wid * 16; tq[1] = tq[0] + 64;
      kb2 = WSB_na_k + (long)TP * 1024 + (long)bhi * 1024 * 64 + rs[0] * 4096;
      vb2 = WSB_na_vT + (long)TP * 1024 + (long)bhi * 1024 * 64 + rs[0] * 4096;
      ckb = WSB_ck_bf + (long)((b2 * 2 + lj) * 16 + h2) * 256 * 64;
      cvb = WSB_cvt_bf + (long)((b2 * 2 + lj) * 16 + h2) * 256 * 64;
      const float* rp = p.na_rpb + (long)(lj * 16 + h2) * 465;
      for (int i = tid; i < 465; i += 256) s_rpb[i] = rp[i];
      __syncthreads();
    } else {
      NTloc = 0; NT = 4;
      tq[0] = b2 * 256 + sub * 128 + wid * 16; tq[1] = tq[0] + 64;
      kb2 = WSB_na_k + (long)bhi * 256 * 64;
      vb2 = WSB_na_vT + (long)bhi * 256 * 64;
    }
    const int cq = wid * 16 + fr;
    const int cstart = min(max(cq - 8, 0), 48);
    bf16x8 qf2[2][2];
    f32x4 o2[2][4];
    float l2[2] = {0.f, 0.f};
#pragma unroll
    for (int u = 0; u < 2; ++u) {
#pragma unroll
      for (int ks = 0; ks < 2; ++ks) qf2[u][ks] = *(const bf16x8*)(WSB_na_q + (long)(tq[u] + fr) * 1024 + h2 * 64 + ks * 32 + fq * 8);
#pragma unroll
      for (int dt = 0; dt < 4; ++dt) o2[u][dt] = f32x4{0.f, 0.f, 0.f, 0.f};
    }
    bf16x8 ring[16];
#pragma unroll
    for (int i = 0; i < 8; ++i) { ring[i] = *(const bf16x8*)(kb2 + i * 512 + lane8); ring[8 + i] = *(const bf16x8*)(vb2 + i * 512 + lane8); }
    for (int tau = 0; tau < NT; ++tau) {
      const bool more = tau + 1 < NT;
      const u16 *kn = kb2, *vn = vb2;
      if (more) {
        if (lat && tau + 1 >= NTloc) { kn = ckb + (tau + 1 - NTloc) * 4096; vn = cvb + (tau + 1 - NTloc) * 4096; }
        else { kn = kb2 + (tau + 1) * 4096; vn = vb2 + (tau + 1) * 4096; }
      }
      f32x4 s[2][4];
#pragma unroll
      for (int u = 0; u < 2; ++u)
#pragma unroll
        for (int n = 0; n < 4; ++n) s[u][n] = f32x4{0.f, 0.f, 0.f, 0.f};
#pragma unroll
      for (int i = 0; i < 8; ++i) {
        s[0][i >> 1] = MFMA16(ring[i], qf2[0][i & 1], s[0][i >> 1]);
        s[1][i >> 1] = MFMA16(ring[i], qf2[1][i & 1], s[1][i >> 1]);
        if (more) ring[i] = *(const bf16x8*)(kn + i * 512 + lane8);
      }
      if (lat && tau < NTloc) {
        const int jr = rs[0] + tau;
#pragma unroll
        for (int u = 0; u < 2; ++u) {
          const bool rowok = (jr >= rs[u]) && (jr < rs[u] + 8);
          const float* rb = s_rpb + min(max(jr - rr[u] + 7, 0), 14) * 31;
#pragma unroll
          for (int n = 0; n < 4; ++n)
#pragma unroll
            for (int j = 0; j < 4; ++j) {
              int ck = n * 16 + fq * 4 + j;
              bool valid = rowok && (ck >= cstart) && (ck < cstart + 16);
              int coff = min(max(ck - cq + 15, 0), 30);
              float e = __expf(s[u][n][j] + rb[coff]);
              float pv = valid ? e : 0.f;
              l2[u] += pv; s[u][n][j] = pv;
            }
        }
      } else {
#pragma unroll
        for (int u = 0; u < 2; ++u)
#pragma unroll
          for (int n = 0; n < 4; ++n)
#pragma unroll
            for (int j = 0; j < 4; ++j) { float pv = __expf(s[u][n][j]); l2[u] += pv; s[u][n][j] = pv; }
      }
      bf16x8 pa[2][2];
#pragma unroll
      for (int u = 0; u < 2; ++u) { pa[u][0] = pack8(s[u][0], s[u][1]); pa[u][1] = pack8(s[u][2], s[u][3]); }
#pragma unroll
      for (int v = 0; v < 8; ++v) {
        o2[0][v & 3] = MFMA16(pa[0][v >> 2], ring[8 + v], o2[0][v & 3]);
        o2[1][v & 3] = MFMA16(pa[1][v >> 2], ring[8 + v], o2[1][v & 3]);
        if (more) ring[8 + v] = *(const bf16x8*)(vn + v * 512 + lane8);
      }
    }
    if (lat) __syncthreads();
    float* wl = (float*)(smem + 4096 + wid * 4352);
#pragma unroll
    for (int u = 0; u < 2; ++u) {
      float lu = l2[u];
      lu += __shfl_xor(lu, 16);
      lu += __shfl_xor(lu, 32);
#pragma unroll
      for (int j = 0; j < 4; ++j) {
        float lq = __shfl(lu, fq * 4 + j);
        float inv = __builtin_amdgcn_rcpf(lq);
#pragma unroll
        for (int dt = 0; dt < 4; ++dt) wl[(fq * 4 + j) * 68 + dt * 16 + fr] = o2[u][dt][j] * inv;
      }
      LDSWAIT();
#pragma unroll
      for (int i = 0; i < 4; ++i) {
        int c = lane + 64 * i, row = c >> 4, ch = c & 15;
        float4 v = *(const float4*)(wl + row * 68 + ch * 4);
        long idx = (long)(tq[u] + row) * 1024 + h2 * 64 + ch * 4;
        uint2 sg = *(const uint2*)(WSB_na_sg + idx);
        store4bf(WSB_na_o + idx, v.x * __uint_as_float(sg.x << 16), v.y * __uint_as_float(sg.x & 0xffff0000u),
                 v.z * __uint_as_float(sg.y << 16), v.w * __uint_as_float(sg.y & 0xffff0000u));
      }
      LDSWAIT();
    }
  }
}

template <bool sample>
__device__ __forceinline__ void ret_main_item(const Params& p, int bh, int qt, char* smem) {
  const int tid = tidx();
  int lane = tid & 63;
  asm volatile("" : "+v"(lane));
  const int fr = lane & 15, fq = lane >> 4;
  const int wid = __builtin_amdgcn_readfirstlane(tid >> 6);
  const int dvh = wid & 1;
  constexpr int S = sample ? 1024 : 256;
  const int tok0 = sample ? TP + (bh >> 2) * 1024 : (bh >> 2) * 256;
  const int hh = bh & 3;
  const int qw = qt * 32 + (wid >> 1) * 16;
  const int qi = qw + fr;
  const float l2f = WSB_dec[hh], l2b = WSB_dec[4 + hh];
  const u16* vFb = (sample ? WSB_rt_vF + (long)TP * 2048 + (long)bh * 1024 * 512 : WSB_rt_vF + (long)bh * 256 * 512) + dvh * 16 * 512;
  const u16* kFb = sample ? WSB_rt_k + (long)TP * 1024 + (long)bh * 1024 * 256 : WSB_rt_k + (long)bh * 256 * 256;
  const unsigned k_lane = fr * 1024 + fq * 8;
  const unsigned lane8 = lane * 8;
  bf16x8* qlds = (bf16x8*)(smem + wid * 8192) + lane;
  {
    const u16* qg = WSB_rt_q + (long)(tok0 + qw) * 1024 + hh * 256;
#pragma unroll
    for (int ks = 0; ks < 8; ++ks) qlds[ks * 64] = *(const bf16x8*)(qg + ks * 32 + k_lane);
  }
  f32x4 o[16];
#pragma unroll
  for (int dt = 0; dt < 16; ++dt) o[dt] = f32x4{0.f, 0.f, 0.f, 0.f};
#define RFRAG(kt_, i_) ((i_) < 16 ? *(const bf16x8*)(kFb + (kt_) * 16384 + (dvh * 16 + (i_)) * 512 + lane8) \
                                  : *(const bf16x8*)(vFb + ((kt_) * 2 + (((i_) - 16) >> 4)) * 16384 + (((i_) - 16) & 15) * 512 + lane8))
  bf16x8* xbuf = (bf16x8*)(smem + 36864);
  bf16x8 ring[16];
#pragma unroll
  for (int i = 0; i < 16; ++i) ring[i] = RFRAG(0, i);
  constexpr int NKT = S / 64;
  for (int kt = 0; kt < NKT; ++kt) {
    f32x4 s[2];
    s[0] = f32x4{0.f, 0.f, 0.f, 0.f}; s[1] = s[0];
#pragma unroll
    for (int i = 0; i < 16; ++i) {
      s[i >> 3] = MFMA16(ring[i], qlds[(i & 7) * 64], s[i >> 3]);
      ring[i] = RFRAG(kt, i + 16);
    }
#pragma unroll
    for (int nl = 0; nl < 2; ++nl)
#pragma unroll
      for (int j = 0; j < 4; ++j) {
        int d = qi - (kt * 64 + (2 * dvh + nl) * 16 + fq * 4 + j);
        float e = (d >= 0 ? l2f : l2b) * fabsf((float)d);
        float w = __builtin_amdgcn_exp2f(e);
        s[nl][j] *= (d == 0 ? 2.0f : w);
      }
    bf16x8 pmine = pack8(s[0], s[1]);
    xbuf[((kt & 1) * 4 + wid) * 64 + lane] = pmine;
    __syncthreads();
    bf16x8 pother = xbuf[((kt & 1) * 4 + (wid ^ 1)) * 64 + lane];
    bf16x8 pa0 = dvh == 0 ? pmine : pother, pa1 = dvh == 0 ? pother : pmine;
#pragma unroll
    for (int v = 0; v < 32; ++v) {
      o[v & 15] = MFMA16(v < 16 ? pa0 : pa1, ring[v & 15], o[v & 15]);
      if (v < 16) ring[v & 15] = RFRAG(kt, 32 + v);
      else if (kt + 1 < NKT) ring[v & 15] = RFRAG(kt + 1, v - 16);
    }
  }
#undef RFRAG
  if (sample) {
    const u16* qs = WSB_rt_qs + ((long)bh * 1024 + qw) * 512;
    const u16* sb = WSB_s0t + (long)bh * 262144 + dvh * 16 * 512;
    const unsigned i_lane = fr * 512 + fq * 8;
#pragma unroll
    for (int dt = 0; dt < 16; ++dt) ring[dt] = *(const bf16x8*)(sb + dt * 512 + lane8);
    bf16x8 a = *(const bf16x8*)(qs + i_lane);
    for (int ks = 0; ks < 16; ++ks) {
      bf16x8 an = a;
      if (ks + 1 < 16) an = *(const bf16x8*)(qs + (ks + 1) * 32 + i_lane);
#pragma unroll
      for (int dt = 0; dt < 16; ++dt) {
        o[dt] = MFMA16(a, ring[dt], o[dt]);
        if (ks + 1 < 16) ring[dt] = *(const bf16x8*)(sb + ((ks + 1) * 32 + dt) * 512 + lane8);
      }
      a = an;
    }
  }
  float* s_st = (float*)(smem + 32768);
  float sm[4], sq[4];
#pragma unroll
  for (int j = 0; j < 4; ++j) {
    float a = 0.f, b = 0.f;
#pragma unroll
    for (int dt = 0; dt < 16; ++dt) { a += o[dt][j]; b += o[dt][j] * o[dt][j]; }
    a += __shfl_xor(a, 1); a += __shfl_xor(a, 2); a += __shfl_xor(a, 4); a += __shfl_xor(a, 8);
    b += __shfl_xor(b, 1); b += __shfl_xor(b, 2); b += __shfl_xor(b, 4); b += __shfl_xor(b, 8);
    sm[j] = a; sq[j] = b;
    if (fr == 0) { s_st[(wid * 16 + fq * 4 + j) * 2] = a; s_st[(wid * 16 + fq * 4 + j) * 2 + 1] = b; }
  }
  __syncthreads();
  float mean[4], rstd[4];
#pragma unroll
  for (int j = 0; j < 4; ++j) {
    float a = sm[j] + s_st[((wid ^ 1) * 16 + fq * 4 + j) * 2];
    float b = sq[j] + s_st[((wid ^ 1) * 16 + fq * 4 + j) * 2 + 1];
    mean[j] = a * (1.f / 512.f);
    float var = fmaxf(b * (1.f / 512.f) - mean[j] * mean[j], 0.f);
    rstd[j] = rsqrtf(var + 1e-6f);
  }
  {
    float* wl = (float*)(smem + wid * 8192);
    const long rowu = (long)(tok0 + qw) * 2048 + hh * 512 + dvh * 256;
    const float* gw = p.ret_gn_w + hh * 512 + dvh * 256;
#pragma unroll
    for (int pp = 0; pp < 4; ++pp) {
#pragma unroll
      for (int j = 0; j < 4; ++j)
#pragma unroll
        for (int d4 = 0; d4 < 4; ++d4) wl[(fq * 4 + j) * 68 + d4 * 16 + fr] = (o[pp * 4 + d4][j] - mean[j]) * rstd[j];
      LDSWAIT();
#pragma unroll
      for (int i = 0; i < 4; ++i) {
        int c = lane + 64 * i, row = c >> 4, ch = c & 15;
        float4 v = *(const float4*)(wl + row * 68 + ch * 4);
        int col = pp * 64 + ch * 4;
        float4 g4 = *(const float4*)(gw + col);
        long idx = rowu + (long)row * 2048 + col;
        uint2 sg = *(const uint2*)(WSB_rt_sg + idx);
        store4bf(WSB_rt_y + idx, v.x * g4.x * __uint_as_float(sg.x << 16), v.y * g4.y * __uint_as_float(sg.x & 0xffff0000u),
                 v.z * g4.z * __uint_as_float(sg.y << 16), v.w * g4.w * __uint_as_float(sg.y & 0xffff0000u));
      }
      LDSWAIT();
    }
  }
  __syncthreads();
}

__device__ __forceinline__ void ret_state_item(const Params& p, int x, char* smem) {
  const int lane = tidx() & 63, wid = tidx() >> 6, wr = wid >> 1, wc = wid & 1;
  float* wl = (float*)(smem + wid * 16384);
  int mat = x >> 3, tile = x & 7, tmm = tile >> 2, tnn = tile & 3;
  f32x4 acc[4][4];
#pragma unroll
  for (int m = 0; m < 4; ++m)
#pragma unroll
    for (int n = 0; n < 4; ++n) acc[m][n] = f32x4{0.f, 0.f, 0.f, 0.f};
  const u16* ka = WSB_rt_kT + (long)mat * 65536 + (tmm * 8 + wr * 4) * 512;
  const u16* vb = WSB_rt_vF + (long)(mat >> 1) * 256 * 512 + (tnn * 8 + wc * 4) * 512;
  const unsigned lane8 = lane * 8;
  bf16x8 afr[2][4], bfg[2][4];
#pragma unroll
  for (int m = 0; m < 4; ++m) { afr[0][m] = *(const bf16x8*)(ka + m * 512 + lane8); bfg[0][m] = *(const bf16x8*)(vb + m * 512 + lane8); }
#pragma unroll
  for (int kk = 0; kk < 8; ++kk) {
    if (kk + 1 < 8) {
#pragma unroll
      for (int m = 0; m < 4; ++m) {
        afr[(kk + 1) & 1][m] = *(const bf16x8*)(ka + (kk + 1) * (16 * 512) + m * 512 + lane8);
        bfg[(kk + 1) & 1][m] = *(const bf16x8*)(vb + (kk + 1) * (32 * 512) + m * 512 + lane8);
      }
    }
#pragma unroll
    for (int m = 0; m < 4; ++m)
#pragma unroll
      for (int n = 0; n < 4; ++n) acc[m][n] = MFMA16(afr[kk & 1][m], bfg[kk & 1][n], acc[m][n]);
  }
  int bh = mat >> 1, dir = mat & 1, b = bh >> 2, hh = bh & 3;
  const int fr = lane & 15, fq = lane >> 4;
  float* outb = WSB_new_ret + ((long)((b * 2 + dir) * 4 + hh) * 256 + tmm * 128 + wr * 64) * 512 + tnn * 128 + wc * 64;
#pragma unroll
  for (int a = 0; a < 2; ++a) {
#pragma unroll
    for (int mm = 0; mm < 2; ++mm)
#pragma unroll
      for (int j = 0; j < 4; ++j)
#pragma unroll
        for (int n = 0; n < 4; ++n) wl[(mm * 16 + fq * 4 + j) * 68 + n * 16 + fr] = acc[2 * a + mm][n][j];
    LDSWAIT();
    rows_out_f32(wl, lane, [&](int row, int ch, float4 v) { nt_store4(outb + (long)(a * 32 + row) * 512 + ch * 4, v); });
    LDSWAIT();
  }
  __syncthreads();
}

__device__ __forceinline__ void ret_phase(const Params& p, char* smem) {
  if (gridDim.x == 512) {
    const int x = blockIdx.x & 7, slot = blockIdx.x >> 3;
    ret_main_item<true>(p, x + 8 * (slot >> 5), slot & 31, smem);
    for (int rho = 0; rho < 2; ++rho) ret_main_item<false>(p, x + 8 * (rho * 8 + (slot >> 3)), slot & 7, smem);
    for (int rho = 0; rho < 4; ++rho) ret_state_item(p, (x + 8 * (rho * 8 + (slot >> 3))) * 8 + (slot & 7), smem);
    return;
  }
  for (int it = blockIdx.x; it < 3584; it += gridDim.x) {
    if (it < 512) ret_main_item<true>(p, it >> 5, it & 31, smem);
    else if (it < 1536) { int x = it - 512; ret_main_item<false>(p, x >> 3, x & 7, smem); }
    else ret_state_item(p, it - 1536, smem);
  }
}

__device__ __forceinline__ void mlp_spatial_phase(const Params& p, char* smem) {
  float* s_mu = (float*)smem;
  float* s_rs = s_mu + 128;
  const int tid = tidx(), lane = tid & 63, wid = tid >> 6, wr = wid >> 1, wc = wid & 1, fr = lane & 15, fq = lane >> 4;
  for (int item = blockIdx.x; item < 1536; item += gridDim.x) {
    int chunk = item >> 4, g = (item >> 1) & 7, dh = item & 1;
    if (tid < 128) {
      const float4* st = (const float4*)(WSB_ml_st + ((long)(chunk * 128 + tid) * 32) * 2);
      float a = 0.f, b = 0.f;
#pragma unroll
      for (int i = 0; i < 16; ++i) { float4 v = st[i]; a += v.x + v.z; b += v.y + v.w; }
      float mu = a * (1.f / 2048.f);
      float var = b * (1.f / 2048.f) - mu * mu;
      s_mu[tid] = mu;
      s_rs[tid] = rsqrtf(fmaxf(var, 0.f) + 1e-6f);
    }
    __syncthreads();
    f32x4 acc[4][4];
#pragma unroll
    for (int m = 0; m < 4; ++m)
#pragma unroll
      for (int n = 0; n < 4; ++n) acc[m][n] = f32x4{0.f, 0.f, 0.f, 0.f};
    const int cb = g * 256 + dh * 128 + wc * 64;
    float lw[4], lb[4];
#pragma unroll
    for (int n = 0; n < 4; ++n) { lw[n] = p.mlp_ln_w[cb + n * 16 + fr]; lb[n] = p.mlp_ln_b[cb + n * 16 + fr]; }
    bf16x4 wa[2][4][2];
    bf16x8 rawb[2][4];
    const u16* wbase = WSB_ws_bf + ((long)g * 128 + wr * 64 + fr) * 128 + fq * 4;
    const u16* vbase = WSB_ml_vT + ((long)(chunk * 4) * 128 + (cb >> 4)) * 512 + lane * 8;
#pragma unroll
    for (int m = 0; m < 4; ++m) { wa[0][m][0] = *(const bf16x4*)(wbase + m * 16 * 128); wa[0][m][1] = *(const bf16x4*)(wbase + m * 16 * 128 + 16); }
#pragma unroll
    for (int n = 0; n < 4; ++n) rawb[0][n] = *(const bf16x8*)(vbase + n * 512);
#pragma unroll
    for (int ks = 0; ks < 4; ++ks) {
      if (ks + 1 < 4) {
#pragma unroll
        for (int m = 0; m < 4; ++m) {
          wa[(ks + 1) & 1][m][0] = *(const bf16x4*)(wbase + m * 16 * 128 + (2 * ks + 2) * 16);
          wa[(ks + 1) & 1][m][1] = *(const bf16x4*)(wbase + m * 16 * 128 + (2 * ks + 3) * 16);
        }
#pragma unroll
        for (int n = 0; n < 4; ++n) rawb[(ks + 1) & 1][n] = *(const bf16x8*)(vbase + (long)(ks + 1) * 128 * 512 + n * 512);
      }
      bf16x8 af[4], bfr[4];
#pragma unroll
      for (int m = 0; m < 4; ++m) af[m] = __builtin_shufflevector(wa[ks & 1][m][0], wa[ks & 1][m][1], 0, 1, 2, 3, 4, 5, 6, 7);
      float mu[8], rs[8];
#pragma unroll
      for (int e = 0; e < 8; ++e) { int jx = (2 * ks + (e >> 2)) * 16 + fq * 4 + (e & 3); mu[e] = s_mu[jx]; rs[e] = s_rs[jx]; }
#pragma unroll
      for (int n = 0; n < 4; ++n) {
        bf16x8 raw = rawb[ks & 1][n];
        float v[8];
#pragma unroll
        for (int e = 0; e < 8; ++e) v[e] = (bf2f((u16)raw[e]) - mu[e]) * rs[e] * lw[n] + lb[n];
        u32x4_t pk;
        pk[0] = pk2(v[0], v[1]); pk[1] = pk2(v[2], v[3]); pk[2] = pk2(v[4], v[5]); pk[3] = pk2(v[6], v[7]);
        bfr[n] = __builtin_bit_cast(bf16x8, pk);
      }
#pragma unroll
      for (int m = 0; m < 4; ++m)
#pragma unroll
        for (int n = 0; n < 4; ++n) acc[m][n] = MFMA16(af[m], bfr[n], acc[m][n]);
    }
    {
      float* wl = (float*)(smem + 4096 + wid * 8704);
#pragma unroll
      for (int a = 0; a < 2; ++a) {
#pragma unroll
        for (int mm = 0; mm < 2; ++mm)
#pragma unroll
          for (int j = 0; j < 4; ++j) {
            float bs = p.mlp_b_s[g * 128 + wr * 64 + (2 * a + mm) * 16 + fq * 4 + j];
#pragma unroll
            for (int n = 0; n < 4; ++n) wl[(mm * 16 + fq * 4 + j) * 68 + n * 16 + fr] = acc[2 * a + mm][n][j] + bs;
          }
        LDSWAIT();
        rows_out_f32(wl, lane, [&](int row, int ch, float4 v) {
          long idx = (long)(chunk * 128 + wr * 64 + a * 32 + row) * 2048 + cb + ch * 4;
          uint2 gu = *(const uint2*)(WSB_ml_gu + idx), sg = *(const uint2*)(WSB_ml_sg + idx);
          store4bf(WSB_ml_o + idx,
                   __uint_as_float(gu.x << 16) * v.x * __uint_as_float(sg.x << 16),
                   __uint_as_float(gu.x & 0xffff0000u) * v.y * __uint_as_float(sg.x & 0xffff0000u),
                   __uint_as_float(gu.y << 16) * v.z * __uint_as_float(sg.y << 16),
                   __uint_as_float(gu.y & 0xffff0000u) * v.w * __uint_as_float(sg.y & 0xffff0000u));
        });
        LDSWAIT();
      }
    }
    __syncthreads();
  }
}


#define XB_TMO      128
#define XB_XCNT(j)  (256  + 64 * (j))
#define XB_XSUB(j)  (1280 + 64 * (j))
#define XB_XGEN(j)  (2304 + 64 * (j))
#define XB_TOP      3328
#define XB_TOPGEN   3392
#define XCD_BAR_WORDS 3456
#define XB_SPIN_CAP (1u << 22)
#define LAS __attribute__((address_space(3)))
__device__ __forceinline__ unsigned xb_ld(unsigned* p)              { return __hip_atomic_load(p, __ATOMIC_RELAXED, __HIP_MEMORY_SCOPE_AGENT); }
__device__ __forceinline__ unsigned xb_add(unsigned* p, unsigned v) { return __hip_atomic_fetch_add(p, v, __ATOMIC_RELAXED, __HIP_MEMORY_SCOPE_AGENT); }
__device__ __forceinline__ unsigned xb_xcc_id() { return (unsigned)__builtin_amdgcn_s_getreg((3 << 11) | 20) & 0xFu; }
#define XB_SPIN(cond, bar) do { unsigned _sp = 0; while (cond) { __builtin_amdgcn_s_sleep(1); \
    if ((++_sp & 255u) == 0u) { if (xb_ld(&(bar)[XB_TMO])) break; if (_sp > XB_SPIN_CAP) { atomicAdd(&(bar)[XB_TMO], 1u); break; } } } } while (0)
struct XcdBarrier { unsigned* bar; unsigned x; volatile LAS unsigned* st; };
__device__ __forceinline__ XcdBarrier xcd_barrier_post(unsigned* bar, volatile LAS unsigned* st) {
  XcdBarrier b; b.bar = bar; b.x = xb_xcc_id(); b.st = st;
  if (threadIdx.x == 0) (void)xb_add(&bar[XB_XCNT(b.x)], 1u);
  return b;
}
__device__ __forceinline__ void xcd_barrier_complete(unsigned* bar, unsigned x, unsigned& nloc, unsigned& nx) {
  const unsigned G = gridDim.x * gridDim.y * gridDim.z;
  unsigned sum, cnt, mine, sp = 0u;
  for (;;) {
    sum = 0u; cnt = 0u; mine = 0u;
#pragma unroll
    for (unsigned j = 0; j < 16; ++j) { const unsigned c = xb_ld(&bar[XB_XCNT(j)]); sum += c; cnt += (c > 0u) ? 1u : 0u; mine = (j == x) ? c : mine; }
    if (sum == G) break;
    __builtin_amdgcn_s_sleep(1);
    if ((++sp & 255u) == 0u) { if (xb_ld(&bar[XB_TMO])) break; if (sp > XB_SPIN_CAP) { atomicAdd(&bar[XB_TMO], 1u); break; } }
  }
  nloc = mine > 0u ? mine : 1u; nx = cnt > 0u ? cnt : 1u;
}
__device__ __forceinline__ void xcd_barrier(const XcdBarrier& b) {
  asm volatile("s_waitcnt vmcnt(0)" ::: "memory");
  __syncthreads();
  if (threadIdx.x == 0) {
    unsigned* bar = b.bar;
    __builtin_amdgcn_s_waitcnt(0);
    unsigned nloc = b.st[0], nx = b.st[1];
    if (nloc == 0u) { xcd_barrier_complete(bar, b.x, nloc, nx); b.st[0] = nloc; b.st[1] = nx; }
    const unsigned old = xb_add(&bar[XB_XSUB(b.x)], 1u);
    const unsigned gen = old / nloc;
    if (old + 1u == (gen + 1u) * nloc) {
      __builtin_amdgcn_fence(__ATOMIC_RELEASE, "agent");
      asm volatile("s_waitcnt vmcnt(0)" ::: "memory");
      const unsigned og = xb_add(&bar[XB_TOP], 1u);
      const unsigned tg = og / nx;
      if (og + 1u == (tg + 1u) * nx) xb_add(&bar[XB_TOPGEN], 1u);
      else XB_SPIN(xb_ld(&bar[XB_TOPGEN]) == tg, bar);
      __builtin_amdgcn_fence(__ATOMIC_ACQUIRE, "agent");
      xb_add(&bar[XB_XGEN(b.x)], 1u);
      asm volatile("s_waitcnt vmcnt(0)" ::: "memory");
    } else {
      XB_SPIN(xb_ld(&bar[XB_XGEN(b.x)]) == gen, bar);
      __builtin_amdgcn_fence(__ATOMIC_ACQUIRE, "agent");
      asm volatile("s_waitcnt vmcnt(0)" ::: "memory");
    }
  }
  __syncthreads();
}

__device__ __forceinline__ bool gemm_tile_map(int it, int ntm, int ntn, int& tm, int& tn) {
  if (gridDim.x == 512 && ntn == 8) {
    int x = blockIdx.x & 7, slot = blockIdx.x >> 3;
    int L = it * 64 + slot;
    if (L >= 96) return false;
    tm = x + 8 * (L >> 3); tn = L & 7;
    return true;
  }
  if (gridDim.x == 99999) {
    int x = blockIdx.x & 7, slot = blockIdx.x >> 3;
    int nsn = ntn >> 3, nst = (ntm >> 3) * nsn;
    int sg = it * 8 + x;
    if (sg >= nst) return false;
    int sn = sg % nsn, sm = sg / nsn;
    tm = sm * 8 + (slot >> 3); tn = sn * 8 + (slot & 7);
    return true;
  }
  int t = blockIdx.x + it * gridDim.x;
  if (t >= ntm * ntn) return false;
  tn = t % ntn; tm = t / ntn;
  return true;
}

__device__ __forceinline__ void run_phase(const Params& p, int ph, char* smem) {
  if (ph == 0) { prep_phase(p, smem); return; }
  const int layer = (ph - 1) >> 2, sub = (ph - 1) & 3;
  const int kind = layer % 3, lj = layer / 3;
  const float* xp = layer == 0 ? p.x_prompt : WSB_X;
  const float* xs = layer == 0 ? p.x_sample : WSB_X + (long)TP * 1024;
  float* xout = layer == 3 ? WSB_y_out : WSB_X;
  if (sub == 0) { norm_phase(p, layer, xp, xs); return; }
  if (sub == 1) {
    if (kind == 0) {
      const u16* W = WSB_wt_na_in + (long)lj * 4096 * 1024;
      const int wcw = (tidx() >> 6) & 1;
      for (int t = blockIdx.x; t < 96 * 16; t += gridDim.x) {
        int tn = t & 15, tm = t >> 4;
        if (gridDim.x == 512) {
          int L = (t >> 9) * 64 + (blockIdx.x >> 3);
          tm = (blockIdx.x & 7) + 8 * (L >> 4); tn = L & 15;
        }
        f32x4 acc[4][8];
        gemm_core_w(WSB_h + (long)tm * 128 * 1024, 1024, W + (long)tn * 256 * 1024, 1024, 1024, smem, acc);
        epi_na_in<0>(p, lj, tm, 2 * tn + wcw, 0, acc, smem);
        epi_na_in<4>(p, lj, tm, 2 * tn + wcw, 1, acc, smem);
        __syncthreads();
      }
    } else {
      const u16* W = kind == 1 ? WSB_wt_ret_in : WSB_wt_mlp_in;
      const int wcw = (tidx() >> 6) & 1;
      if (kind == 1) {
        for (int t = blockIdx.x; t < 96 * 16; t += gridDim.x) {
          int tn = t & 15, tm = t >> 4;
          if (gridDim.x == 512) { int L = (t >> 9) * 64 + (blockIdx.x >> 3); tm = (blockIdx.x & 7) + 8 * (L >> 4); tn = L & 15; }
          f32x4 acc[4][4];
          gemm_core(WSB_h + (long)tm * 128 * 1024, 1024, W + (long)tn * 128 * 1024, 1024, 1024, smem, acc);
          epi_ret_in<0>(p, tm, tn, wcw, acc, smem);
          __syncthreads();
        }
        for (int t = blockIdx.x; t < 96 * 16; t += gridDim.x) {
          int tw = t & 15, tm = t >> 4;
          if (gridDim.x == 512) { int L = (t >> 9) * 64 + (blockIdx.x >> 3); tm = (blockIdx.x & 7) + 8 * (L >> 4); tw = L & 15; }
          f32x4 acc[4][8];
          gemm_core_w(WSB_h + (long)tm * 128 * 1024, 1024, W + (long)(2048 + tw * 256) * 1024, 1024, 1024, smem, acc);
          epi_ret_vg<0>(p, tm, 16 + 2 * tw + wcw, 0, acc, smem);
          epi_ret_vg<4>(p, tm, 16 + 2 * tw + wcw, 1, acc, smem);
          __syncthreads();
        }
      } else
      for (int t = blockIdx.x; t < 96 * 24; t += gridDim.x) {
        int tn = t % 24, tm = t / 24;
        f32x4 acc[4][8];
        gemm_core_w(WSB_h + (long)tm * 128 * 1024, 1024, W + (long)tn * 256 * 1024, 1024, 1024, smem, acc);
        epi_mlp_in<0>(p, tm, 2 * tn + wcw, 0, acc, smem);
        epi_mlp_in<4>(p, tm, 2 * tn + wcw, 1, acc, smem);
        __syncthreads();
      }
    }
    return;
  }
  if (sub == 2) {
    if (kind == 0) na_attn_phase(p, lj, smem);
    else if (kind == 1) ret_phase(p, smem);
    else mlp_spatial_phase(p, smem);
    return;
  }
  {
    const u16* A; const u16* W; int K;
    if (kind == 0) { A = WSB_na_o; W = WSB_wt_na_out + (long)lj * 1024 * 1024; K = 1024; }
    else if (kind == 1) { A = WSB_rt_y; W = WSB_wt_ret_out; K = 2048; }
    else { A = WSB_ml_o; W = WSB_wt_mlp_out; K = 2048; }
    const int wcw = (tidx() >> 6) & 1;
    if (gridDim.x == 512) {
      const int x = blockIdx.x & 7, slot = blockIdx.x >> 3;
      if (slot < 32) {
        int tm = x + 8 * (slot >> 2), tn = slot & 3;
        f32x4 acc[4][8];
        gemm_core_w(A + (long)tm * 128 * K, K, W + (long)tn * 256 * K, K, K, smem, acc);
        epi_resid<0>(p, layer, xp, xs, xout, tm, 2 * tn + wcw, 0, acc, smem);
        epi_resid<4>(p, layer, xp, xs, xout, tm, 2 * tn + wcw, 1, acc, smem);
      } else {
        int L = slot - 32;
        int tm = 64 + x + 8 * (L >> 3), tn = L & 7;
        f32x4 acc[4][4];
        gemm_core(A + (long)tm * 128 * K, K, W + (long)tn * 128 * K, K, K, smem, acc);
        epi_resid<0>(p, layer, xp, xs, xout, tm, tn, wcw, acc, smem);
      }
      __syncthreads();
    } else {
      int tm, tn;
      for (int it = 0; gemm_tile_map(it, 96, 8, tm, tn); ++it) {
        f32x4 acc[4][4];
        gemm_core(A + (long)tm * 128 * K, K, W + (long)tn * 128 * K, K, K, smem, acc);
        epi_resid<0>(p, layer, xp, xs, xout, tm, tn, wcw, acc, smem);
        __syncthreads();
      }
    }
  }
}

#define NPHASE 17
#ifndef PROBE_MASK
#define PROBE_MASK 0
#endif

__global__ void __launch_bounds__(256, 2) mega_kernel(Params p) {
  __shared__ __attribute__((aligned(16))) char smem[65536];
  __shared__ uint4 xb_words;
  cg::grid_group grid = cg::this_grid();
  if (threadIdx.x == 0) xb_words = make_uint4(0u, 0u, 0u, 0u);
  __syncthreads();
  XcdBarrier xb = xcd_barrier_post(WSB_bar, (volatile LAS unsigned*)&xb_words);
  {
    int never = 0;
    asm volatile("" : "+s"(never));
    if (never) grid.sync();
  }
#pragma nounroll
  for (int ph = 0; ph < NPHASE; ++ph) {
    int phv = ph;
    asm volatile("" : "+s"(phv));
    run_phase(p, phv, smem);
#if PROBE_MASK
    {
      int sub = (ph - 1) & 3, kind = ((ph - 1) >> 2) % 3;
      int cls = ph == 0 ? 1 : (sub == 0 ? 2 : (sub == 1 ? 4 : (sub == 2 ? (8 << kind) : 64)));
      if (cls & PROBE_MASK) { xcd_barrier(xb); run_phase(p, phv, smem); }
    }
#endif
    if (ph + 1 < NPHASE) xcd_barrier(xb);
  }
}

#ifndef MULTI_LAUNCH
#define MULTI_LAUNCH 0
#endif

extern "C" void kernel_launch(void* const* d_in, const int* in_sizes, int n_in, void* d_out, int out_size, void* d_ws,
                              size_t ws_size, hipStream_t stream) {
  Params p{};
  p.x_prompt = (const float*)d_in[0];  p.x_sample = (const float*)d_in[1];
  p.cache_k = (const float*)d_in[2];   p.cache_v = (const float*)d_in[3];
  p.state_ret = (const float*)d_in[4]; p.c = (const float*)d_in[5];
  p.c_ctx = (const float*)d_in[6];     p.norm_w = (const float*)d_in[7];
  p.w_ada = (const float*)d_in[8];     p.b_ada = (const float*)d_in[9];
  p.na_w_in = (const float*)d_in[10];  p.na_w_out = (const float*)d_in[11];
  p.na_q_gain = (const float*)d_in[12]; p.na_k_gain = (const float*)d_in[13];
  p.na_rpb = (const float*)d_in[14];
  p.ret_w_in = (const float*)d_in[15]; p.ret_w_out = (const float*)d_in[16];
  p.ret_decay = (const float*)d_in[17]; p.ret_gn_w = (const float*)d_in[18];
  p.mlp_w_in = (const float*)d_in[19]; p.mlp_ln_w = (const float*)d_in[20];
  p.mlp_ln_b = (const float*)d_in[21]; p.mlp_w_s = (const float*)d_in[22];
  p.mlp_b_s = (const float*)d_in[23];  p.mlp_w_out = (const float*)d_in[24];
  p.out = (float*)d_out;
  p.ws = (char*)d_ws;

  static int grid_blocks = 0;
  if (!grid_blocks) {
    int dev = 0, cus = 0, per_cu = 0;
    (void)hipGetDevice(&dev);
    (void)hipDeviceGetAttribute(&cus, hipDeviceAttributeMultiprocessorCount, dev);
    (void)hipOccupancyMaxActiveBlocksPerMultiprocessor(&per_cu, mega_kernel, 256, 0);
    if (per_cu > 2) per_cu = 2;
    if (per_cu < 1) per_cu = 1;
    grid_blocks = cus * per_cu;
  }
  (void)hipMemsetAsync(p.ws + 71844096ULL, 0, (size_t)XCD_BAR_WORDS * 4, stream);
  void* args[] = {&p};
  hipError_t e = hipLaunchCooperativeKernel((void*)mega_kernel, dim3(grid_blocks), dim3(256), args, 0, stream);
  if (e != hipSuccess) fprintf(stderr, "cooperative launch failed: %s (grid %d)\n", hipGetErrorString(e), grid_blocks);
}
```
